# Optimizing an MI355X kernel written in HIP

```python
import math
import jax, jax.numpy as jnp
from jax import lax
import numpy as np

D_MODEL = 1024
BATCH = 1
SEQ = 16384
DEPTH = 1

EPS = 1e-6
D_FF = 2816
MLA_HEADS = 8
QK_NOPE = 64
QK_ROPE = 32
V_DIM = 64
Q_LORA = 384
KV_LORA = 256
ROPE_THETA = 10000.0
DIL_PATTERNS = ((128, 1), (512, 4), (2048, 16))
DIL_GROUPS = len(DIL_PATTERNS)
DIL_HEADS_PER_GROUP = 8
DIL_HEADS = DIL_GROUPS * DIL_HEADS_PER_GROUP
DIL_HEAD_DIM = 64
MAX_DIL = max(r for _, r in DIL_PATTERNS)
NUM_BUCKETS = 32
MAX_DISTANCE = 2048
BLK = 128
MLA_WIDTH = MLA_HEADS * V_DIM
DIL_WIDTH = DIL_HEADS_PER_GROUP * DIL_HEAD_DIM
IN_SIZES = (Q_LORA, KV_LORA, QK_ROPE,
            DIL_HEADS * DIL_HEAD_DIM, DIL_HEADS * DIL_HEAD_DIM, DIL_HEADS * DIL_HEAD_DIM,
            D_MODEL, D_MODEL)
D_IN = int(sum(IN_SIZES))
IN_OFFSETS = tuple(int(v) for v in np.cumsum(IN_SIZES)[:-1])
NEG_INF = -1e30

kernel_name = "hybrid_mla_dilated_gated_macaron"


def rms_norm(x, g):
    x32 = x.astype(jnp.float32)
    y = x32 * lax.rsqrt(jnp.mean(x32 * x32, axis=-1, keepdims=True) + EPS)
    return (y * g.astype(jnp.float32)).astype(x.dtype)


def swiglu(h, w_gate, w_up, w_down):
    return (jax.nn.silu(h @ w_gate) * (h @ w_up)) @ w_down


def rope_tables(positions):
    inv_freq = 1.0 / (ROPE_THETA ** (jnp.arange(0, QK_ROPE, 2, dtype=jnp.float32) / QK_ROPE))
    ang = positions.astype(jnp.float32)[..., None] * inv_freq
    return jnp.cos(ang), jnp.sin(ang)


def apply_rope(x, cos, sin):
    x1, x2 = jnp.split(x, 2, axis=-1)
    cos = cos.astype(x.dtype)
    sin = sin.astype(x.dtype)
    return jnp.concatenate([x1 * cos - x2 * sin, x1 * sin + x2 * cos], axis=-1)


def t5_bucket(dist):
    max_exact = NUM_BUCKETS // 2
    d = jnp.maximum(dist, 1).astype(jnp.float32)
    large = max_exact + (jnp.log(d / max_exact) / math.log(MAX_DISTANCE / max_exact)
                         * (NUM_BUCKETS - max_exact)).astype(jnp.int32)
    large = jnp.minimum(large, NUM_BUCKETS - 1)
    return jnp.where(dist < max_exact, dist, large).astype(jnp.int32)


def causal_dense_attention(q, k, v, scale):
    b, s, h, dqk = q.shape
    dv = v.shape[-1]
    nq = s // BLK
    q_blocks = q.reshape(b, nq, BLK, h, dqk).transpose(1, 0, 2, 3, 4)
    q_pos = jnp.arange(s, dtype=jnp.int32).reshape(nq, BLK)
    k_pos = jnp.arange(s, dtype=jnp.int32)

    def one_block(args):
        qb, qp = args
        logits = jnp.einsum('bqhd,bkhd->bhqk', qb, k).astype(jnp.float32) * scale
        logits = jnp.where(k_pos[None, :] <= qp[:, None], logits, NEG_INF)
        p = jax.nn.softmax(logits, axis=-1)
        return jnp.einsum('bhqk,bkhd->bqhd', p.astype(v.dtype), v)

    out = lax.map(one_block, (q_blocks, q_pos))
    return out.transpose(1, 0, 2, 3, 4).reshape(b, s, h * dv)


def dilated_group_attention(q, k, v, rel_bias_g, dilation, steps):
    b, s_pad, hg, dh = q.shape
    length = s_pad // dilation
    nb = length // BLK

    def to_blocks(t):
        t = t.reshape(b, length, dilation, hg, dh).transpose(0, 2, 1, 3, 4)
        return t.reshape(b, dilation, nb, BLK, hg, dh)

    def with_prev(t):
        prev = jnp.concatenate([jnp.zeros_like(t[:, :, :1]), t[:, :, :-1]], axis=2)
        return jnp.concatenate([prev, t], axis=3)

    qb = to_blocks(q)
    kk = with_prev(to_blocks(k))
    vv = with_prev(to_blocks(v))

    qi = jnp.arange(BLK, dtype=jnp.int32)[:, None]
    kj = jnp.arange(2 * BLK, dtype=jnp.int32)[None, :]
    step = qi + BLK - kj
    band = (step >= 0) & (step <= steps)
    first_block = (jnp.arange(nb) == 0)[:, None, None]
    valid = band[None] & ~(first_block & (kj < BLK)[None])
    bias = rel_bias_g[t5_bucket(jnp.maximum(step, 0) * dilation)]
    bias = bias.transpose(2, 0, 1).astype(jnp.float32)

    scale = DIL_HEAD_DIM ** -0.5
    logits = jnp.einsum('brnqhd,brnkhd->brnhqk', qb, kk).astype(jnp.float32) * scale + bias
    logits = jnp.where(valid[None, None, :, None], logits, NEG_INF)
    m = jnp.max(logits, axis=-1, keepdims=True)
    p = jnp.exp(logits - m)
    den = jnp.sum(p, axis=-1, keepdims=True)
    out = jnp.einsum('brnhqk,brnkhd->brnqhd', (p / den).astype(v.dtype), vv)
    lse = (m + jnp.log(den))[..., 0]

    out = out.reshape(b, dilation, length, hg, dh).transpose(0, 2, 1, 3, 4).reshape(b, s_pad, hg, dh)
    lse = lse.transpose(0, 1, 2, 4, 3).reshape(b, dilation, length, hg)
    lse = lse.transpose(0, 2, 1, 3).reshape(b, s_pad, hg)
    return out, lse


def dilated_mixture(q_d, k_d, v_d, rel_bias):
    b, s, _ = q_d.shape
    unit = MAX_DIL * BLK
    s_pad = -(-s // unit) * unit

    def prep(t):
        t = t.reshape(b, s, DIL_HEADS, DIL_HEAD_DIM)
        return jnp.pad(t, ((0, 0), (0, s_pad - s), (0, 0), (0, 0)))

    qp, kp, vp = prep(q_d), prep(k_d), prep(v_d)
    outs, lses = [], []
    for g, (window, dilation) in enumerate(DIL_PATTERNS):
        hs = slice(g * DIL_HEADS_PER_GROUP, (g + 1) * DIL_HEADS_PER_GROUP)
        o, l = dilated_group_attention(qp[:, :, hs], kp[:, :, hs], vp[:, :, hs],
                                       rel_bias[:, hs], dilation, window // dilation)
        outs.append(o)
        lses.append(l)
    w = jax.nn.softmax(jnp.stack(lses, axis=0), axis=0)
    y = jnp.sum(w[..., None] * jnp.stack(outs, axis=0).astype(jnp.float32), axis=0)
    return y[:, :s].reshape(b, s, DIL_WIDTH).astype(q_d.dtype)


def hybrid_mixer(h, positions, rel_bias, w_in, b_gate, q_norm, w_uq, kv_norm, w_ukv,
                 w_br_mla, w_br_dil, w_out):
    b, s, _ = h.shape
    proj = h @ w_in
    c_q, c_kv, k_rope, q_d, k_d, v_d, g_a, g_b = jnp.split(proj, IN_OFFSETS, axis=-1)

    cos, sin = rope_tables(positions)
    q = (rms_norm(c_q, q_norm) @ w_uq).reshape(b, s, MLA_HEADS, QK_NOPE + QK_ROPE)
    q_nope, q_pe = q[..., :QK_NOPE], q[..., QK_NOPE:]
    q_pe = apply_rope(q_pe, cos[:, :, None], sin[:, :, None])
    kv = (rms_norm(c_kv, kv_norm) @ w_ukv).reshape(b, s, MLA_HEADS, QK_NOPE + V_DIM)
    k_nope, v = kv[..., :QK_NOPE], kv[..., QK_NOPE:]
    k_pe = jnp.broadcast_to(apply_rope(k_rope, cos, sin)[:, :, None], (b, s, MLA_HEADS, QK_ROPE))
    q_full = jnp.concatenate([q_nope, q_pe], axis=-1)
    k_full = jnp.concatenate([k_nope, k_pe], axis=-1)
    y_a = causal_dense_attention(q_full, k_full, v, (QK_NOPE + QK_ROPE) ** -0.5) @ w_br_mla

    y_b = dilated_mixture(q_d, k_d, v_d, rel_bias) @ w_br_dil

    gate_a = jax.nn.sigmoid(g_a + b_gate[:D_MODEL])
    gate_b = jax.nn.sigmoid(g_b + b_gate[D_MODEL:])
    return (gate_a * y_a + gate_b * y_b) @ w_out


def setup_inputs(seed: int = 0) -> dict:
    key = jax.random.key(seed)
    ks = jax.random.split(key, 24)

    def w(k, shape, fan_in):
        return jax.random.normal(k, shape, jnp.float32) * (fan_in ** -0.5)

    def gain(k, shape):
        return 1.0 + 0.02 * jax.random.normal(k, shape, jnp.float32)

    x = jax.random.normal(ks[0], (BATCH, SEQ, D_MODEL), jnp.float32)
    offset = jax.random.randint(ks[1], (BATCH, 1), 0, 4096, dtype=jnp.int32)
    positions = offset + jnp.arange(SEQ, dtype=jnp.int32)[None, :]
    L = DEPTH
    return {
        "x": x,
        "positions": positions,
        "rel_bias": 0.5 * jax.random.normal(ks[2], (NUM_BUCKETS, DIL_HEADS), jnp.float32),
        "norm_final": gain(ks[3], (D_MODEL,)),
        "ffn1_norm": gain(ks[4], (L, D_MODEL)),
        "ffn1_w_gate": w(ks[5], (L, D_MODEL, D_FF), D_MODEL),
        "ffn1_w_up": w(ks[6], (L, D_MODEL, D_FF), D_MODEL),
        "ffn1_w_down": w(ks[7], (L, D_FF, D_MODEL), D_FF),
        "mix_norm": gain(ks[8], (L, D_MODEL)),
        "w_in": w(ks[9], (L, D_MODEL, D_IN), D_MODEL),
        "b_gate": 0.01 * jax.random.normal(ks[10], (L, 2 * D_MODEL), jnp.float32),
        "q_norm": gain(ks[11], (L, Q_LORA)),
        "w_uq": w(ks[12], (L, Q_LORA, MLA_HEADS * (QK_NOPE + QK_ROPE)), Q_LORA),
        "kv_norm": gain(ks[13], (L, KV_LORA)),
        "w_ukv": w(ks[14], (L, KV_LORA, MLA_HEADS * (QK_NOPE + V_DIM)), KV_LORA),
        "w_br_mla": w(ks[15], (L, MLA_WIDTH, D_MODEL), MLA_WIDTH),
        "w_br_dil": w(ks[16], (L, DIL_WIDTH, D_MODEL), DIL_WIDTH),
        "w_out": w(ks[17], (L, D_MODEL, D_MODEL), D_MODEL),
        "ffn2_norm": gain(ks[18], (L, D_MODEL)),
        "ffn2_w_gate": w(ks[19], (L, D_MODEL, D_FF), D_MODEL),
        "ffn2_w_up": w(ks[20], (L, D_MODEL, D_FF), D_MODEL),
        "ffn2_w_down": w(ks[21], (L, D_FF, D_MODEL), D_FF),
    }


def reference(x, positions, rel_bias, norm_final, ffn1_norm, ffn1_w_gate, ffn1_w_up, ffn1_w_down,
              mix_norm, w_in, b_gate, q_norm, w_uq, kv_norm, w_ukv, w_br_mla, w_br_dil, w_out,
              ffn2_norm, ffn2_w_gate, ffn2_w_up, ffn2_w_down):
    for l in range(DEPTH):
        x = x + 0.5 * swiglu(rms_norm(x, ffn1_norm[l]), ffn1_w_gate[l], ffn1_w_up[l], ffn1_w_down[l])
        x = x + hybrid_mixer(rms_norm(x, mix_norm[l]), positions, rel_bias, w_in[l], b_gate[l],
                             q_norm[l], w_uq[l], kv_norm[l], w_ukv[l], w_br_mla[l], w_br_dil[l], w_out[l])
        x = x + 0.5 * swiglu(rms_norm(x, ffn2_norm[l]), ffn2_w_gate[l], ffn2_w_up[l], ffn2_w_down[l])
    return rms_norm(x, norm_final)
```

```cpp
#include <hip/hip_runtime.h>
#include <cstdio>
#include <cstdint>

typedef unsigned short bf16_t;
constexpr int S = 16384, DM = 1024, DFF = 2816, DIN = 7328;
constexpr int NH = 8, DQK = 96, DNOPE = 64, DROPE = 32, DV = 64, QLORA = 384, KVLORA = 256;
constexpr int DH = 64, NG = 3, HPG = 8;
constexpr float EPS = 1e-6f;

__device__ __forceinline__ float bf2f(bf16_t v) { return __uint_as_float(((unsigned)v) << 16); }
__device__ __forceinline__ bf16_t f2bf(float f) { unsigned u = __float_as_uint(f); return (bf16_t)((u + 0x7fffu + ((u >> 16) & 1u)) >> 16); }
__device__ __forceinline__ float ldf(const float* p) { return *p; }
__device__ __forceinline__ float ldf(const bf16_t* p) { return bf2f(*p); }
__device__ __forceinline__ float wave_sum(float v) {
#pragma unroll
    for (int o = 1; o < 64; o <<= 1) v += __shfl_xor(v, o);
    return v;
}

__device__ __forceinline__ void sincos_acc(float angf, float& c, float& s) {
    const double a = (double)angf;
    const double k = rint(a * 0.63661977236758134308);
    const double r = fma(-k, 1.5707963267948966192, a) - k * 6.123233995736766e-17;
    const double r2 = r * r;
    double sp = r * (1.0 + r2 * (-1.0 / 6 + r2 * (1.0 / 120 + r2 * (-1.0 / 5040 + r2 * (1.0 / 362880 + r2 * (-1.0 / 39916800 + r2 * (1.0 / 6227020800.0)))))));
    double cp = 1.0 + r2 * (-0.5 + r2 * (1.0 / 24 + r2 * (-1.0 / 720 + r2 * (1.0 / 40320 + r2 * (-1.0 / 3628800 + r2 * (1.0 / 479001600.0 + r2 * (-1.0 / 87178291200.0)))))));
    const int q = ((int)k) & 3;
    double ss = (q & 1) ? cp : sp, cc = (q & 1) ? sp : cp;
    if (q == 1) cc = -cc; if (q == 2) { ss = -ss; cc = -cc; } if (q == 3) ss = -ss;
    c = (float)cc; s = (float)ss;
}
struct InvFreq { float f[16]; };
namespace pg8 {
#define PG8_LAS __attribute__((address_space(3)))
typedef unsigned short bf16_t;
typedef short bf16x8 __attribute__((ext_vector_type(8)));
typedef float f32x4 __attribute__((ext_vector_type(4)));
typedef unsigned u32x4 __attribute__((ext_vector_type(4)));
constexpr int BM = 256, BK = 64, HALF = 128, HTB = HALF * BK * 2  , STAGE_BYTES = 8 * HTB, NXCD = 8, WGM = 8;

__host__ __device__ __forceinline__ int lds_byte(int r, int c) { const int st = (r >> 4) * 2 + (c >> 5), rr = r & 15, cc = c & 31, ob = rr * 64 + cc * 2; return st * 1024 + (ob ^ (((ob >> 9) & 1) << 5)); }
__host__ __device__ __forceinline__ void stage_rc(int b, int& R, int& C) { const int st = b / 1024, sb = b % 1024, swz = sb ^ (((sb >> 9) & 1) << 5); R = (st >> 1) * 16 + swz / 64; C = (st & 1) * 32 + (swz % 64) / 2; }
__host__ __device__ __forceinline__ int perm32(int rho) { const int n = rho >> 4, i = rho & 15; return 8 * (i >> 2) + 4 * n + (i & 3); }

struct Unit { int pm, pn; };
struct Gemm { const bf16_t* A; const bf16_t* Bt; int M, N, K, lda; };

struct StaticOrder {
    int nM, nN, nwg, G, c;
    __host__ __device__ void init(int M, int N, int G_, int c_) { nM = M / BM; nN = N / BM; nwg = nM * nN; G = G_; c = c_; }
    __host__ __device__ bool next(int i, Unit& u) const {
        const long L = (long)i * G + c; if (L >= nwg) return false;
        int wgid = (int)L; { const int q = nwg / NXCD, r = nwg % NXCD, xcd = wgid % NXCD, off = wgid / NXCD; wgid = (xcd < r ? xcd * (q + 1) : r * (q + 1) + (xcd - r) * q) + off; }
        const int nig = WGM * nN, gid = wgid / nig, fm = gid * WGM, gsz = (nM - fm) < WGM ? (nM - fm) : WGM;
        u.pm = fm + ((wgid % nig) % gsz); u.pn = (wgid % nig) / gsz; return true;
    }
    __device__ __forceinline__ void a_ready(const Unit&) const {}
    __device__ __forceinline__ void done(const Unit&) const {}
};

__device__ __forceinline__ unsigned cvt_pk_bf16(float lo, float hi) { unsigned r; asm volatile("v_cvt_pk_bf16_f32 %0, %1, %2" : "=v"(r) : "v"(lo), "v"(hi)); return r; }
template <class Epi, class Sched, bool ALIGN_EPI = false, bool SP2 = false>
__device__ __forceinline__ void gemm_phase(PG8_LAS unsigned char* lds, const Gemm g, const Sched& S, const Epi& E, const int wid) {
    int lane_ = (int)__builtin_amdgcn_mbcnt_hi(~0u, __builtin_amdgcn_mbcnt_lo(~0u, 0u)); asm volatile("" : "+v"(lane_));
    const int lane = lane_, tid = wid * 64 + lane, wr = wid >> 2, wc = wid & 3, fr = lane & 15, fq = lane >> 4;
    int K_ = g.K; asm volatile("" : "+s"(K_)); const int K = K_, nt = K / BK;
    unsigned voffA[2], voffB[2];
#pragma unroll
    for (int i = 0; i < 2; ++i) { int R, C; stage_rc(tid * 16 + i * 8192, R, C); const int Rb = Epi::PERM ? ((R & ~31) + perm32(R & 31)) : R;
        voffA[i] = (unsigned)(R * g.lda + C) * 2u; voffB[i] = (unsigned)(Rb * K + C) * 2u; }
    const size_t kstep = (size_t)(BK * 2);
    const size_t hstepB = (size_t)HALF * K * 2, hstepA = (size_t)HALF * g.lda * 2;
    const size_t tstepB = 2 * hstepB, tstepA = 2 * hstepA;
    const unsigned ldsw = (unsigned)wid * 1024u;
    const int aoff = lds_byte(wr * 64 + fr, fq * 8), boff = lds_byte(wc * 32 + fr, fq * 8);
#define PG8_SA(b, h) (((b) * 2 + (h)) * HTB)
#define PG8_SB(b, h) ((4 + (b) * 2 + (h)) * HTB)
#define PG8_STAGE(bufoff, gbase, voff) do { _Pragma("unroll") for (int _i = 0; _i < 2; ++_i) \
        __builtin_amdgcn_global_load_lds((const unsigned*)((const char*)(gbase) + (voff)[_i]), (PG8_LAS unsigned*)(lds + (bufoff) + ldsw + _i * 8192), 16, 0, 0); } while (0)
#define PG8_LDA(dst, b, h) do { _Pragma("unroll") for (int m = 0; m < 4; ++m) _Pragma("unroll") for (int k = 0; k < 2; ++k) dst[m][k] = *(const PG8_LAS bf16x8*)(lds + PG8_SA(b, h) + aoff + m * 2048 + k * 1024); } while (0)
#define PG8_LDB(dst, b, h) do { _Pragma("unroll") for (int n = 0; n < 2; ++n) _Pragma("unroll") for (int k = 0; k < 2; ++k) dst[n][k] = *(const PG8_LAS bf16x8*)(lds + PG8_SB(b, h) + boff + n * 2048 + k * 1024); } while (0)
#define PG8_MMA(ai, bj, At, Bt) do { __builtin_amdgcn_s_setprio(1); _Pragma("unroll") for (int m = 0; m < 4; ++m) _Pragma("unroll") for (int n = 0; n < 2; ++n) _Pragma("unroll") for (int k = 0; k < 2; ++k) \
        acc[ai][bj][m][n] = __builtin_amdgcn_mfma_f32_16x16x32_bf16(Bt[n][k], At[m][k], acc[ai][bj][m][n], 0, 0, 0); __builtin_amdgcn_s_setprio(0); } while (0)
#define PG8_WAIT_V(n) asm volatile("s_waitcnt vmcnt(" #n ")" ::: "memory")
#define PG8_WAIT_L(n) asm volatile("s_waitcnt lgkmcnt(" #n ")" ::: "memory")
#define PG8_BAR __builtin_amdgcn_s_barrier()
#define PG8_SCHED __builtin_amdgcn_sched_barrier(0)
    Unit cur, nxt; int ui = 0;
    if (!S.next(0, cur)) return;
    f32x4 acc[2][2][4][2];
#pragma unroll
    for (int a = 0; a < 2; ++a)
#pragma unroll
        for (int b = 0; b < 2; ++b)
#pragma unroll
            for (int m = 0; m < 4; ++m)
#pragma unroll
                for (int n = 0; n < 2; ++n) acc[a][b][m][n] = (f32x4){0.f, 0.f, 0.f, 0.f};
    bf16x8 At[4][2], B0[2][2], B1[2][2];
    const char* cA = (const char*)g.A + (size_t)cur.pm * tstepA; const char* cB = (const char*)g.Bt + (size_t)cur.pn * tstepB;
    S.a_ready(cur);
    if constexpr (SP2) {
        PG8_STAGE(PG8_SB(0, 0), cB, voffB); PG8_STAGE(PG8_SB(0, 1), cB + hstepB, voffB); PG8_STAGE(PG8_SA(0, 0), cA, voffA); PG8_STAGE(PG8_SA(0, 1), cA + hstepA, voffA);
        if (wr == 1) PG8_BAR;
        PG8_WAIT_V(2); PG8_BAR;
        PG8_STAGE(PG8_SB(1, 0), cB + kstep, voffB); PG8_STAGE(PG8_SA(1, 0), cA + kstep, voffA); PG8_STAGE(PG8_SB(1, 1), cB + hstepB + kstep, voffB);
        PG8_WAIT_V(6); PG8_BAR;
    } else {
        PG8_STAGE(PG8_SB(0, 0), cB, voffB); PG8_STAGE(PG8_SA(0, 0), cA, voffA); PG8_STAGE(PG8_SB(0, 1), cB + hstepB, voffB); PG8_STAGE(PG8_SA(0, 1), cA + hstepA, voffA);
        if (wr == 1) PG8_BAR;
        PG8_WAIT_V(4); PG8_BAR;
        PG8_STAGE(PG8_SB(1, 0), cB + kstep, voffB); PG8_STAGE(PG8_SA(1, 0), cA + kstep, voffA); PG8_STAGE(PG8_SB(1, 1), cB + hstepB + kstep, voffB);
        PG8_WAIT_V(6); PG8_BAR;
    }
    for (;;) {
        const bool has_next = S.next(ui + 1, nxt);
        const char* nA = has_next ? (const char*)g.A + (size_t)nxt.pm * tstepA : cA; const char* nB = has_next ? (const char*)g.Bt + (size_t)nxt.pn * tstepB : cB;
        for (int t = 0; t < nt; t += 2) {
            const bool last = (t == nt - 2);
            const char* a1 = cA + (size_t)(t + 1) * kstep;
            const char* a2 = last ? nA : cA + (size_t)(t + 2) * kstep; const char* b2 = last ? nB : cB + (size_t)(t + 2) * kstep;
            const char* a3 = a2 + kstep; const char* b3 = b2 + kstep;
            if (last && has_next) S.a_ready(nxt);
            if constexpr (SP2) {
            PG8_LDB(B0, 0, 0); PG8_LDB(B1, 0, 1); PG8_SCHED; PG8_LDA(At, 0, 0); PG8_STAGE(PG8_SA(1, 1), a1 + hstepA, voffA);
            PG8_WAIT_V(8); PG8_WAIT_L(0); PG8_BAR; PG8_MMA(0, 0, At, B0); PG8_MMA(0, 1, At, B1); PG8_BAR; PG8_SCHED;
            PG8_LDA(At, 0, 1); PG8_STAGE(PG8_SB(0, 0), b2, voffB); PG8_STAGE(PG8_SB(0, 1), b2 + hstepB, voffB); PG8_STAGE(PG8_SA(0, 0), a2, voffA);
            PG8_WAIT_V(8); PG8_WAIT_L(0); PG8_BAR; PG8_MMA(1, 0, At, B0); PG8_MMA(1, 1, At, B1); PG8_BAR; PG8_SCHED;
            PG8_LDB(B0, 1, 0); PG8_LDB(B1, 1, 1); PG8_SCHED; PG8_LDA(At, 1, 0); PG8_STAGE(PG8_SA(0, 1), a2 + hstepA, voffA);
            PG8_WAIT_V(8); PG8_WAIT_L(0); PG8_BAR; PG8_MMA(0, 0, At, B0); PG8_MMA(0, 1, At, B1); PG8_BAR; PG8_SCHED;
            PG8_LDA(At, 1, 1); PG8_STAGE(PG8_SB(1, 0), b3, voffB); PG8_STAGE(PG8_SB(1, 1), b3 + hstepB, voffB); PG8_STAGE(PG8_SA(1, 0), a3, voffA);
            PG8_WAIT_V(8); PG8_WAIT_L(0); PG8_BAR; PG8_MMA(1, 0, At, B0); PG8_MMA(1, 1, At, B1); PG8_BAR; PG8_SCHED;
            } else {
            PG8_LDB(B0, 0, 0); PG8_SCHED; PG8_LDA(At, 0, 0); PG8_STAGE(PG8_SA(1, 1), a1 + hstepA, voffA);
            PG8_WAIT_L(8); PG8_BAR; PG8_WAIT_L(0); PG8_MMA(0, 0, At, B0); PG8_BAR; PG8_SCHED;
            PG8_LDB(B1, 0, 1); PG8_STAGE(PG8_SB(0, 0), b2, voffB);
            PG8_BAR; PG8_WAIT_L(0); PG8_MMA(0, 1, At, B1); PG8_BAR;
            PG8_LDA(At, 0, 1); PG8_STAGE(PG8_SA(0, 0), a2, voffA);
            PG8_BAR; PG8_WAIT_L(0); PG8_MMA(1, 0, At, B0); PG8_BAR; PG8_SCHED;
            PG8_STAGE(PG8_SB(0, 1), b2 + hstepB, voffB);
            PG8_WAIT_V(6); PG8_BAR; PG8_MMA(1, 1, At, B1); PG8_BAR;
            PG8_LDB(B0, 1, 0); PG8_SCHED; PG8_LDA(At, 1, 0); PG8_STAGE(PG8_SA(0, 1), a2 + hstepA, voffA);
            PG8_WAIT_L(8); PG8_BAR; PG8_WAIT_L(0); PG8_MMA(0, 0, At, B0); PG8_BAR; PG8_SCHED;
            PG8_LDB(B1, 1, 1); PG8_STAGE(PG8_SB(1, 0), b3, voffB);
            PG8_BAR; PG8_WAIT_L(0); PG8_MMA(0, 1, At, B1); PG8_BAR;
            PG8_LDA(At, 1, 1); PG8_STAGE(PG8_SA(1, 0), a3, voffA);
            PG8_BAR; PG8_WAIT_L(0); PG8_MMA(1, 0, At, B0); PG8_BAR; PG8_SCHED;
            PG8_STAGE(PG8_SB(1, 1), b3 + hstepB, voffB);
            PG8_WAIT_V(6); PG8_BAR; PG8_MMA(1, 1, At, B1); PG8_BAR;
            }
        }
        if constexpr (ALIGN_EPI) { if (wr == 0) PG8_BAR; }
        if constexpr (!Epi::AFTER_DRAIN) { E(acc, cur, wr, wc, fr, fq); S.done(cur); }
        if (!has_next) break;
#pragma unroll
        for (int a = 0; a < 2; ++a)
#pragma unroll
            for (int b = 0; b < 2; ++b)
#pragma unroll
                for (int m = 0; m < 4; ++m)
#pragma unroll
                    for (int n = 0; n < 2; ++n) acc[a][b][m][n] = (f32x4){0.f, 0.f, 0.f, 0.f};
        cur = nxt; cA = nA; cB = nB; ++ui;
        if constexpr (ALIGN_EPI) { if (wr == 1) PG8_BAR; }
    }
    PG8_WAIT_V(0);
    if constexpr (!ALIGN_EPI) { if (wr == 0) PG8_BAR; }
    PG8_BAR;
    if constexpr (Epi::AFTER_DRAIN) { E.fused(acc, cur, wr, wc, fr, fq, lds, wid, lane); S.done(cur); }
#undef PG8_SA
#undef PG8_SB
#undef PG8_STAGE
#undef PG8_LDA
#undef PG8_LDB
#undef PG8_MMA
#undef PG8_WAIT_V
#undef PG8_WAIT_L
#undef PG8_BAR
#undef PG8_SCHED
}
}
namespace pg8 {
typedef unsigned u32x2 __attribute__((ext_vector_type(2)));
constexpr int S_ = 16384;
__device__ __forceinline__ float hsum4(f32x4 a) { return (a[0] + a[1]) + (a[2] + a[3]); }
__device__ __forceinline__ float dot4(f32x4 a) { return (a[0] * a[0] + a[1] * a[1]) + (a[2] * a[2] + a[3] * a[3]); }
__device__ __forceinline__ float sumslots(const float* p, int n4) { float s = 0.f; for (int i = 0; i < n4; ++i) s += hsum4(*(const f32x4*)(p + 4 * i)); return s; }
__device__ __forceinline__ u32x4 pack8bf(f32x4 a, f32x4 b) { u32x4 w; w.x = cvt_pk_bf16(a[0], a[1]); w.y = cvt_pk_bf16(a[2], a[3]); w.z = cvt_pk_bf16(b[0], b[1]); w.w = cvt_pk_bf16(b[2], b[3]); return w; }
__device__ __forceinline__ float silu_mul(float g, float u) { const float e = __builtin_amdgcn_exp2f(g * -1.4426950408889634f); return g * __builtin_amdgcn_rcpf(1.f + e) * u; }
__device__ __forceinline__ float sigmoidf_(float z) { const float e = __builtin_amdgcn_exp2f(z * -1.4426950408889634f); return __builtin_amdgcn_rcpf(1.f + e); }
__device__ __forceinline__ f32x4 bf4_lo(u32x2 w) { return (f32x4){__uint_as_float(w.x << 16), __uint_as_float(w.x & 0xffff0000u), __uint_as_float(w.y << 16), __uint_as_float(w.y & 0xffff0000u)}; }

struct EpiSwiglu { static constexpr bool PERM = true, AFTER_DRAIN = false;
    bf16_t* H; const float* rs; int rs_slots; const __attribute__((address_space(3))) float* rt;
    __device__ __forceinline__ void operator()(const f32x4 (&acc)[2][2][4][2], const Unit& u, int wr, int wc, int fr, int fq) const {
        const int row0 = u.pm * BM + wr * 64 + fr, col0 = u.pn * 128 + wc * 32 + 8 * fq;
#pragma unroll
        for (int ai = 0; ai < 2; ++ai)
#pragma unroll
            for (int m = 0; m < 4; ++m) { const int row = row0 + ai * HALF + m * 16;
                const float r = rs_slots ? rt[row & 2047] : rs[row];
                f32x4 h0, h1;
#pragma unroll
                for (int e = 0; e < 4; ++e) { h0[e] = silu_mul(acc[ai][0][m][0][e] * r, acc[ai][1][m][0][e] * r); h1[e] = silu_mul(acc[ai][0][m][1][e] * r, acc[ai][1][m][1][e] * r); }
                *(u32x4*)(H + (size_t)row * 2816 + col0) = pack8bf(h0, h1); }
    }
};
template <bool BASE_BF16> struct EpiResid { static constexpr bool PERM = true, AFTER_DRAIN = false;
    const float* basef; bf16_t* xb; float* ssq; float scale; float pad;
    __device__ __forceinline__ void operator()(const f32x4 (&acc)[2][2][4][2], const Unit& u, int wr, int wc, int fr, int fq) const {
        const int row0 = u.pm * BM + wr * 64 + fr, col0 = u.pn * BM + wc * 32 + 8 * fq;
#pragma unroll
        for (int ai = 0; ai < 2; ++ai)
#pragma unroll
            for (int m = 0; m < 4; ++m) { const int row = row0 + ai * HALF + m * 16; float q = 0.f;
#pragma unroll
                for (int bj = 0; bj < 2; ++bj) { const size_t off = (size_t)row * 1024 + col0 + bj * HALF; f32x4 b0, b1;
                    if (BASE_BF16) { const u32x4 bw = *(const u32x4*)(xb + off); b0 = bf4_lo((u32x2){bw.x, bw.y}); b1 = bf4_lo((u32x2){bw.z, bw.w}); }
                    else { b0 = *(const f32x4*)(basef + off); b1 = *(const f32x4*)(basef + off + 4); }
                    const f32x4 v0 = b0 + acc[ai][bj][m][0] * scale, v1 = b1 + acc[ai][bj][m][1] * scale;
                    *(u32x4*)(xb + off) = pack8bf(v0, v1); q += dot4(v0) + dot4(v1); }
                q += __shfl_xor(q, 16); q += __shfl_xor(q, 32);
                if (fq == 0) ssq[(size_t)row * 16 + u.pn * 4 + wc] = q; }
    }
};
struct EpiProj { static constexpr bool PERM = true, AFTER_DRAIN = false;
    bf16_t* LAT; bf16_t* QKV; const __attribute__((address_space(3))) float* rt; float* ssql; int pn_base; int pad;
    __device__ __forceinline__ void operator()(const f32x4 (&acc)[2][2][4][2], const Unit& u, int wr, int wc, int fr, int fq) const {
        const int pe = u.pn + pn_base, lt = pe - 18; const int row0 = u.pm * BM + wr * 64 + fr; const bool lat = pe >= 18;
        const int t = pe, w = t / 6, cc = (t - w * 6) * 256;
        bf16_t* dst = lat ? LAT + lt * 256 : QKV + (size_t)w * ((size_t)S_ * 1536) + cc; const int ld = lat ? 768 : 1536;
#pragma unroll
        for (int ai = 0; ai < 2; ++ai)
#pragma unroll
            for (int m = 0; m < 4; ++m) { const int row = row0 + ai * HALF + m * 16;
                const float r = rt[row & 2047];
#pragma unroll
                for (int bj = 0; bj < 2; ++bj) { const f32x4 v0 = acc[ai][bj][m][0] * r, v1 = acc[ai][bj][m][1] * r;
                    *(u32x4*)(dst + (size_t)row * ld + bj * HALF + wc * 32 + 8 * fq) = pack8bf(v0, v1);
                    if (lat) { float q = dot4(v0) + dot4(v1); q += __shfl_xor(q, 16); q += __shfl_xor(q, 32); if (fq == 0) ssql[(size_t)row * 32 + lt * 8 + bj * 4 + wc] = q; } } }
    }
};
struct EpiGate { static constexpr bool PERM = true, AFTER_DRAIN = false;
    bf16_t* G; const float* b; const __attribute__((address_space(3))) float* rt;
    __device__ __forceinline__ void operator()(const f32x4 (&acc)[2][2][4][2], const Unit& u, int wr, int wc, int fr, int fq) const {
        const int row0 = u.pm * BM + wr * 64 + fr, col0 = u.pn * BM + wc * 32 + 8 * fq;
#pragma unroll
        for (int ai = 0; ai < 2; ++ai)
#pragma unroll
            for (int m = 0; m < 4; ++m) { const int row = row0 + ai * HALF + m * 16;
                const float r = rt[row & 2047];
#pragma unroll
                for (int bj = 0; bj < 2; ++bj) { const f32x4 b0 = *(const f32x4*)(b + col0 + bj * HALF), b1 = *(const f32x4*)(b + col0 + bj * HALF + 4);
                    f32x4 v0 = acc[ai][bj][m][0] * r + b0, v1 = acc[ai][bj][m][1] * r + b1;
#pragma unroll
                    for (int e = 0; e < 4; ++e) { v0[e] = sigmoidf_(v0[e]); v1[e] = sigmoidf_(v1[e]); }
                    *(u32x4*)(G + (size_t)row * 2048 + col0 + bj * HALF) = pack8bf(v0, v1); } }
    }
};
template <bool SECOND> struct EpiMerge { static constexpr bool PERM = true, AFTER_DRAIN = false;
    bf16_t* MG; const bf16_t* G;
    __device__ __forceinline__ void operator()(const f32x4 (&acc)[2][2][4][2], const Unit& u, int wr, int wc, int fr, int fq) const {
        const int row0 = u.pm * BM + wr * 64 + fr, col0 = u.pn * BM + wc * 32 + 8 * fq;
        const __attribute__((address_space(1))) bf16_t* Gg = (const __attribute__((address_space(1))) bf16_t*)G; __attribute__((address_space(1))) bf16_t* Mg = (__attribute__((address_space(1))) bf16_t*)MG;
#pragma unroll
        for (int ai = 0; ai < 2; ++ai) {
            u32x4 gw[4][2], pw[4][2];
#pragma unroll
            for (int m = 0; m < 4; ++m)
#pragma unroll
                for (int bj = 0; bj < 2; ++bj) { const int row = row0 + ai * HALF + m * 16, col = col0 + bj * HALF;
                    gw[m][bj] = *(const __attribute__((address_space(1))) u32x4*)(Gg + (size_t)row * 2048 + (SECOND ? 1024 : 0) + col);
                    if (SECOND) pw[m][bj] = *(const __attribute__((address_space(1))) u32x4*)(Mg + (size_t)row * 1024 + col); }
#pragma unroll
            for (int m = 0; m < 4; ++m)
#pragma unroll
                for (int bj = 0; bj < 2; ++bj) { const int row = row0 + ai * HALF + m * 16, col = col0 + bj * HALF; const u32x4 g4 = gw[m][bj];
                    f32x4 v0 = bf4_lo((u32x2){g4.x, g4.y}) * acc[ai][bj][m][0], v1 = bf4_lo((u32x2){g4.z, g4.w}) * acc[ai][bj][m][1];
                    if (SECOND) { const u32x4 p4 = pw[m][bj]; v0 += bf4_lo((u32x2){p4.x, p4.y}); v1 += bf4_lo((u32x2){p4.z, p4.w}); }
                    *(__attribute__((address_space(1))) u32x4*)(Mg + (size_t)row * 1024 + col) = pack8bf(v0, v1); } }
    }
};
struct EpiQUp { static constexpr bool PERM = false, AFTER_DRAIN = false;
    bf16_t* QF; const __attribute__((address_space(3))) float* rt; const float* cs; const float* sn;
    __device__ __forceinline__ void operator()(const f32x4 (&acc)[2][2][4][2], const Unit& u, int wr, int wc, int fr, int fq) const {
        const int row0 = u.pm * BM + wr * 64 + fr;
#pragma unroll
        for (int ai = 0; ai < 2; ++ai)
#pragma unroll
            for (int m = 0; m < 4; ++m) { const int row = row0 + ai * HALF + m * 16;
                const float r = rt[row & 2047];
#pragma unroll
                for (int bj = 0; bj < 2; ++bj) { const int cg = u.pn * BM + bj * HALF + wc * 32; const bool rope = (cg % 96) == 64;
                    f32x4 x1 = acc[ai][bj][m][0] * r, x2 = acc[ai][bj][m][1] * r;
                    if (rope) { const f32x4 c = *(const f32x4*)(cs + (size_t)row * 16 + 4 * fq), s = *(const f32x4*)(sn + (size_t)row * 16 + 4 * fq);
                        const f32x4 y1 = x1 * c - x2 * s, y2 = x1 * s + x2 * c; x1 = y1; x2 = y2; }
                    u32x2 w1, w2; w1.x = cvt_pk_bf16(x1[0], x1[1]); w1.y = cvt_pk_bf16(x1[2], x1[3]); w2.x = cvt_pk_bf16(x2[0], x2[1]); w2.y = cvt_pk_bf16(x2[2], x2[3]);
                    const bool oddq = (fq & 1) != 0; const u32x2 snd = oddq ? w1 : w2; u32x2 rcv; rcv.x = (unsigned)__shfl_xor((int)snd.x, 16); rcv.y = (unsigned)__shfl_xor((int)snd.y, 16);
                    const u32x4 ov = oddq ? (u32x4){rcv.x, rcv.y, w2.x, w2.y} : (u32x4){w1.x, w1.y, rcv.x, rcv.y};
                    *(u32x4*)(QF + (size_t)row * 768 + cg + 4 * fq + (oddq ? 12 : 0)) = ov; }
                asm volatile("" ::: "memory"); }
    }
};
struct EpiKVUp { static constexpr bool PERM = true, AFTER_DRAIN = false;
    bf16_t* KF; bf16_t* VV; const __attribute__((address_space(3))) float* rt;
    __device__ __forceinline__ void operator()(const f32x4 (&acc)[2][2][4][2], const Unit& u, int wr, int wc, int fr, int fq) const {
        const int row0 = u.pm * BM + wr * 64 + fr;
#pragma unroll
        for (int ai = 0; ai < 2; ++ai)
#pragma unroll
            for (int m = 0; m < 4; ++m) { const int row = row0 + ai * HALF + m * 16;
                const float r = rt[row & 2047];
#pragma unroll
                for (int bj = 0; bj < 2; ++bj) { const int h = u.pn * 2 + bj, d = wc * 32 + 8 * fq;
                    bf16_t* dst = (wc < 2) ? KF + (size_t)row * 768 + h * 96 + d : VV + (size_t)row * 512 + h * 64 + (d - 64);
                    *(u32x4*)dst = pack8bf(acc[ai][bj][m][0] * r, acc[ai][bj][m][1] * r); }
                asm volatile("" ::: "memory"); }
    }
};
#define PGAS __attribute__((address_space(1)))
struct EpiFinal { static constexpr bool PERM = true, AFTER_DRAIN = false;
    const PGAS bf16_t* base; PGAS float* out; const PGAS float* gfin; unsigned* slots; unsigned* cnt; float scale; float pad;
    __device__ __forceinline__ void operator()(f32x4 (&acc)[2][2][4][2], const Unit& u, int wr, int wc, int fr, int fq) const {
        const int row0 = u.pm * BM + wr * 64 + fr, col0 = u.pn * BM + wc * 32 + 8 * fq;
        { u32x4 bw[2][4][2];
#pragma unroll
          for (int ai = 0; ai < 2; ++ai)
#pragma unroll
            for (int m = 0; m < 4; ++m)
#pragma unroll
                for (int bj = 0; bj < 2; ++bj) bw[ai][m][bj] = *(const PGAS u32x4*)(base + (size_t)(row0 + ai * HALF + m * 16) * 1024 + col0 + bj * HALF);
#pragma unroll
          for (int ai = 0; ai < 2; ++ai)
#pragma unroll
            for (int m = 0; m < 4; ++m) { const int row = row0 + ai * HALF + m * 16; float q = 0.f;
#pragma unroll
                for (int bj = 0; bj < 2; ++bj) { const u32x4 w = bw[ai][m][bj];
                    const f32x4 v0 = bf4_lo((u32x2){w.x, w.y}) + acc[ai][bj][m][0] * scale, v1 = bf4_lo((u32x2){w.z, w.w}) + acc[ai][bj][m][1] * scale;
                    acc[ai][bj][m][0] = v0; acc[ai][bj][m][1] = v1; q += dot4(v0) + dot4(v1); }
                q += __shfl_xor(q, 16); q += __shfl_xor(q, 32);
                if (fq == 0) __hip_atomic_store(slots + (size_t)row * 16 + u.pn * 4 + wc, __float_as_uint(q), __ATOMIC_RELAXED, __HIP_MEMORY_SCOPE_AGENT); } }
        asm volatile("s_waitcnt vmcnt(0)" ::: "memory");
        unsigned* c = cnt + 64 * u.pm;
        if (fr == 0 && fq == 0) __hip_atomic_fetch_add(c, 1u, __ATOMIC_RELAXED, __HIP_MEMORY_SCOPE_AGENT);
        { unsigned sp = 0; while ((unsigned)__builtin_amdgcn_readfirstlane(__hip_atomic_load(c, __ATOMIC_RELAXED, __HIP_MEMORY_SCOPE_AGENT)) < 32u) { __builtin_amdgcn_s_sleep(2); if (++sp > (1u << 22)) break; } }
        asm volatile("" ::: "memory");
        unsigned long long sw[2][4][2];
#pragma unroll
        for (int ai = 0; ai < 2; ++ai)
#pragma unroll
            for (int m = 0; m < 4; ++m) { const unsigned long long* sl = (const unsigned long long*)(slots + (size_t)(row0 + ai * HALF + m * 16) * 16 + 4 * fq);
                sw[ai][m][0] = __hip_atomic_load(sl, __ATOMIC_RELAXED, __HIP_MEMORY_SCOPE_AGENT); sw[ai][m][1] = __hip_atomic_load(sl + 1, __ATOMIC_RELAXED, __HIP_MEMORY_SCOPE_AGENT); }
#pragma unroll
        for (int ai = 0; ai < 2; ++ai)
#pragma unroll
            for (int m = 0; m < 4; ++m) { const int row = row0 + ai * HALF + m * 16;
                float ss = (__uint_as_float((unsigned)sw[ai][m][0]) + __uint_as_float((unsigned)(sw[ai][m][0] >> 32))) + (__uint_as_float((unsigned)sw[ai][m][1]) + __uint_as_float((unsigned)(sw[ai][m][1] >> 32)));
                ss += __shfl_xor(ss, 16); ss += __shfl_xor(ss, 32);
                const float r = rsqrtf(ss * (1.f / 1024.f) + 1e-6f);
#pragma unroll
                for (int bj = 0; bj < 2; ++bj) { const size_t off = (size_t)row * 1024 + col0 + bj * HALF;
                    const f32x4 g0 = *(const PGAS f32x4*)(gfin + col0 + bj * HALF), g1 = *(const PGAS f32x4*)(gfin + col0 + bj * HALF + 4);
                    *(PGAS f32x4*)(out + off) = acc[ai][bj][m][0] * r * g0; *(PGAS f32x4*)(out + off + 4) = acc[ai][bj][m][1] * r * g1; } }
    }
};
}

namespace mla {
#define MLAS __attribute__((address_space(3)))
#define MGAS __attribute__((address_space(1)))
constexpr int NW = 8, QBLK = 32, KVBLK = 64, QB = NW * QBLK, QS = 768, KS = 768, VS = 512, OS = 512, NSTEP = 6;
constexpr int SHM_V = KVBLK * 64 * 2, SHM_K = KVBLK * 256;
constexpr int LDS_BYTES = 2 * SHM_V + 2 * SHM_K + NW * 64 * 4;
constexpr float SCALE = 0.10206207261596575f, THR = 8.f;
constexpr unsigned WIN = 0x40000000u;
typedef short bf16x8 __attribute__((ext_vector_type(8)));
typedef short s16x4 __attribute__((ext_vector_type(4)));
typedef float f32x16 __attribute__((ext_vector_type(16)));
typedef unsigned u32x4 __attribute__((ext_vector_type(4)));
#define MLA_KSWZ(row, colB) ((row) * 256 + ((colB) ^ (((row) & 7) << 4)))
#define MLA_SBAR() __builtin_amdgcn_sched_barrier(0)
__device__ __forceinline__ int v_st(int k, int c) { const int kk = (k & ~0xC) | ((k & 4) << 1) | ((k & 8) >> 1); return ((kk >> 3) * 2 + (c >> 5)) * 512 + ((kk & 7) * 32 + (c & 31)) * 2; }
__device__ __forceinline__ int v_rd_base(int lane) { return ((lane & 3) << 3) | (((lane >> 2) & 3) << 6) | (((lane >> 4) & 1) << 5) | (((lane >> 5) & 1) << 8); }
__device__ __forceinline__ int crow(int r, int hi) { return (r & 3) + 8 * (r >> 2) + 4 * hi; }
__device__ __forceinline__ unsigned cvtpk(float lo, float hi) { unsigned r; asm volatile("v_cvt_pk_bf16_f32 %0, %1, %2" : "=v"(r) : "v"(lo), "v"(hi)); return r; }
__device__ __forceinline__ void mask_tile(f32x16& p0, f32x16& p1, int dq) {
    const float NEG = -__builtin_inff();
#pragma unroll
    for (int r = 0; r < 16; ++r) { const int c = (r & 3) + 8 * (r >> 2);
        if ((unsigned)(dq - c) >= WIN) p0[r] = NEG;
        if ((unsigned)(dq - c - 32) >= WIN) p1[r] = NEG; }
}
__device__ __forceinline__ void partialSM(f32x16& p0, f32x16& p1, float& m_reg, float& mn, float& alpha) {
    float pm_[4] = {p0[0], p0[1], p0[2], p0[3]};
#pragma unroll
    for (int r = 4; r < 16; ++r) pm_[r & 3] = fmaxf(pm_[r & 3], p0[r]);
#pragma unroll
    for (int r = 0; r < 16; ++r) pm_[r & 3] = fmaxf(pm_[r & 3], p1[r]);
    float pmax = fmaxf(fmaxf(pm_[0], pm_[1]), fmaxf(pm_[2], pm_[3]));
    { auto rr = __builtin_amdgcn_permlane32_swap(__float_as_uint(pmax), __float_as_uint(pmax), false, false);
      pmax = fmaxf(__uint_as_float(rr[0]), __uint_as_float(rr[1])); }
    constexpr float C2 = 1.4426950408889634f * SCALE;
    if (__builtin_expect(__all((pmax - m_reg) * SCALE <= THR), 1)) { mn = m_reg; alpha = 1.f; }
    else { mn = fmaxf(m_reg, pmax); alpha = __builtin_amdgcn_exp2f((m_reg - mn) * C2); m_reg = mn; }
    const float mnL = -mn * C2;
#pragma unroll
    for (int r = 0; r < 16; ++r) p0[r] = fmaf(p0[r], C2, mnL);
#pragma unroll
    for (int r = 0; r < 16; ++r) p1[r] = fmaf(p1[r], C2, mnL);
#pragma unroll
    for (int r = 0; r < 16; ++r) p0[r] = __builtin_amdgcn_exp2f(p0[r]);
}
__device__ __forceinline__ void finishSM(f32x16& p0, f32x16& p1, float alpha, float& l_reg, bf16x8& pa0, bf16x8& pa1, bf16x8& pa2, bf16x8& pa3) {
#pragma unroll
    for (int r = 0; r < 16; ++r) p1[r] = __builtin_amdgcn_exp2f(p1[r]);
    float ps_[4] = {0.f, 0.f, 0.f, 0.f};
#pragma unroll
    for (int r = 0; r < 16; ++r) ps_[r & 3] += p0[r];
#pragma unroll
    for (int r = 0; r < 16; ++r) ps_[r & 3] += p1[r];
    float ps = (ps_[0] + ps_[1]) + (ps_[2] + ps_[3]);
    { auto rr = __builtin_amdgcn_permlane32_swap(__float_as_uint(ps), __float_as_uint(ps), false, false);
      ps = __uint_as_float(rr[0]) + __uint_as_float(rr[1]); }
    l_reg = l_reg * alpha + ps;
#define MLA_PK4(P, B_, OUT) do { unsigned a0 = cvtpk(P[B_+0], P[B_+1]), a1 = cvtpk(P[B_+2], P[B_+3]);                          \
        unsigned b0 = cvtpk(P[B_+4], P[B_+5]), b1 = cvtpk(P[B_+6], P[B_+7]);                                             \
        auto r0 = __builtin_amdgcn_permlane32_swap(a0, b0, false, false); auto r1 = __builtin_amdgcn_permlane32_swap(a1, b1, false, false); \
        u32x4 w = {r0[0], r1[0], r0[1], r1[1]}; OUT = *reinterpret_cast<bf16x8*>(&w); } while (0)
    MLA_PK4(p0, 0, pa0); MLA_PK4(p0, 8, pa1); MLA_PK4(p1, 0, pa2); MLA_PK4(p1, 8, pa3);
#undef MLA_PK4
}
template <int KB>
__device__ __forceinline__ void qkt(f32x16& p0, f32x16& p1, const MLAS char* K_lds, int r32, int hi, const bf16x8* qr) {
    p0 = f32x16{}; p1 = f32x16{};
    const MLAS char* kb[4];
#pragma unroll
    for (int dd = 0; dd < 4; ++dd) kb[dd] = K_lds + KB * SHM_K + MLA_KSWZ(r32, (dd * 16 + hi * 8) * 2);
#pragma unroll
    for (int d0 = 0; d0 < NSTEP; ++d0) { const MLAS char* a = kb[d0 & 3] + (d0 >> 2) * 128;
        bf16x8 b0 = *(const MLAS bf16x8*)(a);
        bf16x8 b1 = *(const MLAS bf16x8*)(a + 32 * 256);
        p0 = __builtin_amdgcn_mfma_f32_32x32x16_bf16(b0, qr[d0], p0, 0, 0, 0);
        p1 = __builtin_amdgcn_mfma_f32_32x32x16_bf16(b1, qr[d0], p1, 0, 0, 0);
        if (d0 == 2) __builtin_amdgcn_sched_barrier(0); }
}
template <int VB>
__device__ __forceinline__ void pv_tile(f32x16* o, int vb0, bf16x8 pa0, bf16x8 pa1, bf16x8 pa2, bf16x8 pa3) {
#define MLA_TRRD(dst, off) asm volatile("ds_read_b64_tr_b16 %0, %1 offset:%2" : "=&v"(dst) : "v"(vb0), "i"(off) : "memory")
#define MLA_PV_D0(d0) do { s16x4 l0, l1, l2, l3, h0, h1, h2, h3; constexpr int b_ = VB * SHM_V + (d0) * 512;     \
        MLA_TRRD(l0, b_); MLA_TRRD(h0, b_ + 1024); MLA_TRRD(l1, b_ + 2048); MLA_TRRD(h1, b_ + 3072); MLA_TRRD(l2, b_ + 4096); MLA_TRRD(h2, b_ + 5120); MLA_TRRD(l3, b_ + 6144); MLA_TRRD(h3, b_ + 7168); \
        asm volatile("s_waitcnt lgkmcnt(0)" ::: "memory"); MLA_SBAR();   \
        o[d0] = __builtin_amdgcn_mfma_f32_32x32x16_bf16(pa0, (bf16x8){l0[0], l0[1], l0[2], l0[3], h0[0], h0[1], h0[2], h0[3]}, o[d0], 0, 0, 0);   \
        o[d0] = __builtin_amdgcn_mfma_f32_32x32x16_bf16(pa1, (bf16x8){l1[0], l1[1], l1[2], l1[3], h1[0], h1[1], h1[2], h1[3]}, o[d0], 0, 0, 0);   \
        o[d0] = __builtin_amdgcn_mfma_f32_32x32x16_bf16(pa2, (bf16x8){l2[0], l2[1], l2[2], l2[3], h2[0], h2[1], h2[2], h2[3]}, o[d0], 0, 0, 0);   \
        o[d0] = __builtin_amdgcn_mfma_f32_32x32x16_bf16(pa3, (bf16x8){l3[0], l3[1], l3[2], l3[3], h3[0], h3[1], h3[2], h3[3]}, o[d0], 0, 0, 0); } while (0)
    MLA_PV_D0(0); MLA_PV_D0(1);
#undef MLA_PV_D0
#undef MLA_TRRD
}
__device__ __forceinline__ void qkt_rt(f32x16& p0, f32x16& p1, const MLAS char* K_s, int r32, int hi, const bf16x8* qr) {
    p0 = f32x16{}; p1 = f32x16{};
    const MLAS char* kb[6];
#pragma unroll
    for (int d0 = 0; d0 < 6; ++d0) kb[d0] = K_s + r32 * 256 + (((2 * d0 + hi) ^ (r32 & 15)) << 4);
    bf16x8 f0[3], f1[3], g0[3], g1[3];
#pragma unroll
    for (int d0 = 0; d0 < 3; ++d0) { const MLAS char* a = kb[d0]; f0[d0] = *(const MLAS bf16x8*)(a); f1[d0] = *(const MLAS bf16x8*)(a + 32 * 256); }
    __builtin_amdgcn_sched_barrier(0);
#pragma unroll
    for (int d0 = 3; d0 < 6; ++d0) { const MLAS char* a = kb[d0]; g0[d0 - 3] = *(const MLAS bf16x8*)(a); g1[d0 - 3] = *(const MLAS bf16x8*)(a + 32 * 256); }
#pragma unroll
    for (int d0 = 0; d0 < 3; ++d0) { p0 = __builtin_amdgcn_mfma_f32_32x32x16_bf16(f0[d0], qr[d0], p0, 0, 0, 0); p1 = __builtin_amdgcn_mfma_f32_32x32x16_bf16(f1[d0], qr[d0], p1, 0, 0, 0); }
    __builtin_amdgcn_sched_barrier(0);
#pragma unroll
    for (int d0 = 3; d0 < 6; ++d0) { p0 = __builtin_amdgcn_mfma_f32_32x32x16_bf16(g0[d0 - 3], qr[d0], p0, 0, 0, 0); p1 = __builtin_amdgcn_mfma_f32_32x32x16_bf16(g1[d0 - 3], qr[d0], p1, 0, 0, 0); }
}
__device__ __forceinline__ void pv_rt(f32x16* o, int vb, bf16x8 pa0, bf16x8 pa1, bf16x8 pa2, bf16x8 pa3) {
#define MLA_TRRD(dst, off) asm volatile("ds_read_b64_tr_b16 %0, %1 offset:%2" : "=&v"(dst) : "v"(vb), "i"(off) : "memory")
    s16x4 l0, l1, l2, l3, h0, h1, h2, h3, m0, m1, m2, m3, n0, n1, n2, n3;
    MLA_TRRD(l0, 0); MLA_TRRD(h0, 1024); MLA_TRRD(l1, 2048); MLA_TRRD(h1, 3072); MLA_TRRD(l2, 4096); MLA_TRRD(h2, 5120); MLA_TRRD(l3, 6144); MLA_TRRD(h3, 7168);
    MLA_TRRD(m0, 512); MLA_TRRD(n0, 1536); MLA_TRRD(m1, 2560); MLA_TRRD(n1, 3584); MLA_TRRD(m2, 4608); MLA_TRRD(n2, 5632); MLA_TRRD(m3, 6656); MLA_TRRD(n3, 7680);
    asm volatile("s_waitcnt lgkmcnt(8)" ::: "memory"); MLA_SBAR();
    o[0] = __builtin_amdgcn_mfma_f32_32x32x16_bf16(pa0, (bf16x8){l0[0], l0[1], l0[2], l0[3], h0[0], h0[1], h0[2], h0[3]}, o[0], 0, 0, 0);
    o[0] = __builtin_amdgcn_mfma_f32_32x32x16_bf16(pa1, (bf16x8){l1[0], l1[1], l1[2], l1[3], h1[0], h1[1], h1[2], h1[3]}, o[0], 0, 0, 0);
    o[0] = __builtin_amdgcn_mfma_f32_32x32x16_bf16(pa2, (bf16x8){l2[0], l2[1], l2[2], l2[3], h2[0], h2[1], h2[2], h2[3]}, o[0], 0, 0, 0);
    o[0] = __builtin_amdgcn_mfma_f32_32x32x16_bf16(pa3, (bf16x8){l3[0], l3[1], l3[2], l3[3], h3[0], h3[1], h3[2], h3[3]}, o[0], 0, 0, 0);
    asm volatile("s_waitcnt lgkmcnt(0)" ::: "memory"); MLA_SBAR();
    o[1] = __builtin_amdgcn_mfma_f32_32x32x16_bf16(pa0, (bf16x8){m0[0], m0[1], m0[2], m0[3], n0[0], n0[1], n0[2], n0[3]}, o[1], 0, 0, 0);
    o[1] = __builtin_amdgcn_mfma_f32_32x32x16_bf16(pa1, (bf16x8){m1[0], m1[1], m1[2], m1[3], n1[0], n1[1], n1[2], n1[3]}, o[1], 0, 0, 0);
    o[1] = __builtin_amdgcn_mfma_f32_32x32x16_bf16(pa2, (bf16x8){m2[0], m2[1], m2[2], m2[3], n2[0], n2[1], n2[2], n2[3]}, o[1], 0, 0, 0);
    o[1] = __builtin_amdgcn_mfma_f32_32x32x16_bf16(pa3, (bf16x8){m3[0], m3[1], m3[2], m3[3], n3[0], n3[1], n3[2], n3[3]}, o[1], 0, 0, 0);
#undef MLA_TRRD
}
struct BlockRef { const MGAS bf16_t* Q; const MGAS bf16_t* K; const MGAS bf16_t* V; MGAS bf16_t* O; int P0; };
constexpr int KRING = 0, VRING = 3 * SHM_K, WSF_OFF = VRING + 4 * SHM_V, LDS_BYTES2 = WSF_OFF + NW * 64 * 4;
#define MLA_VMC(n) asm volatile("s_waitcnt vmcnt(" #n ")" ::: "memory")
#define MLA_BARX() asm volatile("s_waitcnt lgkmcnt(0)\n\ts_barrier" ::: "memory")
__device__ __forceinline__ void block2(const BlockRef& cur, MLAS char* lds, int wid, int lane) {
    const int r32 = lane & 31, hi = lane >> 5;
    const int NT = (cur.P0 + QB - 1) / KVBLK + 1;
    const int qlo = cur.P0 + wid * QBLK, qm = qlo + r32 - 4 * hi;
    MLAS char* K_lds = lds + KRING; MLAS char* V_lds = lds + VRING;
    MLAS float* wsf = (MLAS float*)(lds + WSF_OFF) + wid * 64; MLAS float* li_l = wsf; MLAS float* al_l = wsf + 32;
    unsigned kso[2];
#pragma unroll
    for (int i = 0; i < 2; ++i) { const int row = 4 * (2 * wid + i) + (lane >> 4), c = (lane & 15) ^ (row & 15), ce = c < 12 ? c : c - 4; kso[i] = (unsigned)(row * KS * 2 + ce * 16); }
    unsigned vso; { const int kk = wid * 8 + ((lane & 31) >> 2), k = (kk & ~0xC) | ((kk & 4) << 1) | ((kk & 8) >> 1), c = (lane >> 5) * 32 + (lane & 3) * 8; vso = (unsigned)(k * VS * 2 + c * 2); }
    const MGAS char* Kb = (const MGAS char*)cur.K; const MGAS char* Vb = (const MGAS char*)cur.V;
#define MLA_DMA(t, koff, voff) do { const MGAS char* kt_ = Kb + (size_t)(t) * (KVBLK * KS * 2); const MGAS char* vt_ = Vb + (size_t)(t) * (KVBLK * VS * 2);          \
        __builtin_amdgcn_global_load_lds((const MGAS unsigned*)(kt_ + kso[0]), (MLAS unsigned*)(K_lds + (koff) + (2 * wid) * 1024), 16, 0, 0);                          \
        __builtin_amdgcn_global_load_lds((const MGAS unsigned*)(kt_ + kso[1]), (MLAS unsigned*)(K_lds + (koff) + (2 * wid + 1) * 1024), 16, 0, 0);                      \
        __builtin_amdgcn_global_load_lds((const MGAS unsigned*)(vt_ + vso), (MLAS unsigned*)(V_lds + (voff) + wid * 1024), 16, 0, 0); } while (0)
    bf16x8 qr[NSTEP];
#pragma unroll
    for (int d0 = 0; d0 < NSTEP; ++d0) qr[d0] = *(const MGAS bf16x8*)(cur.Q + (size_t)(wid * QBLK + r32) * QS + d0 * 16 + hi * 8);
    float m_reg = -1e30f, l_reg = 0; f32x16 o[2] = {};
    const int vb0 = (int)(unsigned)(__UINTPTR_TYPE__)V_lds + v_rd_base(lane);
#define MLA_RESC(a) do { if (__any((a) < 1.f)) { if (hi == 0) al_l[r32] = (a); asm volatile("s_waitcnt lgkmcnt(0)" ::: "memory");              \
                     _Pragma("unroll") for (int d_ = 0; d_ < 2; ++d_) _Pragma("unroll") for (int r = 0; r < 16; ++r) o[d_][r] *= al_l[crow(r, hi)]; } } while (0)
#define MLA_MASKT(P0_, P1_, t) do { const int kb_ = (t) * KVBLK; if (__builtin_expect(__builtin_amdgcn_readfirstlane((int)(kb_ + KVBLK - 1 > qlo)) != 0, 0)) { asm volatile("" ::: "memory"); mask_tile(P0_, P1_, qm - kb_); } } while (0)
    f32x16 pA0, pA1, pB0, pB1; float mnA, mnB, alA, alB; bf16x8 pa0, pa1, pa2, pa3;
    int kc = 0, vc = 0;
#define MLA_KNEXT(x) ((x) == 2 * SHM_K ? 0 : (x) + SHM_K)
#define MLA_VNEXT(x) (((x) + SHM_V) & (4 * SHM_V - 1))
    MLA_DMA(0, 0, 0); MLA_DMA(1, SHM_K, SHM_V);
    MLA_VMC(3); MLA_BARX();
    MLA_SBAR(); qkt_rt(pA0, pA1, K_lds + kc, r32, hi, qr);
    MLA_MASKT(pA0, pA1, 0); partialSM(pA0, pA1, m_reg, mnA, alA);
    MLA_DMA(2, 2 * SHM_K, 2 * SHM_V);
    MLA_RESC(alA);
    MLA_VMC(3); MLA_BARX();
#define MLA_STEP(PX0, PX1, mnX, alX, PY0, PY1, alY, t) do {                                                                        \
        const int kp_ = kc, vp_ = vc; kc = MLA_KNEXT(kc); vc = MLA_VNEXT(vc);                \
        MLA_SBAR(); qkt_rt(PX0, PX1, K_lds + kc, r32, hi, qr);                                                                    \
        finishSM(PY0, PY1, alY, l_reg, pa0, pa1, pa2, pa3); MLA_SBAR();                                                            \
        pv_rt(o, vb0 + vp_, pa0, pa1, pa2, pa3); MLA_MASKT(PX0, PX1, (t)); partialSM(PX0, PX1, m_reg, mnX, alX);                    \
        if ((t) + 2 < NT) { MLA_DMA((t) + 2, kp_, MLA_VNEXT(MLA_VNEXT(vc))); }              \
        MLA_RESC(alX);                                                                                                             \
        if ((t) + 1 < NT) { if ((t) + 2 < NT) MLA_VMC(3); else MLA_VMC(0); MLA_BARX(); } } while (0)
    int t = 1;
    for (; t + 1 < NT; t += 2) {
        MLA_STEP(pB0, pB1, mnB, alB, pA0, pA1, alA, t);
        MLA_STEP(pA0, pA1, mnA, alA, pB0, pB1, alB, t + 1);
    }
    MLA_STEP(pB0, pB1, mnB, alB, pA0, pA1, alA, NT - 1);
    MLA_SBAR(); finishSM(pB0, pB1, alB, l_reg, pa0, pa1, pa2, pa3); MLA_SBAR(); pv_rt(o, vb0 + vc, pa0, pa1, pa2, pa3);
    if (hi == 0) li_l[r32] = l_reg; asm volatile("s_waitcnt lgkmcnt(0)" ::: "memory");
    MGAS bf16_t* Ow = cur.O + (size_t)(wid * QBLK) * OS;
#pragma unroll
    for (int r = 0; r < 16; ++r) { const int orow = crow(r, hi); const float rl = __builtin_amdgcn_rcpf(li_l[orow]);
#pragma unroll
        for (int d0 = 0; d0 < 2; ++d0) { const float v = o[d0][r] * rl; const float vn = __shfl_xor(v, 1);
            if ((r32 & 1) == 0) *(MGAS unsigned*)(Ow + (size_t)orow * OS + d0 * 32 + r32) = cvtpk(v, vn); } }
    MLA_BARX();
#undef MLA_RESC
#undef MLA_MASKT
#undef MLA_STEP
#undef MLA_DMA
}
constexpr int K5_SLOT = 16384, V5_SLOT = 8192, L5_K = 0, L5_V = 4 * K5_SLOT, L5_WS = L5_V + 4 * V5_SLOT, L5_OST = L5_WS + NW * 256, L5_BYTES = L5_OST + NW * 4096;
constexpr float THR5 = 8.f;
typedef const MLAS char* lcp;
typedef short v4i16_t __attribute__((ext_vector_type(4)));
__device__ __forceinline__ s16x4 vtr5(lcp p) { return __builtin_bit_cast(s16x4, __builtin_amdgcn_ds_read_tr16_b64_v4i16((MLAS v4i16_t*)p)); }
__device__ __forceinline__ unsigned cvtpk5(float lo, float hi) { unsigned r; asm("v_cvt_pk_bf16_f32 %0, %1, %2" : "=v"(r) : "v"(lo), "v"(hi)); return r; }
#define MX3(a, b, c) __builtin_fmaxf(__builtin_fmaxf((a), (b)), (c))
__device__ __forceinline__ float halfmax5(const f32x16& p0, const f32x16& p1) {
    float a = MX3(p0[0], p0[1], p1[0]), b = MX3(p0[2], p0[3], p1[1]); a = MX3(a, p1[2], p1[3]);
#pragma unroll
    for (int r = 4; r < 16; r += 4) { a = MX3(a, p0[r], p0[r + 1]); b = MX3(b, p0[r + 2], p0[r + 3]); a = MX3(a, p1[r], p1[r + 1]); b = MX3(b, p1[r + 2], p1[r + 3]); }
    return __builtin_fmaxf(a, b); }
__device__ __forceinline__ float mergehalves5(float m) { auto rr = __builtin_amdgcn_permlane32_swap(__float_as_uint(m), __float_as_uint(m), false, false);
    return __builtin_fmaxf(__uint_as_float(rr[0]), __uint_as_float(rr[1])); }
__device__ __forceinline__ float rowmax5(const f32x16& p0, const f32x16& p1) { return mergehalves5(halfmax5(p0, p1)); }
#undef MX3
__device__ __forceinline__ void cmask5(f32x16& p0, f32x16& p1, int jb, int qrel, int hi) {
    int dq = qrel - 64 * jb - 4 * hi; asm volatile("" : "+v"(dq)); const float NEG = -__builtin_inff();
#pragma unroll
    for (int r = 0; r < 16; ++r) { const int c = (r & 3) + 8 * (r >> 2); if (c > dq) p0[r] = NEG; if (c + 32 > dq) p1[r] = NEG; } }
__device__ __forceinline__ void block5(const BlockRef& cur, MLAS char* lds, int wid, int lane) {
    asm volatile("" : "+v"(lane));
    const int r32 = lane & 31, hi = lane >> 5;
    const int q0 = cur.P0, NT = (q0 + QB) / KVBLK;
    MLAS float* wsf = (MLAS float*)(lds + L5_WS) + wid * 64;
    unsigned kso[2];
#pragma unroll
    for (int i = 0; i < 2; ++i) { const int row = 4 * (2 * wid + i) + (lane >> 4), c = (lane & 15) ^ (row & 15), ce = c < 12 ? c : c - 4; kso[i] = (unsigned)(row * KS * 2 + ce * 16); }
    const unsigned vso = (unsigned)(((16 * (wid & 3) + (lane >> 2)) * VS + (wid >> 2) * 32 + (lane & 3) * 8) * 2);
    const MGAS char* Kb = (const MGAS char*)cur.K; const MGAS char* Vb = (const MGAS char*)cur.V;
    const unsigned ldsa = (unsigned)(__UINTPTR_TYPE__)lds;
#define GLDS16(base, off, la) do { unsigned sv_; asm volatile("s_mov_b32 %0, m0\n\ts_mov_b32 m0, %3\n\ts_nop 0\n\tglobal_load_lds_dwordx4 %1, %2\n\ts_mov_b32 m0, %0" : "=&s"(sv_) : "v"(off), "s"(base), "s"(la) : "memory"); } while (0)
#define DMA_K(t, slot) do { const MGAS char* kt_ = Kb + (size_t)(t) * (KVBLK * KS * 2); const unsigned la_ = (unsigned)__builtin_amdgcn_readfirstlane((int)(ldsa + L5_K + (slot) + (2 * wid) * 1024));  \
        GLDS16(kt_, kso[0], la_); GLDS16(kt_, kso[1], la_ + 1024u); } while (0)
#define DMA_V(t, slot) do { const MGAS char* vt_ = Vb + (size_t)(t) * (KVBLK * VS * 2); const unsigned la_ = (unsigned)__builtin_amdgcn_readfirstlane((int)(ldsa + L5_V + (slot) + wid * 1024));        \
        GLDS16(vt_, vso, la_); } while (0)
#define WAIT_BAR(N) asm volatile("s_waitcnt vmcnt(" #N ") lgkmcnt(0)\n\ts_barrier" ::: "memory")
#define SBAR() __builtin_amdgcn_sched_barrier(0)
#define PIN(x) asm volatile("" : "+v"(x))
#define MFMA(a, b, c) __builtin_amdgcn_mfma_f32_32x32x16_bf16(a, b, c, 0, 0, 0)
    int kofs[6];
#pragma unroll
    for (int d0 = 0; d0 < 6; ++d0) kofs[d0] = r32 * 256 + (((2 * d0 + hi) ^ (r32 & 15)) << 4);
    const lcp kb0 = (lcp)lds + L5_K;
    const lcp vp0 = (lcp)lds + L5_V + ((lane >> 4) & 1) * 32 + (lane & 3) * 8 + (4 * hi + ((lane & 15) >> 2)) * 64;
#define KLD(j, ks) kf[j] = *(const MLAS bf16x8*)(kb0 + (ks) + kofs[(j) >> 1] + ((j) & 1) * 8192)
    DMA_K(0, 0); DMA_V(0, 0); DMA_K(1, K5_SLOT);
    bf16x8 qr[6];
#pragma unroll
    for (int d0 = 0; d0 < 6; ++d0) qr[d0] = *(const MGAS bf16x8*)((const MGAS char*)cur.Q + (unsigned)(((wid * QBLK + r32) * QS + hi * 8) * 2) + d0 * 32);
    float mhat = 0.f, l_reg = 0.f; f32x16 o[2]; o[0] = f32x16{}; o[1] = f32x16{}; f32x16 negm;
    const int qrel = wid * QBLK + r32; bool resc = false;
    f32x16 pA0, pA1, pB0, pB1; bf16x8 kf[12]; s16x4 vlo[8], vhi[8]; u32x4 pw0, pw1, pw2, pw3;
    constexpr bool lag = false;
#define VSL(j) (((j) & 3) * V5_SLOT)
#define RESC() do { if (resc) { _Pragma("unroll") for (int d_ = 0; d_ < 2; ++d_) _Pragma("unroll") for (int r = 0; r < 16; ++r) o[d_][r] *= wsf[crow(r, hi)]; } } while (0)
    DMA_K(2, 2 * K5_SLOT);
    WAIT_BAR(5);
#pragma unroll
    for (int j = 0; j < 12; ++j) KLD(j, 0);
    pA0 = MFMA(kf[0], qr[0], f32x16{}); pA1 = MFMA(kf[1], qr[0], f32x16{});
#pragma unroll
    for (int d0 = 1; d0 < 6; ++d0) { pA0 = MFMA(kf[2 * d0], qr[d0], pA0); pA1 = MFMA(kf[2 * d0 + 1], qr[d0], pA1); }
    if (NT == 4) cmask5(pA0, pA1, 0, qrel, hi);
    { const float rm = rowmax5(pA0, pA1); mhat = rm;
#pragma unroll
      for (int r = 0; r < 16; ++r) { pA0[r] = __builtin_amdgcn_exp2f(pA0[r] - rm); pA1[r] = r < 4 ? __builtin_amdgcn_exp2f(pA1[r] - rm) : pA1[r] - rm; }
#pragma unroll
      for (int r = 0; r < 16; ++r) negm[r] = -mhat;
      PIN(negm); }
    WAIT_BAR(0);
    DMA_K(3, 3 * K5_SLOT); DMA_V(1, VSL(1));
    if (lag) { if (4 < NT) DMA_K(4, 0); DMA_V(2, VSL(2)); }
    KLD(0, K5_SLOT); KLD(1, K5_SLOT); KLD(2, K5_SLOT); KLD(3, K5_SLOT);
#define PKW(P, i) cvtpk5(P[i], P[i + 1])
#define PAF(k) __builtin_bit_cast(bf16x8, pw##k)
#define VFR(i) (bf16x8){vlo[i][0], vlo[i][1], vlo[i][2], vlo[i][3], vhi[i][0], vhi[i][1], vhi[i][2], vhi[i][3]}
#define VRD(i) do { vlo[i] = vtr5(vp_ + (((i) >> 2) * 4096 + ((i) & 3) * 1024)); vhi[i] = vtr5(vp_ + (((i) >> 2) * 4096 + ((i) & 3) * 1024 + 512)); } while (0)
#define EX(v) __builtin_amdgcn_exp2f(v)
#define GAPE(j, MF, P, i) do { KLD((j) + 4, ks_); SBAR(); MF; P[i] = EX(P[i]); P[(i) + 1] = EX(P[(i) + 1]); P[(i) + 2] = EX(P[(i) + 2]); PIN(P); SBAR(); } while (0)
#define GAPA(RD, MF, a0, a1, a2, a3, W0, W1, PW) do { RD; SBAR(); MF; sacc += a0; sacc += a1; sacc += a2; sacc += a3; W0; W1; PIN(PW); PIN(sacc); SBAR(); } while (0)
#define GAPB3(MF, X, i0, Y, i1, Z, i2) do { MF; X[i0] = EX(X[i0]); Y[i1] = EX(Y[i1]); Z[i2] = EX(Z[i2]); PIN(X); PIN(Z); SBAR(); } while (0)
#define GAPB4(MF, X, i) do { MF; X[i] = EX(X[i]); X[(i) + 1] = EX(X[(i) + 1]); X[(i) + 2] = EX(X[(i) + 2]); X[(i) + 3] = EX(X[(i) + 3]); PIN(X); SBAR(); } while (0)
#define KPRE(G, j) do { if (G) { KLD(j, kn_); } } while (0)
#define STEP(C0, C1, P0, P1, t, TS, MASK, GK, GV, GL, GK2, GV2) do { SBAR();                                                                                                                                                           \
    const int ks_ = ((TS) & 3) * K5_SLOT, kn_ = (((TS) + 1) & 3) * K5_SLOT; const lcp vp_ = vp0 + VSL((TS) + 3);                                                                  \
    GAPE(0, C0 = MFMA(kf[0], qr[0], negm), P1, 4);                                                                                                                        \
    GAPE(1, C1 = MFMA(kf[1], qr[0], negm), P1, 7);                                                                                                                        \
    GAPE(2, C0 = MFMA(kf[2], qr[1], C0),   P1, 10);                                                                                                                       \
    GAPE(3, C1 = MFMA(kf[3], qr[1], C1),   P1, 13);                                                                                                                       \
    float sacc = P0[0] + P0[1];                                                                                                                                           \
    GAPA(KLD(8, ks_),  C0 = MFMA(kf[4], qr[2], C0),  P0[2], P0[3], P0[4], P0[5],     pw0[0] = PKW(P0, 0),  pw0[1] = PKW(P0, 2),  pw0);                                     \
    GAPA(KLD(9, ks_),  C1 = MFMA(kf[5], qr[2], C1),  P0[6], P0[7], P0[8], P0[9],     pw0[2] = PKW(P0, 4),  pw0[3] = PKW(P0, 6),  pw0);                                     \
    GAPA(KLD(10, ks_), C0 = MFMA(kf[6], qr[3], C0),  P0[10], P0[11], P0[12], P0[13], pw1[0] = PKW(P0, 8),  pw1[1] = PKW(P0, 10), pw1);                                     \
    GAPA(KLD(11, ks_), C1 = MFMA(kf[7], qr[3], C1),  P0[14], P0[15], P1[0], P1[1],   pw1[2] = PKW(P0, 12), pw1[3] = PKW(P0, 14), pw1);                                     \
    GAPA((void)0,      C0 = MFMA(kf[8], qr[4], C0),  P1[2], P1[3], P1[4], P1[5],     pw2[0] = PKW(P1, 0),  pw2[1] = PKW(P1, 2),  pw2);                                     \
    GAPA((void)0,      C1 = MFMA(kf[9], qr[4], C1),  P1[6], P1[7], P1[8], P1[9],     pw2[2] = PKW(P1, 4),  pw2[3] = PKW(P1, 6),  pw2);                                     \
    GAPA(VRD(0),       C0 = MFMA(kf[10], qr[5], C0), P1[10], P1[11], P1[12], P1[13], pw3[0] = PKW(P1, 8),  pw3[1] = PKW(P1, 10), pw3);                                     \
    GAPA(VRD(4),       C1 = MFMA(kf[11], qr[5], C1), P1[14], P1[15], 0.f, 0.f,       pw3[2] = PKW(P1, 12), pw3[3] = PKW(P1, 14), pw3);                                     \
    l_reg += sacc;                                                                                                                                                        \
    if (!lag) { if (GK) DMA_K((t) + 3, (((TS) + 3) & 3) * K5_SLOT); if (GV) DMA_V((t) + 1, VSL((TS) + 1)); }                                          \
    else { ENDW(t); if (GK2) DMA_K((t) + 4, ((TS) & 3) * K5_SLOT); if (GV2) DMA_V((t) + 2, VSL((TS) + 2)); }                                           \
    VRD(1); VRD(5); SBAR();                                                                                                                                               \
    o[0] = MFMA(PAF(0), VFR(0), o[0]); o[1] = MFMA(PAF(0), VFR(4), o[1]);                                                     \
    if (MASK) cmask5(C0, C1, (t) - (NT - 4), qrel, hi);                                                                                                                   \
    { const float hm = halfmax5(C0, C1); resc = false;                                                                      \
      if (__builtin_expect(__any(hm > THR5), 0)) { const float rm = mergehalves5(hm); const float dl = __builtin_fmaxf(rm, 0.f); mhat += dl;     \
          _Pragma("unroll") for (int r = 0; r < 16; ++r) { C0[r] -= dl; C1[r] -= dl; }                                                                                    \
          _Pragma("unroll") for (int r = 0; r < 16; ++r) negm[r] = -mhat;                                                                                                 \
          PIN(negm);                                                                                                                                                      \
          const float f = __builtin_amdgcn_exp2f(-dl); l_reg *= f; if (hi == 0) wsf[r32] = f; resc = true; } }                                                            \
    SBAR();                                                                                                                                                               \
    VRD(2); KPRE(GL, 0); GAPB4(o[0] = MFMA(PAF(1), VFR(1), o[0]), C0, 0);                                                                                                 \
    VRD(6); KPRE(GL, 1); GAPB4(o[1] = MFMA(PAF(1), VFR(5), o[1]), C0, 4);                                                                                                 \
    VRD(3); KPRE(GL, 2); GAPB3(o[0] = MFMA(PAF(2), VFR(2), o[0]), C0, 8, C0, 9, C0, 10);                                                                                  \
    VRD(7); KPRE(GL, 3); GAPB3(o[1] = MFMA(PAF(2), VFR(6), o[1]), C0, 11, C0, 12, C0, 13);                                                                                \
    GAPB3(o[0] = MFMA(PAF(3), VFR(3), o[0]), C0, 14, C0, 15, C1, 0);                                                                                                      \
    GAPB3(o[1] = MFMA(PAF(3), VFR(7), o[1]), C1, 1, C1, 2, C1, 3);                                                                                                        \
    } while (0)
#define ENDW(tt) do { if ((tt) + 3 < NT) { WAIT_BAR(3); } else if ((tt) + 2 < NT) { WAIT_BAR(1); } else { WAIT_BAR(0); } } while (0)
#define ENDL(tt) do { if (!lag) ENDW(tt); } while (0)
    int t = 1;
    for (; t + 7 < NT; t += 4) {
        STEP(pB0, pB1, pA0, pA1, t,     1, false, true, true, true, true, true); ENDL(t);     RESC();
        STEP(pA0, pA1, pB0, pB1, t + 1, 2, false, true, true, true, true, true); ENDL(t + 1); RESC();
        STEP(pB0, pB1, pA0, pA1, t + 2, 3, false, true, true, true, true, true); ENDL(t + 2); RESC();
        STEP(pA0, pA1, pB0, pB1, t + 3, 0, false, true, true, true, true, true); ENDL(t + 3); RESC();
    }
    for (; t + 1 < NT; t += 2) {
        STEP(pB0, pB1, pA0, pA1, t, t, true, (t + 3 < NT), (t + 1 < NT), (t + 1 < NT), (t + 4 < NT), (t + 2 < NT));                 ENDL(t);     RESC();
        STEP(pA0, pA1, pB0, pB1, t + 1, t + 1, true, (t + 4 < NT), (t + 2 < NT), (t + 2 < NT), (t + 5 < NT), (t + 3 < NT));         ENDL(t + 1); RESC();
    }
    STEP(pB0, pB1, pA0, pA1, NT - 1, NT - 1, true, false, false, false, false, false); ENDL(NT - 1); RESC();
    {
#pragma unroll
      for (int r = 4; r < 16; ++r) pB1[r] = __builtin_amdgcn_exp2f(pB1[r]);
      float sacc = pB0[0] + pB0[1];
#pragma unroll
      for (int r = 2; r < 16; ++r) sacc += pB0[r];
#pragma unroll
      for (int r = 0; r < 16; ++r) sacc += pB1[r];
      l_reg += sacc;
      pw0 = (u32x4){PKW(pB0, 0), PKW(pB0, 2), PKW(pB0, 4), PKW(pB0, 6)}; pw1 = (u32x4){PKW(pB0, 8), PKW(pB0, 10), PKW(pB0, 12), PKW(pB0, 14)};
      pw2 = (u32x4){PKW(pB1, 0), PKW(pB1, 2), PKW(pB1, 4), PKW(pB1, 6)}; pw3 = (u32x4){PKW(pB1, 8), PKW(pB1, 10), PKW(pB1, 12), PKW(pB1, 14)};
      const lcp vp_ = vp0 + VSL(NT - 1);
      VRD(0); VRD(1); VRD(2); VRD(3); VRD(4); VRD(5); VRD(6); VRD(7);
      o[0] = MFMA(PAF(0), VFR(0), o[0]); o[1] = MFMA(PAF(0), VFR(4), o[1]); o[0] = MFMA(PAF(1), VFR(1), o[0]); o[1] = MFMA(PAF(1), VFR(5), o[1]);
      o[0] = MFMA(PAF(2), VFR(2), o[0]); o[1] = MFMA(PAF(2), VFR(6), o[1]); o[0] = MFMA(PAF(3), VFR(3), o[0]); o[1] = MFMA(PAF(3), VFR(7), o[1]); }
    { auto rr = __builtin_amdgcn_permlane32_swap(__float_as_uint(l_reg), __float_as_uint(l_reg), false, false); l_reg = __uint_as_float(rr[0]) + __uint_as_float(rr[1]); }
    if (hi == 0) wsf[32 + r32] = l_reg;
    MGAS bf16_t* Ow = cur.O + (size_t)(wid * QBLK) * OS; MLAS bf16_t* stg = (MLAS bf16_t*)(lds + L5_OST) + wid * 2048;
#pragma unroll
    for (int r = 0; r < 16; ++r) { const int orow = crow(r, hi); const float rl = __builtin_amdgcn_rcpf(wsf[32 + orow]);
#pragma unroll
        for (int d0 = 0; d0 < 2; ++d0) stg[orow * 64 + d0 * 32 + r32] = (bf16_t)cvtpk5(o[d0][r] * rl, 0.f); }
#pragma unroll
    for (int i = 0; i < 4; ++i) { const int row = i * 8 + (lane >> 3), ch = lane & 7; *(MGAS u32x4*)((MGAS char*)Ow + (unsigned)((row * OS + ch * 8) * 2)) = *(const MLAS u32x4*)(stg + row * 64 + ch * 8); }
    asm volatile("s_waitcnt lgkmcnt(0)\n\ts_barrier" ::: "memory");
#undef DMA_K
#undef DMA_V
#undef GLDS16
#undef WAIT_BAR
#undef SBAR
#undef PIN
#undef MFMA
#undef KLD
#undef VSL
#undef ENDL
#undef RESC
#undef PKW
#undef PAF
#undef VFR
#undef VRD
#undef GAPA
#undef GAPE
#undef GAPB3
#undef GAPB4
#undef EX
#undef GAPB
#undef KPRE
#undef STEP
#undef ENDW
}
__device__ __forceinline__ void mla_phase(MLAS char* lds, const bf16_t* QF_, const bf16_t* KF_, const bf16_t* VV_, bf16_t* ATT_, int bx, int nwg, int wid, int lane) {
    const MGAS bf16_t* QF = (const MGAS bf16_t*)QF_; const MGAS bf16_t* KF = (const MGAS bf16_t*)KF_; const MGAS bf16_t* VV = (const MGAS bf16_t*)VV_; MGAS bf16_t* ATT = (MGAS bf16_t*)ATT_;
    for (int item = bx; item < 256; item += nwg) { const int h = item & 7, x = item >> 3;
#pragma unroll 1
        for (int pass = 0; pass < 2; ++pass) { const int qb = pass ? 63 - x : x;
            BlockRef b{QF + (size_t)(qb * QB) * QS + h * 96, KF + h * 96, VV + h * 64, ATT + (size_t)(qb * QB) * OS + h * 64, qb * QB};
            block5(b, lds, wid, lane); }
        asm volatile("s_waitcnt vmcnt(0)" ::: "memory"); __syncthreads(); }
}
}

namespace dil {
#define DLAS __attribute__((address_space(3)))
#define DGAS __attribute__((address_space(1)))
typedef short bf16x8 __attribute__((ext_vector_type(8)));
typedef short s16x4 __attribute__((ext_vector_type(4)));
typedef float f32x16 __attribute__((ext_vector_type(16)));
typedef unsigned u32x4 __attribute__((ext_vector_type(4)));
constexpr int ITEM_LDS = 65536, K_OFF = 0, V_OFF = 32768, BIAS_OFF = 131072, WSF_OFF = 131072 + 2048;
constexpr int LDS_BYTES = WSF_OFF + 8 * 128;
constexpr float LOG2E = 1.4426950408889634f, LN2 = 0.6931471805599453f;
__device__ __forceinline__ int v_st(int k, int c) { const int kk = (k & ~0xC) | ((k & 4) << 1) | ((k & 8) >> 1); return ((kk >> 3) * 2 + (c >> 5)) * 512 + ((kk & 7) * 32 + (c & 31)) * 2; }
__device__ __forceinline__ int v_rd_base(int lane) { return ((lane & 3) << 3) | (((lane >> 2) & 3) << 6) | (((lane >> 4) & 1) << 5) | (((lane >> 5) & 1) << 8); }
__device__ __forceinline__ int crow(int r, int hi) { return (r & 3) + 8 * (r >> 2) + 4 * hi; }
__device__ __forceinline__ unsigned cvtpk(float lo, float hi) { unsigned r; asm volatile("v_cvt_pk_bf16_f32 %0, %1, %2" : "=v"(r) : "v"(lo), "v"(hi)); return r; }
__device__ __forceinline__ int t5b(int dist) { if (dist < 16) return dist; const int large = 16 + (int)(logf((float)dist / 16.f) / 4.852030263919617f * 16.f); return large < 31 ? large : 31; }
struct Item { int hd, r, ph, nbk; };
__device__ __forceinline__ Item decode(int id) { Item it; it.hd = id >> 7; const int blk = id & 127, g = it.hd >> 3; it.r = g == 0 ? 1 : (g == 1 ? 4 : 16);
    const int nblk = 128 / it.r; it.ph = blk / nblk; it.nbk = blk - it.ph * nblk; return it; }

__device__ __forceinline__ void dil_phase(DLAS char* lds, bf16_t* QD_, const bf16_t* KD_, const bf16_t* VD_, const float* rel_bias, float* LSE_, int pr0, int prstep, int prend, int wid, int lane) {
    DGAS bf16_t* QD = (DGAS bf16_t*)QD_; const DGAS bf16_t* KD = (const DGAS bf16_t*)KD_; const DGAS bf16_t* VD = (const DGAS bf16_t*)VD_; DGAS float* LSE = (DGAS float*)LSE_;
    const int tid = wid * 64 + lane, r32 = lane & 31, hi = lane >> 5, w4 = wid & 3, wi = wid >> 2;
    for (int pr = pr0; pr < prend; pr += prstep) {
#pragma unroll 1
        for (int ii = 0; ii < 2; ++ii) { const Item it = decode(2 * pr + ii);
            DLAS char* Kl = lds + ii * ITEM_LDS + K_OFF; DLAS char* Vl = lds + ii * ITEM_LDS + V_OFF;
            bf16x8 kv[4], vv[4];
#pragma unroll
            for (int c = 0; c < 4; ++c) { const int idx = c * 512 + tid, row = idx >> 3, ch = idx & 7; const int srow = (it.nbk - 1) * 128 + row;
                const size_t off = ((size_t)(srow * it.r + it.ph)) * 1536 + it.hd * 64 + ch * 8;
                if (srow >= 0) { kv[c] = *(const DGAS bf16x8*)(KD + off); vv[c] = *(const DGAS bf16x8*)(VD + off); } else { kv[c] = bf16x8{}; vv[c] = bf16x8{}; } }
#pragma unroll
            for (int c = 0; c < 4; ++c) { const int idx = c * 512 + tid, row = idx >> 3, ch = idx & 7;
                *(DLAS bf16x8*)(Kl + row * 128 + ((ch ^ ((row >> 1) & 7)) * 16)) = kv[c];
                *(DLAS bf16x8*)(Vl + v_st(row, ch * 8)) = vv[c]; }
            if (tid < 256) { const int st = tid - 35;
                ((DLAS float*)(lds + BIAS_OFF + ii * 1024))[tid] = (st >= 0 && st <= 128) ? rel_bias[t5b(st * it.r) * 24 + it.hd] * LOG2E : -__builtin_inff(); }
        }
        __syncthreads();
        { const Item it = decode(2 * pr + wi);
            const DLAS char* Kl = lds + wi * ITEM_LDS + K_OFF; const DLAS float* bias = (const DLAS float*)(lds + BIAS_OFF + wi * 1024);
            DLAS float* wsf = (DLAS float*)(lds + WSF_OFF + wid * 128);
            const int qtok = ((it.nbk * 128 + 32 * w4 + r32) * it.r + it.ph);
            bf16x8 qr[4];
#pragma unroll
            for (int d0 = 0; d0 < 4; ++d0) qr[d0] = *(const DGAS bf16x8*)(QD + (size_t)qtok * 1536 + it.hd * 64 + d0 * 16 + hi * 8);
            f32x16 p[5];
            const DLAS char* kb[4];
#pragma unroll
            for (int d0 = 0; d0 < 4; ++d0) kb[d0] = Kl + (32 * w4 + r32) * 128 + (((2 * d0 + hi) ^ ((r32 >> 1) & 7)) * 16);
#pragma unroll
            for (int b = 0; b < 5; ++b) { p[b] = f32x16{};
#pragma unroll
                for (int d0 = 0; d0 < 4; ++d0) p[b] = __builtin_amdgcn_mfma_f32_32x32x16_bf16(*(const DLAS bf16x8*)(kb[d0] + b * 4096), qr[d0], p[b], 0, 0, 0); }
            { const DLAS char* tb = (const DLAS char*)bias + 4 * (4 + r32 - 4 * hi);
#pragma unroll
              for (int b = 0; b < 5; ++b)
#pragma unroll
                for (int r = 0; r < 16; ++r) { const int c = 32 * b + (r & 3) + 8 * (r >> 2); p[b][r] = fmaf(p[b][r], 0.125f * LOG2E, *(const DLAS float*)(tb + 4 * (159 - c))); } }
            if (it.nbk == 0) {
                int lim = 128 - 32 * w4 - 4 * hi; asm volatile("" : "+v"(lim));
#pragma unroll
                for (int b = 0; b < 4; ++b)
#pragma unroll
                    for (int r = 0; r < 16; ++r) { const int c = 32 * b + (r & 3) + 8 * (r >> 2); if (c < lim) p[b][r] = -__builtin_inff(); } }
            float mx;
            { float m0 = fmaxf(fmaxf(p[0][0], p[0][1]), p[0][2]), m1 = fmaxf(fmaxf(p[0][3], p[0][4]), p[0][5]);
#pragma unroll
              for (int r = 6; r < 16; r += 2) { if ((r >> 1) & 1) m0 = fmaxf(fmaxf(m0, p[0][r]), p[0][r + 1]); else m1 = fmaxf(fmaxf(m1, p[0][r]), p[0][r + 1]); }
#pragma unroll
              for (int b = 1; b < 5; ++b)
#pragma unroll
                for (int r = 0; r < 16; r += 4) { m0 = fmaxf(fmaxf(m0, p[b][r]), p[b][r + 1]); m1 = fmaxf(fmaxf(m1, p[b][r + 2]), p[b][r + 3]); }
              mx = fmaxf(m0, m1); }
            { auto rr = __builtin_amdgcn_permlane32_swap(__float_as_uint(mx), __float_as_uint(mx), false, false); mx = fmaxf(__uint_as_float(rr[0]), __uint_as_float(rr[1])); }
            float den = 0.f;
#pragma unroll
            for (int b = 0; b < 5; ++b)
#pragma unroll
                for (int r = 0; r < 16; ++r) { const float e = __builtin_amdgcn_exp2f(p[b][r] - mx); p[b][r] = e; den += e; }
            { auto rr = __builtin_amdgcn_permlane32_swap(__float_as_uint(den), __float_as_uint(den), false, false); den = __uint_as_float(rr[0]) + __uint_as_float(rr[1]); }
            if (hi == 0) { wsf[r32] = __builtin_amdgcn_rcpf(den); LSE[(size_t)qtok * 24 + it.hd] = mx * LN2 + __logf(den); }
            bf16x8 pa[5][2];
#define DIL_PK4(P, B_, OUT) do { unsigned a0 = cvtpk(P[B_+0], P[B_+1]), a1 = cvtpk(P[B_+2], P[B_+3]);                          \
        unsigned b0 = cvtpk(P[B_+4], P[B_+5]), b1 = cvtpk(P[B_+6], P[B_+7]);                                             \
        auto r0 = __builtin_amdgcn_permlane32_swap(a0, b0, false, false); auto r1 = __builtin_amdgcn_permlane32_swap(a1, b1, false, false); \
        u32x4 w_ = {r0[0], r1[0], r0[1], r1[1]}; OUT = *reinterpret_cast<bf16x8*>(&w_); } while (0)
#pragma unroll
            for (int b = 0; b < 5; ++b) { DIL_PK4(p[b], 0, pa[b][0]); DIL_PK4(p[b], 8, pa[b][1]); }
#undef DIL_PK4
            f32x16 o[2] = {};
            const int vb0 = (int)(unsigned)(__UINTPTR_TYPE__)(lds + wi * ITEM_LDS + V_OFF) + v_rd_base(lane) + 4 * w4 * 1024;
#define DIL_TRRD(dst, off) asm volatile("ds_read_b64_tr_b16 %0, %1 offset:%2" : "=&v"(dst) : "v"(vb0), "i"(off) : "memory")
#define DIL_PV(b, d0) do { s16x4 l0, h0, l1, h1; constexpr int o_ = (4 * (b)) * 1024 + (d0) * 512;                                         \
        DIL_TRRD(l0, o_); DIL_TRRD(h0, o_ + 1024); DIL_TRRD(l1, o_ + 2048); DIL_TRRD(h1, o_ + 3072);                                        \
        asm volatile("s_waitcnt lgkmcnt(0)" ::: "memory"); __builtin_amdgcn_sched_barrier(0);                                               \
        o[d0] = __builtin_amdgcn_mfma_f32_32x32x16_bf16(pa[b][0], (bf16x8){l0[0], l0[1], l0[2], l0[3], h0[0], h0[1], h0[2], h0[3]}, o[d0], 0, 0, 0);   \
        o[d0] = __builtin_amdgcn_mfma_f32_32x32x16_bf16(pa[b][1], (bf16x8){l1[0], l1[1], l1[2], l1[3], h1[0], h1[1], h1[2], h1[3]}, o[d0], 0, 0, 0); } while (0)
            DIL_PV(0, 0); DIL_PV(0, 1); DIL_PV(1, 0); DIL_PV(1, 1); DIL_PV(2, 0); DIL_PV(2, 1); DIL_PV(3, 0); DIL_PV(3, 1); DIL_PV(4, 0); DIL_PV(4, 1);
#undef DIL_PV
#undef DIL_TRRD
            asm volatile("s_waitcnt lgkmcnt(0)" ::: "memory");
            __syncthreads();
            { DLAS bf16_t* stg = (DLAS bf16_t*)(lds + wi * ITEM_LDS + K_OFF + w4 * 4096);
#pragma unroll
              for (int r = 0; r < 16; ++r) { const int orow = crow(r, hi); const float rd = wsf[orow];
#pragma unroll
                  for (int d0 = 0; d0 < 2; ++d0) stg[orow * 64 + d0 * 32 + r32] = (bf16_t)cvtpk(o[d0][r] * rd, 0.f); }
              asm volatile("s_waitcnt lgkmcnt(0)" ::: "memory");
#pragma unroll
              for (int i = 0; i < 4; ++i) { const int row = i * 8 + (lane >> 3), ch = lane & 7; const int otok = (it.nbk * 128 + 32 * w4 + row) * it.r + it.ph;
                  *(DGAS u32x4*)(QD + (size_t)otok * 1536 + it.hd * 64 + ch * 8) = *(const DLAS u32x4*)(stg + row * 64 + ch * 8); } }
        }
        __syncthreads();
    }
}
}

#define LAS __attribute__((address_space(3)))
constexpr size_t MiB = 1u << 20;
constexpr int NWAVES = 8, MK_LDS_BYTES = 147456;
constexpr size_t WS_CTL = 0, WS_R0 = 1 * MiB, WS_CS = 2 * MiB, WS_SN = 3 * MiB, WS_SSQ1 = 4 * MiB, WS_SSQ2 = 5 * MiB, WS_SSQL = 6 * MiB, WS_LSE = 8 * MiB;
constexpr size_t WS_WGU = 10 * MiB, WS_WD = 21 * MiB, WS_WIN = 27 * MiB, WS_WG = 38 * MiB, WS_WUQ = 42 * MiB, WS_WUKV = 43 * MiB, WS_WBA = 44 * MiB, WS_WBD = 45 * MiB, WS_WO = 46 * MiB;
constexpr size_t WS_XB = 48 * MiB, WS_ACT = 80 * MiB;
constexpr size_t WS_H = 80 * MiB, WS_QD = 80 * MiB, WS_KD = 128 * MiB, WS_VD = 176 * MiB, WS_LAT = 224 * MiB;
constexpr size_t WS_G = 80 * MiB, WS_QF = 144 * MiB, WS_KF = 168 * MiB, WS_VV = 192 * MiB, WS_DIL = 208 * MiB, WS_ATT = 224 * MiB, WS_MG = 176 * MiB;
constexpr size_t WS_CQN = 80 * MiB, WS_CKVN = 92 * MiB;

struct MkArgs { const float* in[22]; float* out; unsigned char* ws; int ph_lo, ph_hi; };

__device__ __forceinline__ unsigned mk_pk2(float lo, float hi) { return (unsigned)f2bf(lo) | ((unsigned)f2bf(hi) << 16); }
__device__ __forceinline__ void conv_item(const float* W, int ldw, int col0, int k0, int K, bf16_t* WT, int dstrow0, const float* gain, LAS float* scr, int lane) {
    pg8::f32x4 wv[8];
#pragma unroll
    for (int i = 0; i < 8; ++i) { const int kk = 8 * i + (lane >> 3); wv[i] = *(const pg8::f32x4*)(W + (size_t)(k0 + kk) * ldw + col0 + (lane & 7) * 4); }
    const float gl = gain ? gain[k0 + lane] : 1.f;
#pragma unroll
    for (int i = 0; i < 8; ++i) { const int kk = 8 * i + (lane >> 3); const float gk = __shfl(gl, kk); LAS float* d = scr + kk * 33 + (lane & 7) * 4;
        d[0] = wv[i][0] * gk; d[1] = wv[i][1] * gk; d[2] = wv[i][2] * gk; d[3] = wv[i][3] * gk; }
    asm volatile("s_waitcnt lgkmcnt(0)" ::: "memory");
    const int c = lane & 7;
#pragma unroll
    for (int j = 0; j < 4; ++j) { const int n = (lane >> 3) + 8 * j; const LAS float* s = scr + (8 * c) * 33 + n;
        pg8::u32x4 o; o.x = mk_pk2(s[0 * 33], s[1 * 33]); o.y = mk_pk2(s[2 * 33], s[3 * 33]); o.z = mk_pk2(s[4 * 33], s[5 * 33]); o.w = mk_pk2(s[6 * 33], s[7 * 33]);
        *(pg8::u32x4*)(WT + (size_t)(dstrow0 + n) * K + k0 + 8 * c) = o; }
    asm volatile("s_waitcnt lgkmcnt(0)" ::: "memory");
}
struct ConvSeg { const float* src; const float* src2; const float* gain; bf16_t* dst; int ldw, col0, K, row0, nblk, kind; };
typedef const __attribute__((address_space(4))) MkArgs* KArgP;
__device__ __forceinline__ KArgP kargs() { KArgP p = (KArgP)__builtin_amdgcn_kernarg_segment_ptr(); asm volatile("" : "+s"(p)); return p; }
__device__ __forceinline__ ConvSeg conv_seg(KArgP ap, int si) {
    unsigned char* ws = ap->ws;
    bf16_t* W_GU = (bf16_t*)(ws + WS_WGU); bf16_t* W_D = (bf16_t*)(ws + WS_WD); bf16_t* W_IN = (bf16_t*)(ws + WS_WIN); bf16_t* W_G = (bf16_t*)(ws + WS_WG);
    bf16_t* W_UQ = (bf16_t*)(ws + WS_WUQ); bf16_t* W_UKV = (bf16_t*)(ws + WS_WUKV); bf16_t* W_BA = (bf16_t*)(ws + WS_WBA); bf16_t* W_BD = (bf16_t*)(ws + WS_WBD); bf16_t* W_O = (bf16_t*)(ws + WS_WO);
    switch (si) {
    case 0: return ConvSeg{ap->in[5], ap->in[6], ap->in[4], W_GU, DFF, 0, 1024, 0, 176, 1};
    case 1: return ConvSeg{ap->in[7], nullptr, nullptr, W_D, 1024, 0, DFF, 0, 32, 0};
    case 2: return ConvSeg{ap->in[9], nullptr, ap->in[8], W_IN, DIN, 0, 1024, 4608, 21, 0};
    case 3: return ConvSeg{nullptr, nullptr, nullptr, W_IN, 0, 0, 1024, 5280, 3, 2};
    case 4: return ConvSeg{ap->in[9], nullptr, ap->in[8], W_IN, DIN, 672, 1024, 0, 144, 0};
    case 5: return ConvSeg{ap->in[9], nullptr, ap->in[8], W_G, DIN, 5280, 1024, 0, 64, 0};
    case 6: return ConvSeg{ap->in[12], nullptr, ap->in[11], W_UQ, 768, 0, QLORA, 0, 24, 0};
    case 7: return ConvSeg{ap->in[14], nullptr, ap->in[13], W_UKV, 1024, 0, KVLORA, 0, 32, 0};
    case 8: return ConvSeg{ap->in[15], nullptr, nullptr, W_BA, 1024, 0, 512, 0, 32, 0};
    case 9: return ConvSeg{ap->in[16], nullptr, nullptr, W_BD, 1024, 0, 512, 0, 32, 0};
    case 10: return ConvSeg{ap->in[17], nullptr, nullptr, W_O, 1024, 0, 1024, 0, 32, 0};
    case 11: return ConvSeg{ap->in[19], ap->in[20], ap->in[18], W_GU, DFF, 0, 1024, 0, 176, 1};
    default: return ConvSeg{ap->in[21], nullptr, nullptr, W_D, 1024, 0, DFF, 0, 32, 0};
    }
}
__device__ __forceinline__ void conv_run(KArgP a, int s0, int s1, LAS float* scr, int gw, int ngw, int lane) {
    int base = 0;
    for (int si = s0; si < s1; ++si) { const ConvSeg sg = conv_seg(a, si); const int kt = sg.K / 64, nit = sg.nblk * kt;
        int it = gw - (base % ngw); if (it < 0) it += ngw;
        for (; it < nit; it += ngw) { const int b = it / kt, k0 = (it - b * kt) * 64;
            if (sg.kind == 2) { const int c = lane & 7;
#pragma unroll
                for (int j = 0; j < 4; ++j) { const int n = (lane >> 3) + 8 * j; *(pg8::u32x4*)(sg.dst + (size_t)(sg.row0 + 32 * b + n) * sg.K + k0 + 8 * c) = (pg8::u32x4){0u, 0u, 0u, 0u}; } }
            else if (sg.kind == 1) { const int tile = b >> 3, sub = b & 7; conv_item(sub < 4 ? sg.src : sg.src2, sg.ldw, tile * 128 + (sub & 3) * 32, k0, sg.K, sg.dst, sg.row0 + 32 * b, sg.gain, scr, lane); }
            else conv_item(sg.src, sg.ldw, sg.col0 + 32 * b, k0, sg.K, sg.dst, sg.row0 + 32 * b, sg.gain, scr, lane); }
        base += nit; }
}
__device__ __forceinline__ void xb_row(const float* xrow, bf16_t* orow, float* r0, int lane) {
    pg8::f32x4 v[4]; float s = 0.f;
#pragma unroll
    for (int j = 0; j < 4; ++j) { v[j] = *((const pg8::f32x4*)xrow + lane + 64 * j); s += pg8::dot4(v[j]); }
    s = wave_sum(s);
#pragma unroll
    for (int j = 0; j < 4; ++j) { pg8::u32x2 w; w.x = mk_pk2(v[j][0], v[j][1]); w.y = mk_pk2(v[j][2], v[j][3]); *((pg8::u32x2*)orow + lane + 64 * j) = w; }
    if (lane == 0) *r0 = rsqrtf(s * (1.f / 1024.f) + EPS);
}

struct MkConst { InvFreq ifr; };

#define XB_TMO      128
#define XB_XCNT(j)  (256  + 64 * (j))
#define XB_XSUB(j)  (1280 + 64 * (j))
#define XB_XGEN(j)  (2304 + 64 * (j))
#define XB_TOP      3328
#define XB_TOPGEN   3392
#define XCD_BAR_WORDS 3456
#define XB_SPIN_CAP (1u << 18)

__device__ __forceinline__ unsigned xb_ld(unsigned* p)              { return __hip_atomic_load(p, __ATOMIC_RELAXED, __HIP_MEMORY_SCOPE_AGENT); }
__device__ __forceinline__ unsigned xb_add(unsigned* p, unsigned v) { return __hip_atomic_fetch_add(p, v, __ATOMIC_RELAXED, __HIP_MEMORY_SCOPE_AGENT); }
__device__ __forceinline__ unsigned xb_xcc_id() { return (unsigned)__builtin_amdgcn_s_getreg((3 << 11) | 20) & 0xFu; }
#define XB_SPIN(cond, bar) do { unsigned _sp = 0; while (cond) { __builtin_amdgcn_s_sleep(1); \
    if ((++_sp & 255u) == 0u) { if (xb_ld(&(bar)[XB_TMO])) break; if (_sp > XB_SPIN_CAP) { atomicAdd(&(bar)[XB_TMO], 1u); break; } } } } while (0)

struct XcdBarrier {
    unsigned* bar; unsigned x;
    volatile LAS unsigned* st;
};

__device__ __forceinline__ XcdBarrier xcd_barrier_post(unsigned* bar, volatile LAS unsigned* st, bool leader) {
    XcdBarrier b; b.bar = bar; b.x = xb_xcc_id(); b.st = st;
    if (leader) (void)xb_add(&bar[XB_XCNT(b.x)], 1u);
    return b;
}
__device__ __forceinline__ void xcd_barrier_complete(unsigned* bar, unsigned x, unsigned& nloc, unsigned& nx) {
    const unsigned G = gridDim.x * gridDim.y * gridDim.z;
    unsigned sum, cnt, mine, sp = 0u;
    for (;;) {
        sum = 0u; cnt = 0u; mine = 0u;
#pragma unroll
        for (unsigned j = 0; j < 16; ++j) { const unsigned c = xb_ld(&bar[XB_XCNT(j)]); sum += c; cnt += (c > 0u) ? 1u : 0u; mine = (j == x) ? c : mine; }
        if (sum == G) break;
        __builtin_amdgcn_s_sleep(1);
        if ((++sp & 255u) == 0u) { if (xb_ld(&bar[XB_TMO])) break; if (sp > XB_SPIN_CAP) { atomicAdd(&bar[XB_TMO], 1u); break; } }
    }
    nloc = mine > 0u ? mine : 1u; nx = cnt > 0u ? cnt : 1u;
}

__device__ __forceinline__ void xcd_barrier(const XcdBarrier& b, bool leader) {
    asm volatile("s_waitcnt vmcnt(0)" ::: "memory");
    __syncthreads();
    if (leader) {
        unsigned* bar = b.bar;
        __builtin_amdgcn_s_waitcnt(0);
        unsigned nloc = b.st[0], nx = b.st[1];
        if (nloc == 0u) { xcd_barrier_complete(bar, b.x, nloc, nx); b.st[0] = nloc; b.st[1] = nx; }
        const unsigned old = xb_add(&bar[XB_XSUB(b.x)], 1u);
        const unsigned gen = old / nloc;
        if (old + 1u == (gen + 1u) * nloc) {
            __builtin_amdgcn_fence(__ATOMIC_RELEASE, "agent");
            asm volatile("s_waitcnt vmcnt(0)" ::: "memory");
            const unsigned og = xb_add(&bar[XB_TOP], 1u);
            const unsigned tg = og / nx;
            if (og + 1u == (tg + 1u) * nx) xb_add(&bar[XB_TOPGEN], 1u);
            else XB_SPIN(xb_ld(&bar[XB_TOPGEN]) == tg, bar);
            __builtin_amdgcn_fence(__ATOMIC_ACQUIRE, "agent");
            xb_add(&bar[XB_XGEN(b.x)], 1u);
            asm volatile("s_waitcnt vmcnt(0)" ::: "memory");
        } else {
            XB_SPIN(xb_ld(&bar[XB_XGEN(b.x)]) == gen, bar);
            __builtin_amdgcn_fence(__ATOMIC_ACQUIRE, "agent");
            asm volatile("s_waitcnt vmcnt(0)" ::: "memory");
        }
    }
    __syncthreads();
}

#define XB_LSUB(j)  (3456 + 64 * (j))
#define XB_LGEN(j)  (3968 + 64 * (j))
#define XB_MISM     4480
__device__ __forceinline__ void xcd_local_barrier(const XcdBarrier& b, int g, unsigned ngrp, bool leader) {
    asm volatile("s_waitcnt vmcnt(0)" ::: "memory");
    __syncthreads();
    if (leader) {
        unsigned* bar = b.bar;
        __builtin_amdgcn_s_waitcnt(0);
        const unsigned old = xb_add(&bar[XB_LSUB(g)], 1u);
        const unsigned gen = old / ngrp;
        if (old + 1u == (gen + 1u) * ngrp) xb_add(&bar[XB_LGEN(g)], 1u);
        else XB_SPIN(xb_ld(&bar[XB_LGEN(g)]) == gen, bar);
        __builtin_amdgcn_fence(__ATOMIC_ACQUIRE, "agent");
        asm volatile("s_waitcnt vmcnt(0)" ::: "memory");
    }
    __syncthreads();
}

__device__ __forceinline__ unsigned char* opq(unsigned char* p) { asm volatile("" : "+s"(p)); return p; }
#define WP(T, off) ((T*)(w + (off)))
constexpr int RS_TAB_OFF = 131072;
#define RT_PTR ((const LAS float*)(L + RS_TAB_OFF))
__device__ __forceinline__ void rs_fill(LAS unsigned char* L, const float* slots, int stride, int first, int n4, float inv_n, float mul, int group, int wave, int ln) {
    LAS float* tab = (LAS float*)(L + RS_TAB_OFF);
#pragma unroll 1
    for (int i = wave * 64 + ln; i < 2048; i += 512) { const float* p = slots + (size_t)(group * 2048 + i) * stride + first; float sacc = 0.f;
        for (int k = 0; k < n4; ++k) { const pg8::f32x4 v = *(const pg8::f32x4*)(p + 4 * k); sacc += (v[0] + v[1]) + (v[2] + v[3]); }
        tab[i] = rsqrtf(sacc * inv_n + 1e-6f) * mul; }
    __syncthreads();
}
__global__ void __launch_bounds__(NWAVES * 64, 2) mk_fwd(MkArgs args_in_kernarg, InvFreq ifr) {
#define args (*kargs())
    extern __shared__ __attribute__((aligned(16))) unsigned char lds[];
    LAS unsigned char* L = (LAS unsigned char*)lds;
    const int wave = __builtin_amdgcn_readfirstlane((int)threadIdx.x >> 6);
#define lane ((int)__builtin_amdgcn_mbcnt_hi(~0u, __builtin_amdgcn_mbcnt_lo(~0u, 0u)))
#define tid (wave * 64 + lane)
    const int G = gridDim.x, bx = blockIdx.x, vcu = (G % 8 == 0) ? (bx % 8) * (G / 8) + bx / 8 : bx;
    const int gw = vcu * NWAVES + wave, ngw = G * NWAVES;
    const int lo = args.ph_lo, hi = args.ph_hi;
#define IN(k) (lo <= (k) && (k) < hi)
    volatile LAS unsigned* bst = (volatile LAS unsigned*)(L + MK_LDS_BYTES - 64);
    const bool leader = (wave == 0) && (lane == 0);
    XcdBarrier bar; bar.bar = (unsigned*)(args.ws + WS_CTL) + 4096; bar.x = 0; bar.st = bst;
    if (hi - lo > 1) { if (leader) { bst[0] = 0u; bst[1] = 0u; } __syncthreads(); bar = xcd_barrier_post((unsigned*)(args.ws + WS_CTL) + 4096, bst, leader); }
#define SEAM(k) do { if (IN(k) && IN((k) + 1)) xcd_barrier(bar, leader); } while (0)
#define SEAML(k) do { if (IN(k) && IN((k) + 1)) { if (bst[2] != 0u) xcd_local_barrier(bar, bx & 7, (unsigned)(G >> 3), leader); else xcd_barrier(bar, leader); } } while (0)
    if (leader) { bst[2] = 0u; if (hi - lo > 1 && lo == 0 && bar.x != (unsigned)(bx & 7)) (void)xb_add(&bar.bar[XB_MISM], 1u); }

    if (IN(0)) { unsigned char* w = opq(args.ws); LAS float* scr = (LAS float*)(L + wave * 16384);
        conv_run(kargs(), 0, (G == 256) ? 1 : 11, scr, gw, ngw, lane);
        const float* x = args.in[0]; const int* pos = (const int*)args.in[1];
#pragma unroll 4
        for (int m = gw; m < S; m += ngw) xb_row(x + (size_t)m * DM, WP(bf16_t, WS_XB) + (size_t)m * DM, WP(float, WS_R0) + m, lane);
        float* CS = WP(float, WS_CS); float* SN = WP(float, WS_SN);
        for (int idx = (vcu * NWAVES * 64) + tid; idx < S * 16; idx += G * NWAVES * 64) { const float ang = (float)pos[idx >> 4] * ifr.f[idx & 15]; float c, s; sincos_acc(ang, c, s); CS[idx] = c; SN[idx] = s; }
        __syncthreads();
    }
    SEAM(0);
    if (IN(0) && IN(1)) { if (leader) bst[2] = (G == 256 && xb_ld(&bar.bar[XB_MISM]) == 0u) ? 1u : 0u; __syncthreads(); }
    if (IN(1)) { unsigned char* w = opq(args.ws); pg8::Gemm g{WP(bf16_t, WS_XB), WP(bf16_t, WS_WGU), S, 2 * DFF, DM, DM}; pg8::StaticOrder so; so.init(S, 2 * DFF, G, bx);
        pg8::EpiSwiglu E{WP(bf16_t, WS_H), WP(float, WS_R0), 0, RT_PTR}; pg8::gemm_phase<pg8::EpiSwiglu, pg8::StaticOrder, true, true>(L, g, so, E, wave);
        if (G == 256 && bx >= 128) { LAS float* scr = (LAS float*)(L + wave * 16384); conv_run(kargs(), 1, 11, scr, (bx - 128) * NWAVES + wave, 128 * NWAVES, lane); __syncthreads(); } }
    SEAM(1);
    if (IN(2)) { unsigned char* w = opq(args.ws); pg8::Gemm g{WP(bf16_t, WS_H), WP(bf16_t, WS_WD), S, DM, DFF, DFF}; pg8::StaticOrder so; so.init(S, DM, G, bx);
        pg8::EpiResid<true> E{nullptr, WP(bf16_t, WS_XB), WP(float, WS_SSQ1), 0.5f, 0.f}; pg8::gemm_phase<pg8::EpiResid<true>, pg8::StaticOrder, true, true>(L, g, so, E, wave); }
    SEAM(2);
    if (IN(3)) { unsigned char* w = opq(args.ws); pg8::Gemm g{WP(bf16_t, WS_XB), WP(bf16_t, WS_WIN), S, 5120, DM, DM}; pg8::StaticOrder so; so.init(S, 5120, G, bx);
        rs_fill(L, WP(const float, WS_SSQ1), 16, 0, 4, 1.f / 1024.f, 1.f, bx & 7, wave, lane); pg8::EpiProj E{WP(bf16_t, WS_LAT), WP(bf16_t, WS_QD), RT_PTR, WP(float, WS_SSQL), 0, 0}; pg8::gemm_phase<pg8::EpiProj, pg8::StaticOrder, true, true>(L, g, so, E, wave); }
    SEAM(3);
    if (IN(4)) {
        { unsigned char* w = opq(args.ws); pg8::Gemm g{WP(bf16_t, WS_XB), WP(bf16_t, WS_WIN) + (size_t)5120 * DM, S, 256, DM, DM}; pg8::StaticOrder so; so.init(S, 256, G, bx);
          rs_fill(L, WP(const float, WS_SSQ1), 16, 0, 4, 1.f / 1024.f, 1.f, bx & 7, wave, lane); pg8::EpiProj E{WP(bf16_t, WS_LAT), WP(bf16_t, WS_QD), RT_PTR, WP(float, WS_SSQL), 20, 0}; pg8::gemm_phase<pg8::EpiProj, pg8::StaticOrder, true, true>(L, g, so, E, wave); }
        unsigned char* w = opq(args.ws); const bool split = (G == 256); const int p0 = !split ? bx : (bx < 64 ? 1344 + bx : bx - 64), pst = !split ? G : (bx < 64 ? 64 : 192), pend = !split ? 1536 : (bx < 64 ? 1536 : 1344);
        dil::dil_phase((__attribute__((address_space(3))) char*)L, WP(bf16_t, WS_QD), WP(const bf16_t, WS_KD), WP(const bf16_t, WS_VD), args.in[2], WP(float, WS_LSE), p0, pst, pend, wave, lane); }
    SEAM(4);
    if (IN(5)) { unsigned char* w = opq(args.ws); LAS float* scr = (LAS float*)(L + wave * 16384);
        conv_run(kargs(), 11, 13, scr, gw, ngw, lane);
        const bf16_t* DO = WP(const bf16_t, WS_QD); const float* LSE = WP(const float, WS_LSE); const bf16_t* LAT = WP(const bf16_t, WS_LAT);
        const float* CS = WP(const float, WS_CS); const float* SN = WP(const float, WS_SN);
        bf16_t* KF = WP(bf16_t, WS_KF); bf16_t* DIL = WP(bf16_t, WS_DIL);
#pragma unroll 4
        for (int row = gw; row < S; row += ngw) {
            { const int j = lane >> 3, d0 = (lane & 7) * 8; const float* lp = LSE + (size_t)row * 24 + j;
              const float l0 = lp[0], l1 = lp[8], l2 = lp[16]; const float mx = fmaxf(l0, fmaxf(l1, l2));
              const float e0 = __expf(l0 - mx), e1 = __expf(l1 - mx), e2 = __expf(l2 - mx), inv = 1.f / (e0 + e1 + e2);
              const bf16_t* dp = DO + (size_t)row * 1536 + j * 64 + d0;
              const pg8::u32x4 a = *(const pg8::u32x4*)dp, b = *(const pg8::u32x4*)(dp + 512), c = *(const pg8::u32x4*)(dp + 1024);
              const float w0 = e0 * inv, w1 = e1 * inv, w2 = e2 * inv;
              const pg8::f32x4 o0 = pg8::bf4_lo((pg8::u32x2){a.x, a.y}) * w0 + pg8::bf4_lo((pg8::u32x2){b.x, b.y}) * w1 + pg8::bf4_lo((pg8::u32x2){c.x, c.y}) * w2;
              const pg8::f32x4 o1 = pg8::bf4_lo((pg8::u32x2){a.z, a.w}) * w0 + pg8::bf4_lo((pg8::u32x2){b.z, b.w}) * w1 + pg8::bf4_lo((pg8::u32x2){c.z, c.w}) * w2;
              *(pg8::u32x4*)(DIL + (size_t)row * 512 + j * 64 + d0) = pg8::pack8bf(o0, o1); }
            { const int h = lane >> 3, ii = (lane & 7) * 2; const bf16_t* lp = LAT + (size_t)row * 768 + 640;
              const unsigned xa = *(const unsigned*)(lp + ii), xb2 = *(const unsigned*)(lp + 16 + ii);
              const float x10 = __uint_as_float(xa << 16), x11 = __uint_as_float(xa & 0xffff0000u), x20 = __uint_as_float(xb2 << 16), x21 = __uint_as_float(xb2 & 0xffff0000u);
              const float c0 = CS[(size_t)row * 16 + ii], c1 = CS[(size_t)row * 16 + ii + 1], s0 = SN[(size_t)row * 16 + ii], s1 = SN[(size_t)row * 16 + ii + 1];
              *(unsigned*)(KF + (size_t)row * 768 + h * 96 + 64 + ii) = mk_pk2(x10 * c0 - x20 * s0, x11 * c1 - x21 * s1);
              *(unsigned*)(KF + (size_t)row * 768 + h * 96 + 80 + ii) = mk_pk2(x10 * s0 + x20 * c0, x11 * s1 + x21 * c1); }
        }
        __syncthreads();
        { unsigned char* w = opq(args.ws); pg8::Gemm g{WP(bf16_t, WS_LAT), WP(bf16_t, WS_WUQ), S, 768, QLORA, 768}; pg8::StaticOrder so; so.init(S, 768, G, bx);
          rs_fill(L, WP(const float, WS_SSQL), 32, 0, 3, 1.f / 384.f, 0.14724444602590306f, bx & 7, wave, lane); pg8::EpiQUp E{WP(bf16_t, WS_QF), RT_PTR, WP(float, WS_CS), WP(float, WS_SN)}; pg8::gemm_phase<pg8::EpiQUp, pg8::StaticOrder, true, true>(L, g, so, E, wave); }
        { unsigned char* w = opq(args.ws); pg8::Gemm g{WP(bf16_t, WS_LAT) + 384, WP(bf16_t, WS_WUKV), S, 1024, KVLORA, 768}; pg8::StaticOrder so; so.init(S, 1024, G, bx);
          rs_fill(L, WP(const float, WS_SSQL), 32, 12, 2, 1.f / 256.f, 1.f, bx & 7, wave, lane); pg8::EpiKVUp E{WP(bf16_t, WS_KF), WP(bf16_t, WS_VV), RT_PTR}; pg8::gemm_phase<pg8::EpiKVUp, pg8::StaticOrder, true, true>(L, g, so, E, wave); }
    }
    SEAM(5);
    if (IN(6)) { { unsigned char* w = opq(args.ws); mla::mla_phase((__attribute__((address_space(3))) char*)L, WP(const bf16_t, WS_QF), WP(const bf16_t, WS_KF), WP(const bf16_t, WS_VV), WP(bf16_t, WS_ATT), bx, G, wave, lane); }
        unsigned char* w = opq(args.ws); pg8::Gemm g{WP(bf16_t, WS_XB), WP(bf16_t, WS_WG), S, 2048, DM, DM}; pg8::StaticOrder so; so.init(S, 2048, G, bx);
        rs_fill(L, WP(const float, WS_SSQ1), 16, 0, 4, 1.f / 1024.f, 1.f, bx & 7, wave, lane); pg8::EpiGate E{WP(bf16_t, WS_G), args.in[10], RT_PTR}; pg8::gemm_phase<pg8::EpiGate, pg8::StaticOrder, true, true>(L, g, so, E, wave); }
    SEAM(6);
    if (IN(7)) { pg8::StaticOrder so; so.init(S, DM, G, bx);
        { unsigned char* w = opq(args.ws); pg8::Gemm g{WP(bf16_t, WS_ATT), WP(bf16_t, WS_WBA), S, DM, 512, 512}; pg8::EpiMerge<false> E{WP(bf16_t, WS_MG), WP(bf16_t, WS_G)}; pg8::gemm_phase<pg8::EpiMerge<false>, pg8::StaticOrder, true, true>(L, g, so, E, wave); }
        { unsigned char* w = opq(args.ws); pg8::Gemm g{WP(bf16_t, WS_DIL), WP(bf16_t, WS_WBD), S, DM, 512, 512}; pg8::EpiMerge<true> E{WP(bf16_t, WS_MG), WP(bf16_t, WS_G)}; pg8::gemm_phase<pg8::EpiMerge<true>, pg8::StaticOrder, true, true>(L, g, so, E, wave); } }
    SEAM(7);
    if (IN(8)) { unsigned char* w = opq(args.ws); pg8::Gemm g{WP(bf16_t, WS_MG), WP(bf16_t, WS_WO), S, DM, DM, DM}; pg8::StaticOrder so; so.init(S, DM, G, bx);
        pg8::EpiResid<true> E{nullptr, WP(bf16_t, WS_XB), WP(float, WS_SSQ2), 1.0f, 0.f}; pg8::gemm_phase<pg8::EpiResid<true>, pg8::StaticOrder, true, true>(L, g, so, E, wave); }
    SEAML(8);
    if (IN(9)) { unsigned char* w = opq(args.ws); pg8::Gemm g{WP(bf16_t, WS_XB), WP(bf16_t, WS_WGU), S, 2 * DFF, DM, DM}; pg8::StaticOrder so; so.init(S, 2 * DFF, G, bx);
        rs_fill(L, WP(const float, WS_SSQ2), 16, 0, 4, 1.f / 1024.f, 1.f, bx & 7, wave, lane); pg8::EpiSwiglu E{WP(bf16_t, WS_H), WP(float, WS_SSQ2), 1, RT_PTR}; pg8::gemm_phase<pg8::EpiSwiglu, pg8::StaticOrder, true, true>(L, g, so, E, wave); }
    SEAML(9);
    if (IN(10)) { unsigned char* w = opq(args.ws); pg8::Gemm g{WP(bf16_t, WS_H), WP(bf16_t, WS_WD), S, DM, DFF, DFF}; pg8::StaticOrder so; so.init(S, DM, G, bx);
        pg8::EpiFinal E{(const PGAS bf16_t*)WP(bf16_t, WS_XB), (PGAS float*)args.out, (const PGAS float*)args.in[3], (unsigned*)(w + 248 * MiB), (unsigned*)(w + WS_CTL) + 16384, 0.5f, 0.f};
        pg8::gemm_phase<pg8::EpiFinal, pg8::StaticOrder, true, true>(L, g, so, E, wave); }
#undef IN
#undef SEAM
#undef lane
#undef tid
}

#undef args
extern "C" void kernel_launch(void* const* d_in, const int* in_sizes, int n_in, void* d_out, int out_size, void* d_ws, size_t ws_size, hipStream_t stream) {
    float* R = (float*)d_out; unsigned char* ws = (unsigned char*)d_ws;
    if (ws_size < 256 * MiB || n_in != 22) { fprintf(stderr, "bad args: ws %zu n_in %d\n", ws_size, n_in); return; }
    static int grid = 0;
    if (grid == 0) {
        int dev = 0, cus = 0, per_cu = 0; (void)hipGetDevice(&dev); (void)hipDeviceGetAttribute(&cus, hipDeviceAttributeMultiprocessorCount, dev);
        if (hipFuncSetAttribute((const void*)mk_fwd, hipFuncAttributeMaxDynamicSharedMemorySize, MK_LDS_BYTES) != hipSuccess) fprintf(stderr, "hipFuncSetAttribute failed\n");
        if (hipOccupancyMaxActiveBlocksPerMultiprocessor(&per_cu, (const void*)mk_fwd, NWAVES * 64, MK_LDS_BYTES) != hipSuccess || per_cu < 1) { fprintf(stderr, "occupancy query: %d\n", per_cu); per_cu = 1; }
        (void)hipGetLastError();
        grid = cus * (per_cu < 1 ? 1 : per_cu);
        if (grid != 256) fprintf(stderr, "note: grid %d (per_cu %d)\n", grid, per_cu);
    }
    MkArgs a{}; for (int i = 0; i < 22; ++i) a.in[i] = (const float*)d_in[i]; a.out = R; a.ws = ws;
    InvFreq ifr; for (int i = 0; i < 16; ++i) ifr.f[i] = (float)(1.0 / pow(10000.0, (double)(2 * i) / 32.0));
    (void)hipMemsetAsync(ws + WS_CTL, 0, 131072, stream);
    a.ph_lo = 0; a.ph_hi = 11;
    void* kargs[] = {(void*)&a, (void*)&ifr};
    hipError_t le = hipLaunchCooperativeKernel((const void*)mk_fwd, dim3(grid), dim3(NWAVES * 64), kargs, MK_LDS_BYTES, stream);
    if (le != hipSuccess) fprintf(stderr, "cooperative launch failed: %s (grid %d)\n", hipGetErrorString(le), grid);
}
```

```cpp
#include <hip/hip_runtime.h>
#include <cstdio>
#include <cstdint>

typedef unsigned short bf16_t;
constexpr int S = 16384, DM = 1024, DFF = 2816, DIN = 7328;
constexpr int NH = 8, DQK = 96, DNOPE = 64, DROPE = 32, DV = 64, QLORA = 384, KVLORA = 256;
constexpr int DH = 64, NG = 3, HPG = 8;
constexpr float EPS = 1e-6f;

__device__ __forceinline__ float bf2f(bf16_t v) { return __uint_as_float(((unsigned)v) << 16); }
__device__ __forceinline__ bf16_t f2bf(float f) { unsigned u = __float_as_uint(f); return (bf16_t)((u + 0x7fffu + ((u >> 16) & 1u)) >> 16); }
__device__ __forceinline__ float ldf(const float* p) { return *p; }
__device__ __forceinline__ float ldf(const bf16_t* p) { return bf2f(*p); }
__device__ __forceinline__ float wave_sum(float v) {
#pragma unroll
    for (int o = 1; o < 64; o <<= 1) v += __shfl_xor(v, o);
    return v;
}

__device__ __forceinline__ void sincos_acc(float angf, float& c, float& s) {
    const double a = (double)angf;
    const double k = rint(a * 0.63661977236758134308);
    const double r = fma(-k, 1.5707963267948966192, a) - k * 6.123233995736766e-17;
    const double r2 = r * r;
    double sp = r * (1.0 + r2 * (-1.0 / 6 + r2 * (1.0 / 120 + r2 * (-1.0 / 5040 + r2 * (1.0 / 362880 + r2 * (-1.0 / 39916800 + r2 * (1.0 / 6227020800.0)))))));
    double cp = 1.0 + r2 * (-0.5 + r2 * (1.0 / 24 + r2 * (-1.0 / 720 + r2 * (1.0 / 40320 + r2 * (-1.0 / 3628800 + r2 * (1.0 / 479001600.0 + r2 * (-1.0 / 87178291200.0)))))));
    const int q = ((int)k) & 3;
    double ss = (q & 1) ? cp : sp, cc = (q & 1) ? sp : cp;
    if (q == 1) cc = -cc; if (q == 2) { ss = -ss; cc = -cc; } if (q == 3) ss = -ss;
    c = (float)cc; s = (float)ss;
}
struct InvFreq { float f[16]; };
namespace pg8 {
#define PG8_LAS __attribute__((address_space(3)))
typedef unsigned short bf16_t;
typedef short bf16x8 __attribute__((ext_vector_type(8)));
typedef float f32x4 __attribute__((ext_vector_type(4)));
typedef unsigned u32x4 __attribute__((ext_vector_type(4)));
constexpr int BM = 256, BK = 64, HALF = 128, HTB = HALF * BK * 2  , STAGE_BYTES = 8 * HTB, NXCD = 8, WGM = 8;

__host__ __device__ __forceinline__ int lds_byte(int r, int c) { const int st = (r >> 4) * 2 + (c >> 5), rr = r & 15, cc = c & 31, ob = rr * 64 + cc * 2; return st * 1024 + (ob ^ (((ob >> 9) & 1) << 5)); }
__host__ __device__ __forceinline__ void stage_rc(int b, int& R, int& C) { const int st = b / 1024, sb = b % 1024, swz = sb ^ (((sb >> 9) & 1) << 5); R = (st >> 1) * 16 + swz / 64; C = (st & 1) * 32 + (swz % 64) / 2; }
__host__ __device__ __forceinline__ int perm32(int rho) { const int n = rho >> 4, i = rho & 15; return 8 * (i >> 2) + 4 * n + (i & 3); }

struct Unit { int pm, pn; };
struct Gemm { const bf16_t* A; const bf16_t* Bt; int M, N, K, lda; };

struct StaticOrder {
    int nM, nN, nwg, G, c;
    __host__ __device__ void init(int M, int N, int G_, int c_) { nM = M / BM; nN = N / BM; nwg = nM * nN; G = G_; c = c_; }
    __host__ __device__ bool next(int i, Unit& u) const {
        const long L = (long)i * G + c; if (L >= nwg) return false;
        int wgid = (int)L; { const int q = nwg / NXCD, r = nwg % NXCD, xcd = wgid % NXCD, off = wgid / NXCD; wgid = (xcd < r ? xcd * (q + 1) : r * (q + 1) + (xcd - r) * q) + off; }
        const int nig = WGM * nN, gid = wgid / nig, fm = gid * WGM, gsz = (nM - fm) < WGM ? (nM - fm) : WGM;
        u.pm = fm + ((wgid % nig) % gsz); u.pn = (wgid % nig) / gsz; return true;
    }
    __device__ __forceinline__ void a_ready(const Unit&) const {}
    __device__ __forceinline__ void done(const Unit&) const {}
};

__device__ __forceinline__ unsigned cvt_pk_bf16(float lo, float hi) { unsigned r; asm volatile("v_cvt_pk_bf16_f32 %0, %1, %2" : "=v"(r) : "v"(lo), "v"(hi)); return r; }
template <class Epi, class Sched, bool ALIGN_EPI = false, bool SP2 = false>
__device__ __forceinline__ void gemm_phase(PG8_LAS unsigned char* lds, const Gemm g, const Sched& S, const Epi& E, const int wid) {
    int lane_ = (int)__builtin_amdgcn_mbcnt_hi(~0u, __builtin_amdgcn_mbcnt_lo(~0u, 0u)); asm volatile("" : "+v"(lane_));
    const int lane = lane_, tid = wid * 64 + lane, wr = wid >> 2, wc = wid & 3, fr = lane & 15, fq = lane >> 4;
    int K_ = g.K; asm volatile("" : "+s"(K_)); const int K = K_, nt = K / BK;
    unsigned voffA[2], voffB[2];
#pragma unroll
    for (int i = 0; i < 2; ++i) { int R, C; stage_rc(tid * 16 + i * 8192, R, C); const int Rb = Epi::PERM ? ((R & ~31) + perm32(R & 31)) : R;
        voffA[i] = (unsigned)(R * g.lda + C) * 2u; voffB[i] = (unsigned)(Rb * K + C) * 2u; }
    const size_t kstep = (size_t)(BK * 2);
    const size_t hstepB = (size_t)HALF * K * 2, hstepA = (size_t)HALF * g.lda * 2;
    const size_t tstepB = 2 * hstepB, tstepA = 2 * hstepA;
    const unsigned ldsw = (unsigned)wid * 1024u;
    const int aoff = lds_byte(wr * 64 + fr, fq * 8), boff = lds_byte(wc * 32 + fr, fq * 8);
#define PG8_SA(b, h) (((b) * 2 + (h)) * HTB)
#define PG8_SB(b, h) ((4 + (b) * 2 + (h)) * HTB)
#define PG8_STAGE(bufoff, gbase, voff) do { _Pragma("unroll") for (int _i = 0; _i < 2; ++_i) \
        __builtin_amdgcn_global_load_lds((const unsigned*)((const char*)(gbase) + (voff)[_i]), (PG8_LAS unsigned*)(lds + (bufoff) + ldsw + _i * 8192), 16, 0, 0); } while (0)
#define PG8_LDA(dst, b, h) do { _Pragma("unroll") for (int m = 0; m < 4; ++m) _Pragma("unroll") for (int k = 0; k < 2; ++k) dst[m][k] = *(const PG8_LAS bf16x8*)(lds + PG8_SA(b, h) + aoff + m * 2048 + k * 1024); } while (0)
#define PG8_LDB(dst, b, h) do { _Pragma("unroll") for (int n = 0; n < 2; ++n) _Pragma("unroll") for (int k = 0; k < 2; ++k) dst[n][k] = *(const PG8_LAS bf16x8*)(lds + PG8_SB(b, h) + boff + n * 2048 + k * 1024); } while (0)
#define PG8_MMA(ai, bj, At, Bt) do { __builtin_amdgcn_s_setprio(1); _Pragma("unroll") for (int m = 0; m < 4; ++m) _Pragma("unroll") for (int n = 0; n < 2; ++n) _Pragma("unroll") for (int k = 0; k < 2; ++k) \
        acc[ai][bj][m][n] = __builtin_amdgcn_mfma_f32_16x16x32_bf16(Bt[n][k], At[m][k], acc[ai][bj][m][n], 0, 0, 0); __builtin_amdgcn_s_setprio(0); } while (0)
#define PG8_WAIT_V(n) asm volatile("s_waitcnt vmcnt(" #n ")" ::: "memory")
#define PG8_WAIT_L(n) asm volatile("s_waitcnt lgkmcnt(" #n ")" ::: "memory")
#define PG8_BAR __builtin_amdgcn_s_barrier()
#define PG8_SCHED __builtin_amdgcn_sched_barrier(0)
    Unit cur, nxt; int ui = 0;
    if (!S.next(0, cur)) return;
    f32x4 acc[2][2][4][2];
#pragma unroll
    for (int a = 0; a < 2; ++a)
#pragma unroll
        for (int b = 0; b < 2; ++b)
#pragma unroll
            for (int m = 0; m < 4; ++m)
#pragma unroll
                for (int n = 0; n < 2; ++n) acc[a][b][m][n] = (f32x4){0.f, 0.f, 0.f, 0.f};
    bf16x8 At[4][2], B0[2][2], B1[2][2];
    const char* cA = (const char*)g.A + (size_t)cur.pm * tstepA; const char* cB = (const char*)g.Bt + (size_t)cur.pn * tstepB;
    S.a_ready(cur);
    if constexpr (SP2) {
        PG8_STAGE(PG8_SB(0, 0), cB, voffB); PG8_STAGE(PG8_SB(0, 1), cB + hstepB, voffB); PG8_STAGE(PG8_SA(0, 0), cA, voffA); PG8_STAGE(PG8_SA(0, 1), cA + hstepA, voffA);
        if (wr == 1) PG8_BAR;
        PG8_WAIT_V(2); PG8_BAR;
        PG8_STAGE(PG8_SB(1, 0), cB + kstep, voffB); PG8_STAGE(PG8_SA(1, 0), cA + kstep, voffA); PG8_STAGE(PG8_SB(1, 1), cB + hstepB + kstep, voffB);
        PG8_WAIT_V(6); PG8_BAR;
    } else {
        PG8_STAGE(PG8_SB(0, 0), cB, voffB); PG8_STAGE(PG8_SA(0, 0), cA, voffA); PG8_STAGE(PG8_SB(0, 1), cB + hstepB, voffB); PG8_STAGE(PG8_SA(0, 1), cA + hstepA, voffA);
        if (wr == 1) PG8_BAR;
        PG8_WAIT_V(4); PG8_BAR;
        PG8_STAGE(PG8_SB(1, 0), cB + kstep, voffB); PG8_STAGE(PG8_SA(1, 0), cA + kstep, voffA); PG8_STAGE(PG8_SB(1, 1), cB + hstepB + kstep, voffB);
        PG8_WAIT_V(6); PG8_BAR;
    }
    for (;;) {
        const bool has_next = S.next(ui + 1, nxt);
        const char* nA = has_next ? (const char*)g.A + (size_t)nxt.pm * tstepA : cA; const char* nB = has_next ? (const char*)g.Bt + (size_t)nxt.pn * tstepB : cB;
        for (int t = 0; t < nt; t += 2) {
            const bool last = (t == nt - 2);
            const char* a1 = cA + (size_t)(t + 1) * kstep;
            const char* a2 = last ? nA : cA + (size_t)(t + 2) * kstep; const char* b2 = last ? nB : cB + (size_t)(t + 2) * kstep;
            const char* a3 = a2 + kstep; const char* b3 = b2 + kstep;
            if (last && has_next) S.a_ready(nxt);
            if constexpr (SP2) {
            PG8_LDB(B0, 0, 0); PG8_LDB(B1, 0, 1); PG8_SCHED; PG8_LDA(At, 0, 0); PG8_STAGE(PG8_SA(1, 1), a1 + hstepA, voffA);
            PG8_WAIT_V(8); PG8_WAIT_L(0); PG8_BAR; PG8_MMA(0, 0, At, B0); PG8_MMA(0, 1, At, B1); PG8_BAR; PG8_SCHED;
            PG8_LDA(At, 0, 1); PG8_STAGE(PG8_SB(0, 0), b2, voffB); PG8_STAGE(PG8_SB(0, 1), b2 + hstepB, voffB); PG8_STAGE(PG8_SA(0, 0), a2, voffA);
            PG8_WAIT_V(8); PG8_WAIT_L(0); PG8_BAR; PG8_MMA(1, 0, At, B0); PG8_MMA(1, 1, At, B1); PG8_BAR; PG8_SCHED;
            PG8_LDB(B0, 1, 0); PG8_LDB(B1, 1, 1); PG8_SCHED; PG8_LDA(At, 1, 0); PG8_STAGE(PG8_SA(0, 1), a2 + hstepA, voffA);
            PG8_WAIT_V(8); PG8_WAIT_L(0); PG8_BAR; PG8_MMA(0, 0, At, B0); PG8_MMA(0, 1, At, B1); PG8_BAR; PG8_SCHED;
            PG8_LDA(At, 1, 1); PG8_STAGE(PG8_SB(1, 0), b3, voffB); PG8_STAGE(PG8_SB(1, 1), b3 + hstepB, voffB); PG8_STAGE(PG8_SA(1, 0), a3, voffA);
            PG8_WAIT_V(8); PG8_WAIT_L(0); PG8_BAR; PG8_MMA(1, 0, At, B0); PG8_MMA(1, 1, At, B1); PG8_BAR; PG8_SCHED;
            } else {
            PG8_LDB(B0, 0, 0); PG8_SCHED; PG8_LDA(At, 0, 0); PG8_STAGE(PG8_SA(1, 1), a1 + hstepA, voffA);
            PG8_WAIT_L(8); PG8_BAR; PG8_WAIT_L(0); PG8_MMA(0, 0, At, B0); PG8_BAR; PG8_SCHED;
            PG8_LDB(B1, 0, 1); PG8_STAGE(PG8_SB(0, 0), b2, voffB);
            PG8_BAR; PG8_WAIT_L(0); PG8_MMA(0, 1, At, B1); PG8_BAR;
            PG8_LDA(At, 0, 1); PG8_STAGE(PG8_SA(0, 0), a2, voffA);
            PG8_BAR; PG8_WAIT_L(0); PG8_MMA(1, 0, At, B0); PG8_BAR; PG8_SCHED;
            PG8_STAGE(PG8_SB(0, 1), b2 + hstepB, voffB);
            PG8_WAIT_V(6); PG8_BAR; PG8_MMA(1, 1, At, B1); PG8_BAR;
            PG8_LDB(B0, 1, 0); PG8_SCHED; PG8_LDA(At, 1, 0); PG8_STAGE(PG8_SA(0, 1), a2 + hstepA, voffA);
            PG8_WAIT_L(8); PG8_BAR; PG8_WAIT_L(0); PG8_MMA(0, 0, At, B0); PG8_BAR; PG8_SCHED;
            PG8_LDB(B1, 1, 1); PG8_STAGE(PG8_SB(1, 0), b3, voffB);
            PG8_BAR; PG8_WAIT_L(0); PG8_MMA(0, 1, At, B1); PG8_BAR;
            PG8_LDA(At, 1, 1); PG8_STAGE(PG8_SA(1, 0), a3, voffA);
            PG8_BAR; PG8_WAIT_L(0); PG8_MMA(1, 0, At, B0); PG8_BAR; PG8_SCHED;
            PG8_STAGE(PG8_SB(1, 1), b3 + hstepB, voffB);
            PG8_WAIT_V(6); PG8_BAR; PG8_MMA(1, 1, At, B1); PG8_BAR;
            }
        }
        if constexpr (ALIGN_EPI) { if (wr == 0) PG8_BAR; }
        if constexpr (!Epi::AFTER_DRAIN) { E(acc, cur, wr, wc, fr, fq); S.done(cur); }
        if (!has_next) break;
#pragma unroll
        for (int a = 0; a < 2; ++a)
#pragma unroll
            for (int b = 0; b < 2; ++b)
#pragma unroll
                for (int m = 0; m < 4; ++m)
#pragma unroll
                    for (int n = 0; n < 2; ++n) acc[a][b][m][n] = (f32x4){0.f, 0.f, 0.f, 0.f};
        cur = nxt; cA = nA; cB = nB; ++ui;
        if constexpr (ALIGN_EPI) { if (wr == 1) PG8_BAR; }
    }
    PG8_WAIT_V(0);
    if constexpr (!ALIGN_EPI) { if (wr == 0) PG8_BAR; }
    PG8_BAR;
    if constexpr (Epi::AFTER_DRAIN) { E.fused(acc, cur, wr, wc, fr, fq, lds, wid, lane); S.done(cur); }
#undef PG8_SA
#undef PG8_SB
#undef PG8_STAGE
#undef PG8_LDA
#undef PG8_LDB
#undef PG8_MMA
#undef PG8_WAIT_V
#undef PG8_WAIT_L
#undef PG8_BAR
#undef PG8_SCHED
}
}
namespace pg8 {
typedef unsigned u32x2 __attribute__((ext_vector_type(2)));
constexpr int S_ = 16384;
__device__ __forceinline__ float hsum4(f32x4 a) { return (a[0] + a[1]) + (a[2] + a[3]); }
__device__ __forceinline__ float dot4(f32x4 a) { return (a[0] * a[0] + a[1] * a[1]) + (a[2] * a[2] + a[3] * a[3]); }
__device__ __forceinline__ float sumslots(const float* p, int n4) { float s = 0.f; for (int i = 0; i < n4; ++i) s += hsum4(*(const f32x4*)(p + 4 * i)); return s; }
__device__ __forceinline__ u32x4 pack8bf(f32x4 a, f32x4 b) { u32x4 w; w.x = cvt_pk_bf16(a[0], a[1]); w.y = cvt_pk_bf16(a[2], a[3]); w.z = cvt_pk_bf16(b[0], b[1]); w.w = cvt_pk_bf16(b[2], b[3]); return w; }
__device__ __forceinline__ float silu_mul(float g, float u) { const float e = __builtin_amdgcn_exp2f(g * -1.4426950408889634f); return g * __builtin_amdgcn_rcpf(1.f + e) * u; }
__device__ __forceinline__ float sigmoidf_(float z) { const float e = __builtin_amdgcn_exp2f(z * -1.4426950408889634f); return __builtin_amdgcn_rcpf(1.f + e); }
__device__ __forceinline__ f32x4 bf4_lo(u32x2 w) { return (f32x4){__uint_as_float(w.x << 16), __uint_as_float(w.x & 0xffff0000u), __uint_as_float(w.y << 16), __uint_as_float(w.y & 0xffff0000u)}; }

struct EpiSwiglu { static constexpr bool PERM = true, AFTER_DRAIN = false;
    bf16_t* H; const float* rs; int rs_slots; const __attribute__((address_space(3))) float* rt;
    __device__ __forceinline__ void operator()(const f32x4 (&acc)[2][2][4][2], const Unit& u, int wr, int wc, int fr, int fq) const {
        const int row0 = u.pm * BM + wr * 64 + fr, col0 = u.pn * 128 + wc * 32 + 8 * fq;
#pragma unroll
        for (int ai = 0; ai < 2; ++ai)
#pragma unroll
            for (int m = 0; m < 4; ++m) { const int row = row0 + ai * HALF + m * 16;
                const float r = rs_slots ? rt[row & 2047] : rs[row];
                f32x4 h0, h1;
#pragma unroll
                for (int e = 0; e < 4; ++e) { h0[e] = silu_mul(acc[ai][0][m][0][e] * r, acc[ai][1][m][0][e] * r); h1[e] = silu_mul(acc[ai][0][m][1][e] * r, acc[ai][1][m][1][e] * r); }
                *(u32x4*)(H + (size_t)row * 2816 + col0) = pack8bf(h0, h1); }
    }
};
template <bool BASE_BF16> struct EpiResid { static constexpr bool PERM = true, AFTER_DRAIN = false;
    const float* basef; bf16_t* xb; float* ssq; float scale; float pad;
    __device__ __forceinline__ void operator()(const f32x4 (&acc)[2][2][4][2], const Unit& u, int wr, int wc, int fr, int fq) const {
        const int row0 = u.pm * BM + wr * 64 + fr, col0 = u.pn * BM + wc * 32 + 8 * fq;
#pragma unroll
        for (int ai = 0; ai < 2; ++ai)
#pragma unroll
            for (int m = 0; m < 4; ++m) { const int row = row0 + ai * HALF + m * 16; float q = 0.f;
#pragma unroll
                for (int bj = 0; bj < 2; ++bj) { const size_t off = (size_t)row * 1024 + col0 + bj * HALF; f32x4 b0, b1;
                    if (BASE_BF16) { const u32x4 bw = *(const u32x4*)(xb + off); b0 = bf4_lo((u32x2){bw.x, bw.y}); b1 = bf4_lo((u32x2){bw.z, bw.w}); }
                    else { b0 = *(const f32x4*)(basef + off); b1 = *(const f32x4*)(basef + off + 4); }
                    const f32x4 v0 = b0 + acc[ai][bj][m][0] * scale, v1 = b1 + acc[ai][bj][m][1] * scale;
                    *(u32x4*)(xb + off) = pack8bf(v0, v1); q += dot4(v0) + dot4(v1); }
                q += __shfl_xor(q, 16); q += __shfl_xor(q, 32);
                if (fq == 0) ssq[(size_t)row * 16 + u.pn * 4 + wc] = q; }
    }
};
struct EpiProj { static constexpr bool PERM = true, AFTER_DRAIN = false;
    bf16_t* LAT; bf16_t* QKV; const __attribute__((address_space(3))) float* rt; float* ssql; int pn_base; int pad;
    __device__ __forceinline__ void operator()(const f32x4 (&acc)[2][2][4][2], const Unit& u, int wr, int wc, int fr, int fq) const {
        const int pe = u.pn + pn_base, lt = pe - 18; const int row0 = u.pm * BM + wr * 64 + fr; const bool lat = pe >= 18;
        const int t = pe, w = t / 6, cc = (t - w * 6) * 256;
        bf16_t* dst = lat ? LAT + lt * 256 : QKV + (size_t)w * ((size_t)S_ * 1536) + cc; const int ld = lat ? 768 : 1536;
#pragma unroll
        for (int ai = 0; ai < 2; ++ai)
#pragma unroll
            for (int m = 0; m < 4; ++m) { const int row = row0 + ai * HALF + m * 16;
                const float r = rt[row & 2047];
#pragma unroll
                for (int bj = 0; bj < 2; ++bj) { const f32x4 v0 = acc[ai][bj][m][0] * r, v1 = acc[ai][bj][m][1] * r;
                    *(u32x4*)(dst + (size_t)row * ld + bj * HALF + wc * 32 + 8 * fq) = pack8bf(v0, v1);
                    if (lat) { float q = dot4(v0) + dot4(v1); q += __shfl_xor(q, 16); q += __shfl_xor(q, 32); if (fq == 0) ssql[(size_t)row * 32 + lt * 8 + bj * 4 + wc] = q; } } }
    }
};
struct EpiGate { static constexpr bool PERM = true, AFTER_DRAIN = false;
    bf16_t* G; const float* b; const __attribute__((address_space(3))) float* rt;
    __device__ __forceinline__ void operator()(const f32x4 (&acc)[2][2][4][2], const Unit& u, int wr, int wc, int fr, int fq) const {
        const int row0 = u.pm * BM + wr * 64 + fr, col0 = u.pn * BM + wc * 32 + 8 * fq;
#pragma unroll
        for (int ai = 0; ai < 2; ++ai)
#pragma unroll
            for (int m = 0; m < 4; ++m) { const int row = row0 + ai * HALF + m * 16;
                const float r = rt[row & 2047];
#pragma unroll
                for (int bj = 0; bj < 2; ++bj) { const f32x4 b0 = *(const f32x4*)(b + col0 + bj * HALF), b1 = *(const f32x4*)(b + col0 + bj * HALF + 4);
                    f32x4 v0 = acc[ai][bj][m][0] * r + b0, v1 = acc[ai][bj][m][1] * r + b1;
#pragma unroll
                    for (int e = 0; e < 4; ++e) { v0[e] = sigmoidf_(v0[e]); v1[e] = sigmoidf_(v1[e]); }
                    *(u32x4*)(G + (size_t)row * 2048 + col0 + bj * HALF) = pack8bf(v0, v1); } }
    }
};
template <bool SECOND> struct EpiMerge { static constexpr bool PERM = true, AFTER_DRAIN = false;
    bf16_t* MG; const bf16_t* G;
    __device__ __forceinline__ void operator()(const f32x4 (&acc)[2][2][4][2], const Unit& u, int wr, int wc, int fr, int fq) const {
        const int row0 = u.pm * BM + wr * 64 + fr, col0 = u.pn * BM + wc * 32 + 8 * fq;
        const __attribute__((address_space(1))) bf16_t* Gg = (const __attribute__((address_space(1))) bf16_t*)G; __attribute__((address_space(1))) bf16_t* Mg = (__attribute__((address_space(1))) bf16_t*)MG;
#pragma unroll
        for (int ai = 0; ai < 2; ++ai) {
            u32x4 gw[4][2], pw[4][2];
#pragma unroll
            for (int m = 0; m < 4; ++m)
#pragma unroll
                for (int bj = 0; bj < 2; ++bj) { const int row = row0 + ai * HALF + m * 16, col = col0 + bj * HALF;
                    gw[m][bj] = *(const __attribute__((address_space(1))) u32x4*)(Gg + (size_t)row * 2048 + (SECOND ? 1024 : 0) + col);
                    if (SECOND) pw[m][bj] = *(const __attribute__((address_space(1))) u32x4*)(Mg + (size_t)row * 1024 + col); }
#pragma unroll
            for (int m = 0; m < 4; ++m)
#pragma unroll
                for (int bj = 0; bj < 2; ++bj) { const int row = row0 + ai * HALF + m * 16, col = col0 + bj * HALF; const u32x4 g4 = gw[m][bj];
                    f32x4 v0 = bf4_lo((u32x2){g4.x, g4.y}) * acc[ai][bj][m][0], v1 = bf4_lo((u32x2){g4.z, g4.w}) * acc[ai][bj][m][1];
                    if (SECOND) { const u32x4 p4 = pw[m][bj]; v0 += bf4_lo((u32x2){p4.x, p4.y}); v1 += bf4_lo((u32x2){p4.z, p4.w}); }
                    *(__attribute__((address_space(1))) u32x4*)(Mg + (size_t)row * 1024 + col) = pack8bf(v0, v1); } }
    }
};
struct EpiQUp { static constexpr bool PERM = false, AFTER_DRAIN = false;
    bf16_t* QF; const __attribute__((address_space(3))) float* rt; const float* cs; const float* sn;
    __device__ __forceinline__ void operator()(const f32x4 (&acc)[2][2][4][2], const Unit& u, int wr, int wc, int fr, int fq) const {
        const int row0 = u.pm * BM + wr * 64 + fr;
#pragma unroll
        for (int ai = 0; ai < 2; ++ai)
#pragma unroll
            for (int m = 0; m < 4; ++m) { const int row = row0 + ai * HALF + m * 16;
                const float r = rt[row & 2047];
#pragma unroll
                for (int bj = 0; bj < 2; ++bj) { const int cg = u.pn * BM + bj * HALF + wc * 32; const bool rope = (cg % 96) == 64;
                    f32x4 x1 = acc[ai][bj][m][0] * r, x2 = acc[ai][bj][m][1] * r;
                    if (rope) { const f32x4 c = *(const f32x4*)(cs + (size_t)row * 16 + 4 * fq), s = *(const f32x4*)(sn + (size_t)row * 16 + 4 * fq);
                        const f32x4 y1 = x1 * c - x2 * s, y2 = x1 * s + x2 * c; x1 = y1; x2 = y2; }
                    u32x2 w1, w2; w1.x = cvt_pk_bf16(x1[0], x1[1]); w1.y = cvt_pk_bf16(x1[2], x1[3]); w2.x = cvt_pk_bf16(x2[0], x2[1]); w2.y = cvt_pk_bf16(x2[2], x2[3]);
                    const bool oddq = (fq & 1) != 0; const u32x2 snd = oddq ? w1 : w2; u32x2 rcv; rcv.x = (unsigned)__shfl_xor((int)snd.x, 16); rcv.y = (unsigned)__shfl_xor((int)snd.y, 16);
                    const u32x4 ov = oddq ? (u32x4){rcv.x, rcv.y, w2.x, w2.y} : (u32x4){w1.x, w1.y, rcv.x, rcv.y};
                    *(u32x4*)(QF + (size_t)row * 768 + cg + 4 * fq + (oddq ? 12 : 0)) = ov; }
                asm volatile("" ::: "memory"); }
    }
};
struct EpiKVUp { static constexpr bool PERM = true, AFTER_DRAIN = false;
    bf16_t* KF; bf16_t* VV; const __attribute__((address_space(3))) float* rt;
    __device__ __forceinline__ void operator()(const f32x4 (&acc)[2][2][4][2], const Unit& u, int wr, int wc, int fr, int fq) const {
        const int row0 = u.pm * BM + wr * 64 + fr;
#pragma unroll
        for (int ai = 0; ai < 2; ++ai)
#pragma unroll
            for (int m = 0; m < 4; ++m) { const int row = row0 + ai * HALF + m * 16;
                const float r = rt[row & 2047];
#pragma unroll
                for (int bj = 0; bj < 2; ++bj) { const int h = u.pn * 2 + bj, d = wc * 32 + 8 * fq;
                    bf16_t* dst = (wc < 2) ? KF + (size_t)row * 768 + h * 96 + d : VV + (size_t)row * 512 + h * 64 + (d - 64);
                    *(u32x4*)dst = pack8bf(acc[ai][bj][m][0] * r, acc[ai][bj][m][1] * r); }
                asm volatile("" ::: "memory"); }
    }
};
#define PGAS __attribute__((address_space(1)))
struct EpiFinal { static constexpr bool PERM = true, AFTER_DRAIN = false;
    const PGAS bf16_t* base; PGAS float* out; const PGAS float* gfin; unsigned* slots; unsigned* cnt; float scale; float pad;
    __device__ __forceinline__ void operator()(f32x4 (&acc)[2][2][4][2], const Unit& u, int wr, int wc, int fr, int fq) const {
        const int row0 = u.pm * BM + wr * 64 + fr, col0 = u.pn * BM + wc * 32 + 8 * fq;
        { u32x4 bw[2][4][2];
#pragma unroll
          for (int ai = 0; ai < 2; ++ai)
#pragma unroll
            for (int m = 0; m < 4; ++m)
#pragma unroll
                for (int bj = 0; bj < 2; ++bj) bw[ai][m][bj] = *(const PGAS u32x4*)(base + (size_t)(row0 + ai * HALF + m * 16) * 1024 + col0 + bj * HALF);
#pragma unroll
          for (int ai = 0; ai < 2; ++ai)
#pragma unroll
            for (int m = 0; m < 4; ++m) { const int row = row0 + ai * HALF + m * 16; float q = 0.f;
#pragma unroll
                for (int bj = 0; bj < 2; ++bj) { const u32x4 w = bw[ai][m][bj];
                    const f32x4 v0 = bf4_lo((u32x2){w.x, w.y}) + acc[ai][bj][m][0] * scale, v1 = bf4_lo((u32x2){w.z, w.w}) + acc[ai][bj][m][1] * scale;
                    acc[ai][bj][m][0] = v0; acc[ai][bj][m][1] = v1; q += dot4(v0) + dot4(v1); }
                q += __shfl_xor(q, 16); q += __shfl_xor(q, 32);
                if (fq == 0) __hip_atomic_store(slots + (size_t)row * 16 + u.pn * 4 + wc, __float_as_uint(q), __ATOMIC_RELAXED, __HIP_MEMORY_SCOPE_AGENT); } }
        asm volatile("s_waitcnt vmcnt(0)" ::: "memory");
        unsigned* c = cnt + 64 * u.pm;
        if (fr == 0 && fq == 0) __hip_atomic_fetch_add(c, 1u, __ATOMIC_RELAXED, __HIP_MEMORY_SCOPE_AGENT);
        { unsigned sp = 0; while ((unsigned)__builtin_amdgcn_readfirstlane(__hip_atomic_load(c, __ATOMIC_RELAXED, __HIP_MEMORY_SCOPE_AGENT)) < 32u) { __builtin_amdgcn_s_sleep(2); if (++sp > (1u << 22)) break; } }
        asm volatile("" ::: "memory");
        unsigned long long sw[2][4][2];
#pragma unroll
        for (int ai = 0; ai < 2; ++ai)
#pragma unroll
            for (int m = 0; m < 4; ++m) { const unsigned long long* sl = (const unsigned long long*)(slots + (size_t)(row0 + ai * HALF + m * 16) * 16 + 4 * fq);
                sw[ai][m][0] = __hip_atomic_load(sl, __ATOMIC_RELAXED, __HIP_MEMORY_SCOPE_AGENT); sw[ai][m][1] = __hip_atomic_load(sl + 1, __ATOMIC_RELAXED, __HIP_MEMORY_SCOPE_AGENT); }
#pragma unroll
        for (int ai = 0; ai < 2; ++ai)
#pragma unroll
            for (int m = 0; m < 4; ++m) { const int row = row0 + ai * HALF + m * 16;
                float ss = (__uint_as_float((unsigned)sw[ai][m][0]) + __uint_as_float((unsigned)(sw[ai][m][0] >> 32))) + (__uint_as_float((unsigned)sw[ai][m][1]) + __uint_as_float((unsigned)(sw[ai][m][1] >> 32)));
                ss += __shfl_xor(ss, 16); ss += __shfl_xor(ss, 32);
                const float r = rsqrtf(ss * (1.f / 1024.f) + 1e-6f);
#pragma unroll
                for (int bj = 0; bj < 2; ++bj) { const size_t off = (size_t)row * 1024 + col0 + bj * HALF;
                    const f32x4 g0 = *(const PGAS f32x4*)(gfin + col0 + bj * HALF), g1 = *(const PGAS f32x4*)(gfin + col0 + bj * HALF + 4);
                    *(PGAS f32x4*)(out + off) = acc[ai][bj][m][0] * r * g0; *(PGAS f32x4*)(out + off + 4) = acc[ai][bj][m][1] * r * g1; } }
    }
};
}

namespace mla {
#define MLAS __attribute__((address_space(3)))
#define MGAS __attribute__((address_space(1)))
constexpr int NW = 8, QBLK = 32, KVBLK = 64, QB = NW * QBLK, QS = 768, KS = 768, VS = 512, OS = 512, NSTEP = 6;
constexpr int SHM_V = KVBLK * 64 * 2, SHM_K = KVBLK * 256;
constexpr int LDS_BYTES = 2 * SHM_V + 2 * SHM_K + NW * 64 * 4;
constexpr float SCALE = 0.10206207261596575f, THR = 8.f;
constexpr unsigned WIN = 0x40000000u;
typedef short bf16x8 __attribute__((ext_vector_type(8)));
typedef short s16x4 __attribute__((ext_vector_type(4)));
typedef float f32x16 __attribute__((ext_vector_type(16)));
typedef unsigned u32x4 __attribute__((ext_vector_type(4)));
#define MLA_KSWZ(row, colB) ((row) * 256 + ((colB) ^ (((row) & 7) << 4)))
#define MLA_SBAR() __builtin_amdgcn_sched_barrier(0)
__device__ __forceinline__ int v_st(int k, int c) { const int kk = (k & ~0xC) | ((k & 4) << 1) | ((k & 8) >> 1); return ((kk >> 3) * 2 + (c >> 5)) * 512 + ((kk & 7) * 32 + (c & 31)) * 2; }
__device__ __forceinline__ int v_rd_base(int lane) { return ((lane & 3) << 3) | (((lane >> 2) & 3) << 6) | (((lane >> 4) & 1) << 5) | (((lane >> 5) & 1) << 8); }
__device__ __forceinline__ int crow(int r, int hi) { return (r & 3) + 8 * (r >> 2) + 4 * hi; }
__device__ __forceinline__ unsigned cvtpk(float lo, float hi) { unsigned r; asm volatile("v_cvt_pk_bf16_f32 %0, %1, %2" : "=v"(r) : "v"(lo), "v"(hi)); return r; }
__device__ __forceinline__ void mask_tile(f32x16& p0, f32x16& p1, int dq) {
    const float NEG = -__builtin_inff();
#pragma unroll
    for (int r = 0; r < 16; ++r) { const int c = (r & 3) + 8 * (r >> 2);
        if ((unsigned)(dq - c) >= WIN) p0[r] = NEG;
        if ((unsigned)(dq - c - 32) >= WIN) p1[r] = NEG; }
}
__device__ __forceinline__ void partialSM(f32x16& p0, f32x16& p1, float& m_reg, float& mn, float& alpha) {
    float pm_[4] = {p0[0], p0[1], p0[2], p0[3]};
#pragma unroll
    for (int r = 4; r < 16; ++r) pm_[r & 3] = fmaxf(pm_[r & 3], p0[r]);
#pragma unroll
    for (int r = 0; r < 16; ++r) pm_[r & 3] = fmaxf(pm_[r & 3], p1[r]);
    float pmax = fmaxf(fmaxf(pm_[0], pm_[1]), fmaxf(pm_[2], pm_[3]));
    { auto rr = __builtin_amdgcn_permlane32_swap(__float_as_uint(pmax), __float_as_uint(pmax), false, false);
      pmax = fmaxf(__uint_as_float(rr[0]), __uint_as_float(rr[1])); }
    constexpr float C2 = 1.4426950408889634f * SCALE;
    if (__builtin_expect(__all((pmax - m_reg) * SCALE <= THR), 1)) { mn = m_reg; alpha = 1.f; }
    else { mn = fmaxf(m_reg, pmax); alpha = __builtin_amdgcn_exp2f((m_reg - mn) * C2); m_reg = mn; }
    const float mnL = -mn * C2;
#pragma unroll
    for (int r = 0; r < 16; ++r) p0[r] = fmaf(p0[r], C2, mnL);
#pragma unroll
    for (int r = 0; r < 16; ++r) p1[r] = fmaf(p1[r], C2, mnL);
#pragma unroll
    for (int r = 0; r < 16; ++r) p0[r] = __builtin_amdgcn_exp2f(p0[r]);
}
__device__ __forceinline__ void finishSM(f32x16& p0, f32x16& p1, float alpha, float& l_reg, bf16x8& pa0, bf16x8& pa1, bf16x8& pa2, bf16x8& pa3) {
#pragma unroll
    for (int r = 0; r < 16; ++r) p1[r] = __builtin_amdgcn_exp2f(p1[r]);
    float ps_[4] = {0.f, 0.f, 0.f, 0.f};
#pragma unroll
    for (int r = 0; r < 16; ++r) ps_[r & 3] += p0[r];
#pragma unroll
    for (int r = 0; r < 16; ++r) ps_[r & 3] += p1[r];
    float ps = (ps_[0] + ps_[1]) + (ps_[2] + ps_[3]);
    { auto rr = __builtin_amdgcn_permlane32_swap(__float_as_uint(ps), __float_as_uint(ps), false, false);
      ps = __uint_as_float(rr[0]) + __uint_as_float(rr[1]); }
    l_reg = l_reg * alpha + ps;
#define MLA_PK4(P, B_, OUT) do { unsigned a0 = cvtpk(P[B_+0], P[B_+1]), a1 = cvtpk(P[B_+2], P[B_+3]);                          \
        unsigned b0 = cvtpk(P[B_+4], P[B_+5]), b1 = cvtpk(P[B_+6], P[B_+7]);                                             \
        auto r0 = __builtin_amdgcn_permlane32_swap(a0, b0, false, false); auto r1 = __builtin_amdgcn_permlane32_swap(a1, b1, false, false); \
        u32x4 w = {r0[0], r1[0], r0[1], r1[1]}; OUT = *reinterpret_cast<bf16x8*>(&w); } while (0)
    MLA_PK4(p0, 0, pa0); MLA_PK4(p0, 8, pa1); MLA_PK4(p1, 0, pa2); MLA_PK4(p1, 8, pa3);
#undef MLA_PK4
}
template <int KB>
__device__ __forceinline__ void qkt(f32x16& p0, f32x16& p1, const MLAS char* K_lds, int r32, int hi, const bf16x8* qr) {
    p0 = f32x16{}; p1 = f32x16{};
    const MLAS char* kb[4];
#pragma unroll
    for (int dd = 0; dd < 4; ++dd) kb[dd] = K_lds + KB * SHM_K + MLA_KSWZ(r32, (dd * 16 + hi * 8) * 2);
#pragma unroll
    for (int d0 = 0; d0 < NSTEP; ++d0) { const MLAS char* a = kb[d0 & 3] + (d0 >> 2) * 128;
        bf16x8 b0 = *(const MLAS bf16x8*)(a);
        bf16x8 b1 = *(const MLAS bf16x8*)(a + 32 * 256);
        p0 = __builtin_amdgcn_mfma_f32_32x32x16_bf16(b0, qr[d0], p0, 0, 0, 0);
        p1 = __builtin_amdgcn_mfma_f32_32x32x16_bf16(b1, qr[d0], p1, 0, 0, 0);
        if (d0 == 2) __builtin_amdgcn_sched_barrier(0); }
}
template <int VB>
__device__ __forceinline__ void pv_tile(f32x16* o, int vb0, bf16x8 pa0, bf16x8 pa1, bf16x8 pa2, bf16x8 pa3) {
#define MLA_TRRD(dst, off) asm volatile("ds_read_b64_tr_b16 %0, %1 offset:%2" : "=&v"(dst) : "v"(vb0), "i"(off) : "memory")
#define MLA_PV_D0(d0) do { s16x4 l0, l1, l2, l3, h0, h1, h2, h3; constexpr int b_ = VB * SHM_V + (d0) * 512;     \
        MLA_TRRD(l0, b_); MLA_TRRD(h0, b_ + 1024); MLA_TRRD(l1, b_ + 2048); MLA_TRRD(h1, b_ + 3072); MLA_TRRD(l2, b_ + 4096); MLA_TRRD(h2, b_ + 5120); MLA_TRRD(l3, b_ + 6144); MLA_TRRD(h3, b_ + 7168); \
        asm volatile("s_waitcnt lgkmcnt(0)" ::: "memory"); MLA_SBAR();   \
        o[d0] = __builtin_amdgcn_mfma_f32_32x32x16_bf16(pa0, (bf16x8){l0[0], l0[1], l0[2], l0[3], h0[0], h0[1], h0[2], h0[3]}, o[d0], 0, 0, 0);   \
        o[d0] = __builtin_amdgcn_mfma_f32_32x32x16_bf16(pa1, (bf16x8){l1[0], l1[1], l1[2], l1[3], h1[0], h1[1], h1[2], h1[3]}, o[d0], 0, 0, 0);   \
        o[d0] = __builtin_amdgcn_mfma_f32_32x32x16_bf16(pa2, (bf16x8){l2[0], l2[1], l2[2], l2[3], h2[0], h2[1], h2[2], h2[3]}, o[d0], 0, 0, 0);   \
        o[d0] = __builtin_amdgcn_mfma_f32_32x32x16_bf16(pa3, (bf16x8){l3[0], l3[1], l3[2], l3[3], h3[0], h3[1], h3[2], h3[3]}, o[d0], 0, 0, 0); } while (0)
    MLA_PV_D0(0); MLA_PV_D0(1);
#undef MLA_PV_D0
#undef MLA_TRRD
}
__device__ __forceinline__ void qkt_rt(f32x16& p0, f32x16& p1, const MLAS char* K_s, int r32, int hi, const bf16x8* qr) {
    p0 = f32x16{}; p1 = f32x16{};
    const MLAS char* kb[6];
#pragma unroll
    for (int d0 = 0; d0 < 6; ++d0) kb[d0] = K_s + r32 * 256 + (((2 * d0 + hi) ^ (r32 & 15)) << 4);
    bf16x8 f0[3], f1[3], g0[3], g1[3];
#pragma unroll
    for (int d0 = 0; d0 < 3; ++d0) { const MLAS char* a = kb[d0]; f0[d0] = *(const MLAS bf16x8*)(a); f1[d0] = *(const MLAS bf16x8*)(a + 32 * 256); }
    __builtin_amdgcn_sched_barrier(0);
#pragma unroll
    for (int d0 = 3; d0 < 6; ++d0) { const MLAS char* a = kb[d0]; g0[d0 - 3] = *(const MLAS bf16x8*)(a); g1[d0 - 3] = *(const MLAS bf16x8*)(a + 32 * 256); }
#pragma unroll
    for (int d0 = 0; d0 < 3; ++d0) { p0 = __builtin_amdgcn_mfma_f32_32x32x16_bf16(f0[d0], qr[d0], p0, 0, 0, 0); p1 = __builtin_amdgcn_mfma_f32_32x32x16_bf16(f1[d0], qr[d0], p1, 0, 0, 0); }
    __builtin_amdgcn_sched_barrier(0);
#pragma unroll
    for (int d0 = 3; d0 < 6; ++d0) { p0 = __builtin_amdgcn_mfma_f32_32x32x16_bf16(g0[d0 - 3], qr[d0], p0, 0, 0, 0); p1 = __builtin_amdgcn_mfma_f32_32x32x16_bf16(g1[d0 - 3], qr[d0], p1, 0, 0, 0); }
}
__device__ __forceinline__ void pv_rt(f32x16* o, int vb, bf16x8 pa0, bf16x8 pa1, bf16x8 pa2, bf16x8 pa3) {
#define MLA_TRRD(dst, off) asm volatile("ds_read_b64_tr_b16 %0, %1 offset:%2" : "=&v"(dst) : "v"(vb), "i"(off) : "memory")
    s16x4 l0, l1, l2, l3, h0, h1, h2, h3, m0, m1, m2, m3, n0, n1, n2, n3;
    MLA_TRRD(l0, 0); MLA_TRRD(h0, 1024); MLA_TRRD(l1, 2048); MLA_TRRD(h1, 3072); MLA_TRRD(l2, 4096); MLA_TRRD(h2, 5120); MLA_TRRD(l3, 6144); MLA_TRRD(h3, 7168);
    MLA_TRRD(m0, 512); MLA_TRRD(n0, 1536); MLA_TRRD(m1, 2560); MLA_TRRD(n1, 3584); MLA_TRRD(m2, 4608); MLA_TRRD(n2, 5632); MLA_TRRD(m3, 6656); MLA_TRRD(n3, 7680);
    asm volatile("s_waitcnt lgkmcnt(8)" ::: "memory"); MLA_SBAR();
    o[0] = __builtin_amdgcn_mfma_f32_32x32x16_bf16(pa0, (bf16x8){l0[0], l0[1], l0[2], l0[3], h0[0], h0[1], h0[2], h0[3]}, o[0], 0, 0, 0);
    o[0] = __builtin_amdgcn_mfma_f32_32x32x16_bf16(pa1, (bf16x8){l1[0], l1[1], l1[2], l1[3], h1[0], h1[1], h1[2], h1[3]}, o[0], 0, 0, 0);
    o[0] = __builtin_amdgcn_mfma_f32_32x32x16_bf16(pa2, (bf16x8){l2[0], l2[1], l2[2], l2[3], h2[0], h2[1], h2[2], h2[3]}, o[0], 0, 0, 0);
    o[0] = __builtin_amdgcn_mfma_f32_32x32x16_bf16(pa3, (bf16x8){l3[0], l3[1], l3[2], l3[3], h3[0], h3[1], h3[2], h3[3]}, o[0], 0, 0, 0);
    asm volatile("s_waitcnt lgkmcnt(0)" ::: "memory"); MLA_SBAR();
    o[1] = __builtin_amdgcn_mfma_f32_32x32x16_bf16(pa0, (bf16x8){m0[0], m0[1], m0[2], m0[3], n0[0], n0[1], n0[2], n0[3]}, o[1], 0, 0, 0);
    o[1] = __builtin_amdgcn_mfma_f32_32x32x16_bf16(pa1, (bf16x8){m1[0], m1[1], m1[2], m1[3], n1[0], n1[1], n1[2], n1[3]}, o[1], 0, 0, 0);
    o[1] = __builtin_amdgcn_mfma_f32_32x32x16_bf16(pa2, (bf16x8){m2[0], m2[1], m2[2], m2[3], n2[0], n2[1], n2[2], n2[3]}, o[1], 0, 0, 0);
    o[1] = __builtin_amdgcn_mfma_f32_32x32x16_bf16(pa3, (bf16x8){m3[0], m3[1], m3[2], m3[3], n3[0], n3[1], n3[2], n3[3]}, o[1], 0, 0, 0);
#undef MLA_TRRD
}
struct BlockRef { const MGAS bf16_t* Q; const MGAS bf16_t* K; const MGAS bf16_t* V; MGAS bf16_t* O; int P0; };
constexpr int KRING = 0, VRING = 3 * SHM_K, WSF_OFF = VRING + 4 * SHM_V, LDS_BYTES2 = WSF_OFF + NW * 64 * 4;
#define MLA_VMC(n) asm volatile("s_waitcnt vmcnt(" #n ")" ::: "memory")
#define MLA_BARX() asm volatile("s_waitcnt lgkmcnt(0)\n\ts_barrier" ::: "memory")
__device__ __forceinline__ void block2(const BlockRef& cur, MLAS char* lds, int wid, int lane) {
    const int r32 = lane & 31, hi = lane >> 5;
    const int NT = (cur.P0 + QB - 1) / KVBLK + 1;
    const int qlo = cur.P0 + wid * QBLK, qm = qlo + r32 - 4 * hi;
    MLAS char* K_lds = lds + KRING; MLAS char* V_lds = lds + VRING;
    MLAS float* wsf = (MLAS float*)(lds + WSF_OFF) + wid * 64; MLAS float* li_l = wsf; MLAS float* al_l = wsf + 32;
    unsigned kso[2];
#pragma unroll
    for (int i = 0; i < 2; ++i) { const int row = 4 * (2 * wid + i) + (lane >> 4), c = (lane & 15) ^ (row & 15), ce = c < 12 ? c : c - 4; kso[i] = (unsigned)(row * KS * 2 + ce * 16); }
    unsigned vso; { const int kk = wid * 8 + ((lane & 31) >> 2), k = (kk & ~0xC) | ((kk & 4) << 1) | ((kk & 8) >> 1), c = (lane >> 5) * 32 + (lane & 3) * 8; vso = (unsigned)(k * VS * 2 + c * 2); }
    const MGAS char* Kb = (const MGAS char*)cur.K; const MGAS char* Vb = (const MGAS char*)cur.V;
#define MLA_DMA(t, koff, voff) do { const MGAS char* kt_ = Kb + (size_t)(t) * (KVBLK * KS * 2); const MGAS char* vt_ = Vb + (size_t)(t) * (KVBLK * VS * 2);          \
        __builtin_amdgcn_global_load_lds((const MGAS unsigned*)(kt_ + kso[0]), (MLAS unsigned*)(K_lds + (koff) + (2 * wid) * 1024), 16, 0, 0);                          \
        __builtin_amdgcn_global_load_lds((const MGAS unsigned*)(kt_ + kso[1]), (MLAS unsigned*)(K_lds + (koff) + (2 * wid + 1) * 1024), 16, 0, 0);                      \
        __builtin_amdgcn_global_load_lds((const MGAS unsigned*)(vt_ + vso), (MLAS unsigned*)(V_lds + (voff) + wid * 1024), 16, 0, 0); } while (0)
    bf16x8 qr[NSTEP];
#pragma unroll
    for (int d0 = 0; d0 < NSTEP; ++d0) qr[d0] = *(const MGAS bf16x8*)(cur.Q + (size_t)(wid * QBLK + r32) * QS + d0 * 16 + hi * 8);
    float m_reg = -1e30f, l_reg = 0; f32x16 o[2] = {};
    const int vb0 = (int)(unsigned)(__UINTPTR_TYPE__)V_lds + v_rd_base(lane);
#define MLA_RESC(a) do { if (__any((a) < 1.f)) { if (hi == 0) al_l[r32] = (a); asm volatile("s_waitcnt lgkmcnt(0)" ::: "memory");              \
                     _Pragma("unroll") for (int d_ = 0; d_ < 2; ++d_) _Pragma("unroll") for (int r = 0; r < 16; ++r) o[d_][r] *= al_l[crow(r, hi)]; } } while (0)
#define MLA_MASKT(P0_, P1_, t) do { const int kb_ = (t) * KVBLK; if (__builtin_expect(__builtin_amdgcn_readfirstlane((int)(kb_ + KVBLK - 1 > qlo)) != 0, 0)) { asm volatile("" ::: "memory"); mask_tile(P0_, P1_, qm - kb_); } } while (0)
    f32x16 pA0, pA1, pB0, pB1; float mnA, mnB, alA, alB; bf16x8 pa0, pa1, pa2, pa3;
    int kc = 0, vc = 0;
#define MLA_KNEXT(x) ((x) == 2 * SHM_K ? 0 : (x) + SHM_K)
#define MLA_VNEXT(x) (((x) + SHM_V) & (4 * SHM_V - 1))
    MLA_DMA(0, 0, 0); MLA_DMA(1, SHM_K, SHM_V);
    MLA_VMC(3); MLA_BARX();
    MLA_SBAR(); qkt_rt(pA0, pA1, K_lds + kc, r32, hi, qr);
    MLA_MASKT(pA0, pA1, 0); partialSM(pA0, pA1, m_reg, mnA, alA);
    MLA_DMA(2, 2 * SHM_K, 2 * SHM_V);
    MLA_RESC(alA);
    MLA_VMC(3); MLA_BARX();
#define MLA_STEP(PX0, PX1, mnX, alX, PY0, PY1, alY, t) do {                                                                        \
        const int kp_ = kc, vp_ = vc; kc = MLA_KNEXT(kc); vc = MLA_VNEXT(vc);                \
        MLA_SBAR(); qkt_rt(PX0, PX1, K_lds + kc, r32, hi, qr);                                                                    \
        finishSM(PY0, PY1, alY, l_reg, pa0, pa1, pa2, pa3); MLA_SBAR();                                                            \
        pv_rt(o, vb0 + vp_, pa0, pa1, pa2, pa3); MLA_MASKT(PX0, PX1, (t)); partialSM(PX0, PX1, m_reg, mnX, alX);                    \
        if ((t) + 2 < NT) { MLA_DMA((t) + 2, kp_, MLA_VNEXT(MLA_VNEXT(vc))); }              \
        MLA_RESC(alX);                                                                                                             \
        if ((t) + 1 < NT) { if ((t) + 2 < NT) MLA_VMC(3); else MLA_VMC(0); MLA_BARX(); } } while (0)
    int t = 1;
    for (; t + 1 < NT; t += 2) {
        MLA_STEP(pB0, pB1, mnB, alB, pA0, pA1, alA, t);
        MLA_STEP(pA0, pA1, mnA, alA, pB0, pB1, alB, t + 1);
    }
    MLA_STEP(pB0, pB1, mnB, alB, pA0, pA1, alA, NT - 1);
    MLA_SBAR(); finishSM(pB0, pB1, alB, l_reg, pa0, pa1, pa2, pa3); MLA_SBAR(); pv_rt(o, vb0 + vc, pa0, pa1, pa2, pa3);
    if (hi == 0) li_l[r32] = l_reg; asm volatile("s_waitcnt lgkmcnt(0)" ::: "memory");
    MGAS bf16_t* Ow = cur.O + (size_t)(wid * QBLK) * OS;
#pragma unroll
    for (int r = 0; r < 16; ++r) { const int orow = crow(r, hi); const float rl = __builtin_amdgcn_rcpf(li_l[orow]);
#pragma unroll
        for (int d0 = 0; d0 < 2; ++d0) { const float v = o[d0][r] * rl; const float vn = __shfl_xor(v, 1);
            if ((r32 & 1) == 0) *(MGAS unsigned*)(Ow + (size_t)orow * OS + d0 * 32 + r32) = cvtpk(v, vn); } }
    MLA_BARX();
#undef MLA_RESC
#undef MLA_MASKT
#undef MLA_STEP
#undef MLA_DMA
}
constexpr int K5_SLOT = 16384, V5_SLOT = 8192, L5_K = 0, L5_V = 4 * K5_SLOT, L5_WS = L5_V + 4 * V5_SLOT, L5_OST = L5_WS + NW * 256, L5_BYTES = L5_OST + NW * 4096;
constexpr float THR5 = 8.f;
typedef const MLAS char* lcp;
typedef short v4i16_t __attribute__((ext_vector_type(4)));
__device__ __forceinline__ s16x4 vtr5(lcp p) { return __builtin_bit_cast(s16x4, __builtin_amdgcn_ds_read_tr16_b64_v4i16((MLAS v4i16_t*)p)); }
__device__ __forceinline__ unsigned cvtpk5(float lo, float hi) { unsigned r; asm("v_cvt_pk_bf16_f32 %0, %1, %2" : "=v"(r) : "v"(lo), "v"(hi)); return r; }
#define MX3(a, b, c) __builtin_fmaxf(__builtin_fmaxf((a), (b)), (c))
__device__ __forceinline__ float halfmax5(const f32x16& p0, const f32x16& p1) {
    float a = MX3(p0[0], p0[1], p1[0]), b = MX3(p0[2], p0[3], p1[1]); a = MX3(a, p1[2], p1[3]);
#pragma unroll
    for (int r = 4; r < 16; r += 4) { a = MX3(a, p0[r], p0[r + 1]); b = MX3(b, p0[r + 2], p0[r + 3]); a = MX3(a, p1[r], p1[r + 1]); b = MX3(b, p1[r + 2], p1[r + 3]); }
    return __builtin_fmaxf(a, b); }
__device__ __forceinline__ float mergehalves5(float m) { auto rr = __builtin_amdgcn_permlane32_swap(__float_as_uint(m), __float_as_uint(m), false, false);
    return __builtin_fmaxf(__uint_as_float(rr[0]), __uint_as_float(rr[1])); }
__device__ __forceinline__ float rowmax5(const f32x16& p0, const f32x16& p1) { return mergehalves5(halfmax5(p0, p1)); }
#undef MX3
__device__ __forceinline__ void cmask5(f32x16& p0, f32x16& p1, int jb, int qrel, int hi) {
    int dq = qrel - 64 * jb - 4 * hi; asm volatile("" : "+v"(dq)); const float NEG = -__builtin_inff();
#pragma unroll
    for (int r = 0; r < 16; ++r) { const int c = (r & 3) + 8 * (r >> 2); if (c > dq) p0[r] = NEG; if (c + 32 > dq) p1[r] = NEG; } }
__device__ __forceinline__ void block5(const BlockRef& cur, MLAS char* lds, int wid, int lane) {
    asm volatile("" : "+v"(lane));
    const int r32 = lane & 31, hi = lane >> 5;
    const int q0 = cur.P0, NT = (q0 + QB) / KVBLK;
    MLAS float* wsf = (MLAS float*)(lds + L5_WS) + wid * 64;
    unsigned kso[2];
#pragma unroll
    for (int i = 0; i < 2; ++i) { const int row = 4 * (2 * wid + i) + (lane >> 4), c = (lane & 15) ^ (row & 15), ce = c < 12 ? c : c - 4; kso[i] = (unsigned)(row * KS * 2 + ce * 16); }
    const unsigned vso = (unsigned)(((16 * (wid & 3) + (lane >> 2)) * VS + (wid >> 2) * 32 + (lane & 3) * 8) * 2);
    const MGAS char* Kb = (const MGAS char*)cur.K; const MGAS char* Vb = (const MGAS char*)cur.V;
    const unsigned ldsa = (unsigned)(__UINTPTR_TYPE__)lds;
#define GLDS16(base, off, la) do { unsigned sv_; asm volatile("s_mov_b32 %0, m0\n\ts_mov_b32 m0, %3\n\ts_nop 0\n\tglobal_load_lds_dwordx4 %1, %2\n\ts_mov_b32 m0, %0" : "=&s"(sv_) : "v"(off), "s"(base), "s"(la) : "memory"); } while (0)
#define DMA_K(t, slot) do { const MGAS char* kt_ = Kb + (size_t)(t) * (KVBLK * KS * 2); const unsigned la_ = (unsigned)__builtin_amdgcn_readfirstlane((int)(ldsa + L5_K + (slot) + (2 * wid) * 1024));  \
        GLDS16(kt_, kso[0], la_); GLDS16(kt_, kso[1], la_ + 1024u); } while (0)
#define DMA_V(t, slot) do { const MGAS char* vt_ = Vb + (size_t)(t) * (KVBLK * VS * 2); const unsigned la_ = (unsigned)__builtin_amdgcn_readfirstlane((int)(ldsa + L5_V + (slot) + wid * 1024));        \
        GLDS16(vt_, vso, la_); } while (0)
#define WAIT_BAR(N) asm volatile("s_waitcnt vmcnt(" #N ") lgkmcnt(0)\n\ts_barrier" ::: "memory")
#define SBAR() __builtin_amdgcn_sched_barrier(0)
#define PIN(x) asm volatile("" : "+v"(x))
#define MFMA(a, b, c) __builtin_amdgcn_mfma_f32_32x32x16_bf16(a, b, c, 0, 0, 0)
    int kofs[6];
#pragma unroll
    for (int d0 = 0; d0 < 6; ++d0) kofs[d0] = r32 * 256 + (((2 * d0 + hi) ^ (r32 & 15)) << 4);
    const lcp kb0 = (lcp)lds + L5_K;
    const lcp vp0 = (lcp)lds + L5_V + ((lane >> 4) & 1) * 32 + (lane & 3) * 8 + (4 * hi + ((lane & 15) >> 2)) * 64;
#define KLD(j, ks) kf[j] = *(const MLAS bf16x8*)(kb0 + (ks) + kofs[(j) >> 1] + ((j) & 1) * 8192)
    DMA_K(0, 0); DMA_V(0, 0); DMA_K(1, K5_SLOT);
    bf16x8 qr[6];
#pragma unroll
    for (int d0 = 0; d0 < 6; ++d0) qr[d0] = *(const MGAS bf16x8*)((const MGAS char*)cur.Q + (unsigned)(((wid * QBLK + r32) * QS + hi * 8) * 2) + d0 * 32);
    float mhat = 0.f, l_reg = 0.f; f32x16 o[2]; o[0] = f32x16{}; o[1] = f32x16{}; f32x16 negm;
    const int qrel = wid * QBLK + r32; bool resc = false;
    f32x16 pA0, pA1, pB0, pB1; bf16x8 kf[12]; s16x4 vlo[8], vhi[8]; u32x4 pw0, pw1, pw2, pw3;
    constexpr bool lag = false;
#define VSL(j) (((j) & 3) * V5_SLOT)
#define RESC() do { if (resc) { _Pragma("unroll") for (int d_ = 0; d_ < 2; ++d_) _Pragma("unroll") for (int r = 0; r < 16; ++r) o[d_][r] *= wsf[crow(r, hi)]; } } while (0)
    DMA_K(2, 2 * K5_SLOT);
    WAIT_BAR(5);
#pragma unroll
    for (int j = 0; j < 12; ++j) KLD(j, 0);
    pA0 = MFMA(kf[0], qr[0], f32x16{}); pA1 = MFMA(kf[1], qr[0], f32x16{});
#pragma unroll
    for (int d0 = 1; d0 < 6; ++d0) { pA0 = MFMA(kf[2 * d0], qr[d0], pA0); pA1 = MFMA(kf[2 * d0 + 1], qr[d0], pA1); }
    if (NT == 4) cmask5(pA0, pA1, 0, qrel, hi);
    { const float rm = rowmax5(pA0, pA1); mhat = rm;
#pragma unroll
      for (int r = 0; r < 16; ++r) { pA0[r] = __builtin_amdgcn_exp2f(pA0[r] - rm); pA1[r] = r < 4 ? __builtin_amdgcn_exp2f(pA1[r] - rm) : pA1[r] - rm; }
#pragma unroll
      for (int r = 0; r < 16; ++r) negm[r] = -mhat;
      PIN(negm); }
    WAIT_BAR(0);
    DMA_K(3, 3 * K5_SLOT); DMA_V(1, VSL(1));
    if (lag) { if (4 < NT) DMA_K(4, 0); DMA_V(2, VSL(2)); }
    KLD(0, K5_SLOT); KLD(1, K5_SLOT); KLD(2, K5_SLOT); KLD(3, K5_SLOT);
#define PKW(P, i) cvtpk5(P[i], P[i + 1])
#define PAF(k) __builtin_bit_cast(bf16x8, pw##k)
#define VFR(i) (bf16x8){vlo[i][0], vlo[i][1], vlo[i][2], vlo[i][3], vhi[i][0], vhi[i][1], vhi[i][2], vhi[i][3]}
#define VRD(i) do { vlo[i] = vtr5(vp_ + (((i) >> 2) * 4096 + ((i) & 3) * 1024)); vhi[i] = vtr5(vp_ + (((i) >> 2) * 4096 + ((i) & 3) * 1024 + 512)); } while (0)
#define EX(v) __builtin_amdgcn_exp2f(v)
#define GAPE(j, MF, P, i) do { KLD((j) + 4, ks_); SBAR(); MF; P[i] = EX(P[i]); P[(i) + 1] = EX(P[(i) + 1]); P[(i) + 2] = EX(P[(i) + 2]); PIN(P); SBAR(); } while (0)
#define GAPA(RD, MF, a0, a1, a2, a3, W0, W1, PW) do { RD; SBAR(); MF; sacc += a0; sacc += a1; sacc += a2; sacc += a3; W0; W1; PIN(PW); PIN(sacc); SBAR(); } while (0)
#define GAPB3(MF, X, i0, Y, i1, Z, i2) do { MF; X[i0] = EX(X[i0]); Y[i1] = EX(Y[i1]); Z[i2] = EX(Z[i2]); PIN(X); PIN(Z); SBAR(); } while (0)
#define GAPB4(MF, X, i) do { MF; X[i] = EX(X[i]); X[(i) + 1] = EX(X[(i) + 1]); X[(i) + 2] = EX(X[(i) + 2]); X[(i) + 3] = EX(X[(i) + 3]); PIN(X); SBAR(); } while (0)
#define KPRE(G, j) do { if (G) { KLD(j, kn_); } } while (0)
#define STEP(C0, C1, P0, P1, t, TS, MASK, GK, GV, GL, GK2, GV2) do { SBAR();                                                                                                                                                           \
    const int ks_ = ((TS) & 3) * K5_SLOT, kn_ = (((TS) + 1) & 3) * K5_SLOT; const lcp vp_ = vp0 + VSL((TS) + 3);                                                                  \
    GAPE(0, C0 = MFMA(kf[0], qr[0], negm), P1, 4);                                                                                                                        \
    GAPE(1, C1 = MFMA(kf[1], qr[0], negm), P1, 7);                                                                                                                        \
    GAPE(2, C0 = MFMA(kf[2], qr[1], C0),   P1, 10);                                                                                                                       \
    GAPE(3, C1 = MFMA(kf[3], qr[1], C1),   P1, 13);                                                                                                                       \
    float sacc = P0[0] + P0[1];                                                                                                                                           \
    GAPA(KLD(8, ks_),  C0 = MFMA(kf[4], qr[2], C0),  P0[2], P0[3], P0[4], P0[5],     pw0[0] = PKW(P0, 0),  pw0[1] = PKW(P0, 2),  pw0);                                     \
    GAPA(KLD(9, ks_),  C1 = MFMA(kf[5], qr[2], C1),  P0[6], P0[7], P0[8], P0[9],     pw0[2] = PKW(P0, 4),  pw0[3] = PKW(P0, 6),  pw0);                                     \
    GAPA(KLD(10, ks_), C0 = MFMA(kf[6], qr[3], C0),  P0[10], P0[11], P0[12], P0[13], pw1[0] = PKW(P0, 8),  pw1[1] = PKW(P0, 10), pw1);                                     \
    GAPA(KLD(11, ks_), C1 = MFMA(kf[7], qr[3], C1),  P0[14], P0[15], P1[0], P1[1],   pw1[2] = PKW(P0, 12), pw1[3] = PKW(P0, 14), pw1);                                     \
    GAPA((void)0,      C0 = MFMA(kf[8], qr[4], C0),  P1[2], P1[3], P1[4], P1[5],     pw2[0] = PKW(P1, 0),  pw2[1] = PKW(P1, 2),  pw2);                                     \
    GAPA((void)0,      C1 = MFMA(kf[9], qr[4], C1),  P1[6], P1[7], P1[8], P1[9],     pw2[2] = PKW(P1, 4),  pw2[3] = PKW(P1, 6),  pw2);                                     \
    GAPA(VRD(0),       C0 = MFMA(kf[10], qr[5], C0), P1[10], P1[11], P1[12], P1[13], pw3[0] = PKW(P1, 8),  pw3[1] = PKW(P1, 10), pw3);                                     \
    GAPA(VRD(4),       C1 = MFMA(kf[11], qr[5], C1), P1[14], P1[15], 0.f, 0.f,       pw3[2] = PKW(P1, 12), pw3[3] = PKW(P1, 14), pw3);                                     \
    l_reg += sacc;                                                                                                                                                        \
    if (!lag) { if (GK) DMA_K((t) + 3, (((TS) + 3) & 3) * K5_SLOT); if (GV) DMA_V((t) + 1, VSL((TS) + 1)); }                                          \
    else { ENDW(t); if (GK2) DMA_K((t) + 4, ((TS) & 3) * K5_SLOT); if (GV2) DMA_V((t) + 2, VSL((TS) + 2)); }                                           \
    VRD(1); VRD(5); SBAR();                                                                                                                                               \
    o[0] = MFMA(PAF(0), VFR(0), o[0]); o[1] = MFMA(PAF(0), VFR(4), o[1]);                                                     \
    if (MASK) cmask5(C0, C1, (t) - (NT - 4), qrel, hi);                                                                                                                   \
    { const float hm = halfmax5(C0, C1); resc = false;                                                                      \
      if (__builtin_expect(__any(hm > THR5), 0)) { const float rm = mergehalves5(hm); const float dl = __builtin_fmaxf(rm, 0.f); mhat += dl;     \
          _Pragma("unroll") for (int r = 0; r < 16; ++r) { C0[r] -= dl; C1[r] -= dl; }                                                                                    \
          _Pragma("unroll") for (int r = 0; r < 16; ++r) negm[r] = -mhat;                                                                                                 \
          PIN(negm);                                                                                                                                                      \
          const float f = __builtin_amdgcn_exp2f(-dl); l_reg *= f; if (hi == 0) wsf[r32] = f; resc = true; } }                                                            \
    SBAR();                                                                                                                                                               \
    VRD(2); KPRE(GL, 0); GAPB4(o[0] = MFMA(PAF(1), VFR(1), o[0]), C0, 0);                                                                                                 \
    VRD(6); KPRE(GL, 1); GAPB4(o[1] = MFMA(PAF(1), VFR(5), o[1]), C0, 4);                                                                                                 \
    VRD(3); KPRE(GL, 2); GAPB3(o[0] = MFMA(PAF(2), VFR(2), o[0]), C0, 8, C0, 9, C0, 10);                                                                                  \
    VRD(7); KPRE(GL, 3); GAPB3(o[1] = MFMA(PAF(2), VFR(6), o[1]), C0, 11, C0, 12, C0, 13);                                                                                \
    GAPB3(o[0] = MFMA(PAF(3), VFR(3), o[0]), C0, 14, C0, 15, C1, 0);                                                                                                      \
    GAPB3(o[1] = MFMA(PAF(3), VFR(7), o[1]), C1, 1, C1, 2, C1, 3);                                                                                                        \
    } while (0)
#define ENDW(tt) do { if ((tt) + 3 < NT) { WAIT_BAR(3); } else if ((tt) + 2 < NT) { WAIT_BAR(1); } else { WAIT_BAR(0); } } while (0)
#define ENDL(tt) do { if (!lag) ENDW(tt); } while (0)
    int t = 1;
    for (; t + 7 < NT; t += 4) {
        STEP(pB0, pB1, pA0, pA1, t,     1, false, true, true, true, true, true); ENDL(t);     RESC();
        STEP(pA0, pA1, pB0, pB1, t + 1, 2, false, true, true, true, true, true); ENDL(t + 1); RESC();
        STEP(pB0, pB1, pA0, pA1, t + 2, 3, false, true, true, true, true, true); ENDL(t + 2); RESC();
        STEP(pA0, pA1, pB0, pB1, t + 3, 0, false, true, true, true, true, true); ENDL(t + 3); RESC();
    }
    for (; t + 1 < NT; t += 2) {
        STEP(pB0, pB1, pA0, pA1, t, t, true, (t + 3 < NT), (t + 1 < NT), (t + 1 < NT), (t + 4 < NT), (t + 2 < NT));                 ENDL(t);     RESC();
        STEP(pA0, pA1, pB0, pB1, t + 1, t + 1, true, (t + 4 < NT), (t + 2 < NT), (t + 2 < NT), (t + 5 < NT), (t + 3 < NT));         ENDL(t + 1); RESC();
    }
    STEP(pB0, pB1, pA0, pA1, NT - 1, NT - 1, true, false, false, false, false, false); ENDL(NT - 1); RESC();
    {
#pragma unroll
      for (int r = 4; r < 16; ++r) pB1[r] = __builtin_amdgcn_exp2f(pB1[r]);
      float sacc = pB0[0] + pB0[1];
#pragma unroll
      for (int r = 2; r < 16; ++r) sacc += pB0[r];
#pragma unroll
      for (int r = 0; r < 16; ++r) sacc += pB1[r];
      l_reg += sacc;
      pw0 = (u32x4){PKW(pB0, 0), PKW(pB0, 2), PKW(pB0, 4), PKW(pB0, 6)}; pw1 = (u32x4){PKW(pB0, 8), PKW(pB0, 10), PKW(pB0, 12), PKW(pB0, 14)};
      pw2 = (u32x4){PKW(pB1, 0), PKW(pB1, 2), PKW(pB1, 4), PKW(pB1, 6)}; pw3 = (u32x4){PKW(pB1, 8), PKW(pB1, 10), PKW(pB1, 12), PKW(pB1, 14)};
      const lcp vp_ = vp0 + VSL(NT - 1);
      VRD(0); VRD(1); VRD(2); VRD(3); VRD(4); VRD(5); VRD(6); VRD(7);
      o[0] = MFMA(PAF(0), VFR(0), o[0]); o[1] = MFMA(PAF(0), VFR(4), o[1]); o[0] = MFMA(PAF(1), VFR(1), o[0]); o[1] = MFMA(PAF(1), VFR(5), o[1]);
      o[0] = MFMA(PAF(2), VFR(2), o[0]); o[1] = MFMA(PAF(2), VFR(6), o[1]); o[0] = MFMA(PAF(3), VFR(3), o[0]); o[1] = MFMA(PAF(3), VFR(7), o[1]); }
    { auto rr = __builtin_amdgcn_permlane32_swap(__float_as_uint(l_reg), __float_as_uint(l_reg), false, false); l_reg = __uint_as_float(rr[0]) + __uint_as_float(rr[1]); }
    if (hi == 0) wsf[32 + r32] = l_reg;
    MGAS bf16_t* Ow = cur.O + (size_t)(wid * QBLK) * OS; MLAS bf16_t* stg = (MLAS bf16_t*)(lds + L5_OST) + wid * 2048;
#pragma unroll
    for (int r = 0; r < 16; ++r) { const int orow = crow(r, hi); const float rl = __builtin_amdgcn_rcpf(wsf[32 + orow]);
#pragma unroll
        for (int d0 = 0; d0 < 2; ++d0) stg[orow * 64 + d0 * 32 + r32] = (bf16_t)cvtpk5(o[d0][r] * rl, 0.f); }
#pragma unroll
    for (int i = 0; i < 4; ++i) { const int row = i * 8 + (lane >> 3), ch = lane & 7; *(MGAS u32x4*)((MGAS char*)Ow + (unsigned)((row * OS + ch * 8) * 2)) = *(const MLAS u32x4*)(stg + row * 64 + ch * 8); }
    asm volatile("s_waitcnt lgkmcnt(0)\n\ts_barrier" ::: "memory");
#undef DMA_K
#undef DMA_V
#undef GLDS16
#undef WAIT_BAR
#undef SBAR
#undef PIN
#undef MFMA
#undef KLD
#undef VSL
#undef ENDL
#undef RESC
#undef PKW
#undef PAF
#undef VFR
#undef VRD
#undef GAPA
#undef GAPE
#undef GAPB3
#undef GAPB4
#undef EX
#undef GAPB
#undef KPRE
#undef STEP
#undef ENDW
}
__device__ __forceinline__ void mla_phase(MLAS char* lds, const bf16_t* QF_, const bf16_t* KF_, const bf16_t* VV_, bf16_t* ATT_, int bx, int nwg, int wid, int lane) {
    const MGAS bf16_t* QF = (const MGAS bf16_t*)QF_; const MGAS bf16_t* KF = (const MGAS bf16_t*)KF_; const MGAS bf16_t* VV = (const MGAS bf16_t*)VV_; MGAS bf16_t* ATT = (MGAS bf16_t*)ATT_;
    for (int item = bx; item < 256; item += nwg) { const int h = item & 7, x = item >> 3;
#pragma unroll 1
        for (int pass = 0; pass < 2; ++pass) { const int qb = pass ? 63 - x : x;
            BlockRef b{QF + (size_t)(qb * QB) * QS + h * 96, KF + h * 96, VV + h * 64, ATT + (size_t)(qb * QB) * OS + h * 64, qb * QB};
            block5(b, lds, wid, lane); }
        asm volatile("s_waitcnt vmcnt(0)" ::: "memory"); __syncthreads(); }
}
}

namespace dil {
#define DLAS __attribute__((address_space(3)))
#define DGAS __attribute__((address_space(1)))
typedef short bf16x8 __attribute__((ext_vector_type(8)));
typedef short s16x4 __attribute__((ext_vector_type(4)));
typedef float f32x16 __attribute__((ext_vector_type(16)));
typedef unsigned u32x4 __attribute__((ext_vector_type(4)));
constexpr int ITEM_LDS = 65536, K_OFF = 0, V_OFF = 32768, BIAS_OFF = 131072, WSF_OFF = 131072 + 2048;
constexpr int LDS_BYTES = WSF_OFF + 8 * 128;
constexpr float LOG2E = 1.4426950408889634f, LN2 = 0.6931471805599453f;
__device__ __forceinline__ int v_st(int k, int c) { const int kk = (k & ~0xC) | ((k & 4) << 1) | ((k & 8) >> 1); return ((kk >> 3) * 2 + (c >> 5)) * 512 + ((kk & 7) * 32 + (c & 31)) * 2; }
__device__ __forceinline__ int v_rd_base(int lane) { return ((lane & 3) << 3) | (((lane >> 2) & 3) << 6) | (((lane >> 4) & 1) << 5) | (((lane >> 5) & 1) << 8); }
__device__ __forceinline__ int crow(int r, int hi) { return (r & 3) + 8 * (r >> 2) + 4 * hi; }
__device__ __forceinline__ unsigned cvtpk(float lo, float hi) { unsigned r; asm volatile("v_cvt_pk_bf16_f32 %0, %1, %2" : "=v"(r) : "v"(lo), "v"(hi)); return r; }
__device__ __forceinline__ int t5b(int dist) { if (dist < 16) return dist; const int large = 16 + (int)(logf((float)dist / 16.f) / 4.852030263919617f * 16.f); return large < 31 ? large : 31; }
struct Item { int hd, r, ph, nbk; };
__device__ __forceinline__ Item decode(int id) { Item it; it.hd = id >> 7; const int blk = id & 127, g = it.hd >> 3; it.r = g == 0 ? 1 : (g == 1 ? 4 : 16);
    const int nblk = 128 / it.r; it.ph = blk / nblk; it.nbk = blk - it.ph * nblk; return it; }

__device__ __forceinline__ void dil_phase(DLAS char* lds, bf16_t* QD_, const bf16_t* KD_, const bf16_t* VD_, const float* rel_bias, float* LSE_, int pr0, int prstep, int prend, int wid, int lane) {
    DGAS bf16_t* QD = (DGAS bf16_t*)QD_; const DGAS bf16_t* KD = (const DGAS bf16_t*)KD_; const DGAS bf16_t* VD = (const DGAS bf16_t*)VD_; DGAS float* LSE = (DGAS float*)LSE_;
    const int tid = wid * 64 + lane, r32 = lane & 31, hi = lane >> 5, w4 = wid & 3, wi = wid >> 2;
    for (int pr = pr0; pr < prend; pr += prstep) {
#pragma unroll 1
        for (int ii = 0; ii < 2; ++ii) { const Item it = decode(2 * pr + ii);
            DLAS char* Kl = lds + ii * ITEM_LDS + K_OFF; DLAS char* Vl = lds + ii * ITEM_LDS + V_OFF;
            bf16x8 kv[4], vv[4];
#pragma unroll
            for (int c = 0; c < 4; ++c) { const int idx = c * 512 + tid, row = idx >> 3, ch = idx & 7; const int srow = (it.nbk - 1) * 128 + row;
                const size_t off = ((size_t)(srow * it.r + it.ph)) * 1536 + it.hd * 64 + ch * 8;
                if (srow >= 0) { kv[c] = *(const DGAS bf16x8*)(KD + off); vv[c] = *(const DGAS bf16x8*)(VD + off); } else { kv[c] = bf16x8{}; vv[c] = bf16x8{}; } }
#pragma unroll
            for (int c = 0; c < 4; ++c) { const int idx = c * 512 + tid, row = idx >> 3, ch = idx & 7;
                *(DLAS bf16x8*)(Kl + row * 128 + ((ch ^ ((row >> 1) & 7)) * 16)) = kv[c];
                *(DLAS bf16x8*)(Vl + v_st(row, ch * 8)) = vv[c]; }
            if (tid < 256) { const int st = tid - 35;
                ((DLAS float*)(lds + BIAS_OFF + ii * 1024))[tid] = (st >= 0 && st <= 128) ? rel_bias[t5b(st * it.r) * 24 + it.hd] * LOG2E : -__builtin_inff(); }
        }
        __syncthreads();
        { const Item it = decode(2 * pr + wi);
            const DLAS char* Kl = lds + wi * ITEM_LDS + K_OFF; const DLAS float* bias = (const DLAS float*)(lds + BIAS_OFF + wi * 1024);
            DLAS float* wsf = (DLAS float*)(lds + WSF_OFF + wid * 128);
            const int qtok = ((it.nbk * 128 + 32 * w4 + r32) * it.r + it.ph);
            bf16x8 qr[4];
#pragma unroll
            for (int d0 = 0; d0 < 4; ++d0) qr[d0] = *(const DGAS bf16x8*)(QD + (size_t)qtok * 1536 + it.hd * 64 + d0 * 16 + hi * 8);
            f32x16 p[5];
            const DLAS char* kb[4];
#pragma unroll
            for (int d0 = 0; d0 < 4; ++d0) kb[d0] = Kl + (32 * w4 + r32) * 128 + (((2 * d0 + hi) ^ ((r32 >> 1) & 7)) * 16);
#pragma unroll
            for (int b = 0; b < 5; ++b) { p[b] = f32x16{};
#pragma unroll
                for (int d0 = 0; d0 < 4; ++d0) p[b] = __builtin_amdgcn_mfma_f32_32x32x16_bf16(*(const DLAS bf16x8*)(kb[d0] + b * 4096), qr[d0], p[b], 0, 0, 0); }
            { const DLAS char* tb = (const DLAS char*)bias + 4 * (4 + r32 - 4 * hi);
#pragma unroll
              for (int b = 0; b < 5; ++b)
#pragma unroll
                for (int r = 0; r < 16; ++r) { const int c = 32 * b + (r & 3) + 8 * (r >> 2); p[b][r] = fmaf(p[b][r], 0.125f * LOG2E, *(const DLAS float*)(tb + 4 * (159 - c))); } }
            if (it.nbk == 0) {
                int lim = 128 - 32 * w4 - 4 * hi; asm volatile("" : "+v"(lim));
#pragma unroll
                for (int b = 0; b < 4; ++b)
#pragma unroll
                    for (int r = 0; r < 16; ++r) { const int c = 32 * b + (r & 3) + 8 * (r >> 2); if (c < lim) p[b][r] = -__builtin_inff(); } }
            float mx;
            { float m0 = fmaxf(fmaxf(p[0][0], p[0][1]), p[0][2]), m1 = fmaxf(fmaxf(p[0][3], p[0][4]), p[0][5]);
#pragma unroll
              for (int r = 6; r < 16; r += 2) { if ((r >> 1) & 1) m0 = fmaxf(fmaxf(m0, p[0][r]), p[0][r + 1]); else m1 = fmaxf(fmaxf(m1, p[0][r]), p[0][r + 1]); }
#pragma unroll
              for (int b = 1; b < 5; ++b)
#pragma unroll
                for (int r = 0; r < 16; r += 4) { m0 = fmaxf(fmaxf(m0, p[b][r]), p[b][r + 1]); m1 = fmaxf(fmaxf(m1, p[b][r + 2]), p[b][r + 3]); }
              mx = fmaxf(m0, m1); }
            { auto rr = __builtin_amdgcn_permlane32_swap(__float_as_uint(mx), __float_as_uint(mx), false, false); mx = fmaxf(__uint_as_float(rr[0]), __uint_as_float(rr[1])); }
            float den = 0.f;
#pragma unroll
            for (int b = 0; b < 5; ++b)
#pragma unroll
                for (int r = 0; r < 16; ++r) { const float e = __builtin_amdgcn_exp2f(p[b][r] - mx); p[b][r] = e; den += e; }
            { auto rr = __builtin_amdgcn_permlane32_swap(__float_as_uint(den), __float_as_uint(den), false, false); den = __uint_as_float(rr[0]) + __uint_as_float(rr[1]); }
            if (hi == 0) { wsf[r32] = __builtin_amdgcn_rcpf(den); LSE[(size_t)qtok * 24 + it.hd] = mx * LN2 + __logf(den); }
            bf16x8 pa[5][2];
#define DIL_PK4(P, B_, OUT) do { unsigned a0 = cvtpk(P[B_+0], P[B_+1]), a1 = cvtpk(P[B_+2], P[B_+3]);                          \
        unsigned b0 = cvtpk(P[B_+4], P[B_+5]), b1 = cvtpk(P[B_+6], P[B_+7]);                                             \
        auto r0 = __builtin_amdgcn_permlane32_swap(a0, b0, false, false); auto r1 = __builtin_amdgcn_permlane32_swap(a1, b1, false, false); \
        u32x4 w_ = {r0[0], r1[0], r0[1], r1[1]}; OUT = *reinterpret_cast<bf16x8*>(&w_); } while (0)
#pragma unroll
            for (int b = 0; b < 5; ++b) { DIL_PK4(p[b], 0, pa[b][0]); DIL_PK4(p[b], 8, pa[b][1]); }
#undef DIL_PK4
            f32x16 o[2] = {};
            const int vb0 = (int)(unsigned)(__UINTPTR_TYPE__)(lds + wi * ITEM_LDS + V_OFF) + v_rd_base(lane) + 4 * w4 * 1024;
#define DIL_TRRD(dst, off) asm volatile("ds_read_b64_tr_b16 %0, %1 offset:%2" : "=&v"(dst) : "v"(vb0), "i"(off) : "memory")
#define DIL_PV(b, d0) do { s16x4 l0, h0, l1, h1; constexpr int o_ = (4 * (b)) * 1024 + (d0) * 512;                                         \
        DIL_TRRD(l0, o_); DIL_TRRD(h0, o_ + 1024); DIL_TRRD(l1, o_ + 2048); DIL_TRRD(h1, o_ + 3072);                                        \
        asm volatile("s_waitcnt lgkmcnt(0)" ::: "memory"); __builtin_amdgcn_sched_barrier(0);                                               \
        o[d0] = __builtin_amdgcn_mfma_f32_32x32x16_bf16(pa[b][0], (bf16x8){l0[0], l0[1], l0[2], l0[3], h0[0], h0[1], h0[2], h0[3]}, o[d0], 0, 0, 0);   \
        o[d0] = __builtin_amdgcn_mfma_f32_32x32x16_bf16(pa[b][1], (bf16x8){l1[0], l1[1], l1[2], l1[3], h1[0], h1[1], h1[2], h1[3]}, o[d0], 0, 0, 0); } while (0)
            DIL_PV(0, 0); DIL_PV(0, 1); DIL_PV(1, 0); DIL_PV(1, 1); DIL_PV(2, 0); DIL_PV(2, 1); DIL_PV(3, 0); DIL_PV(3, 1); DIL_PV(4, 0); DIL_PV(4, 1);
#undef DIL_PV
#undef DIL_TRRD
            asm volatile("s_waitcnt lgkmcnt(0)" ::: "memory");
            __syncthreads();
            { DLAS bf16_t* stg = (DLAS bf16_t*)(lds + wi * ITEM_LDS + K_OFF + w4 * 4096);
#pragma unroll
              for (int r = 0; r < 16; ++r) { const int orow = crow(r, hi); const float rd = wsf[orow];
#pragma unroll
                  for (int d0 = 0; d0 < 2; ++d0) stg[orow * 64 + d0 * 32 + r32] = (bf16_t)cvtpk(o[d0][r] * rd, 0.f); }
              asm volatile("s_waitcnt lgkmcnt(0)" ::: "memory");
#pragma unroll
              for (int i = 0; i < 4; ++i) { const int row = i * 8 + (lane >> 3), ch = lane & 7; const int otok = (it.nbk * 128 + 32 * w4 + row) * it.r + it.ph;
                  *(DGAS u32x4*)(QD + (size_t)otok * 1536 + it.hd * 64 + ch * 8) = *(const DLAS u32x4*)(stg + row * 64 + ch * 8); } }
        }
        __syncthreads();
    }
}
}

#define LAS __attribute__((address_space(3)))
constexpr size_t MiB = 1u << 20;
constexpr int NWAVES = 8, MK_LDS_BYTES = 147456;
constexpr size_t WS_CTL = 0, WS_R0 = 1 * MiB, WS_CS = 2 * MiB, WS_SN = 3 * MiB, WS_SSQ1 = 4 * MiB, WS_SSQ2 = 5 * MiB, WS_SSQL = 6 * MiB, WS_LSE = 8 * MiB;
constexpr size_t WS_WGU = 10 * MiB, WS_WD = 21 * MiB, WS_WIN = 27 * MiB, WS_WG = 38 * MiB, WS_WUQ = 42 * MiB, WS_WUKV = 43 * MiB, WS_WBA = 44 * MiB, WS_WBD = 45 * MiB, WS_WO = 46 * MiB;
constexpr size_t WS_XB = 48 * MiB, WS_ACT = 80 * MiB;
constexpr size_t WS_H = 80 * MiB, WS_QD = 80 * MiB, WS_KD = 128 * MiB, WS_VD = 176 * MiB, WS_LAT = 224 * MiB;
constexpr size_t WS_G = 80 * MiB, WS_QF = 144 * MiB, WS_KF = 168 * MiB, WS_VV = 192 * MiB, WS_DIL = 208 * MiB, WS_ATT = 224 * MiB, WS_MG = 176 * MiB;
constexpr size_t WS_CQN = 80 * MiB, WS_CKVN = 92 * MiB;

struct MkArgs { const float* in[22]; float* out; unsigned char* ws; int ph_lo, ph_hi; };

__device__ __forceinline__ unsigned mk_pk2(float lo, float hi) { return (unsigned)f2bf(lo) | ((unsigned)f2bf(hi) << 16); }
__device__ __forceinline__ void conv_item(const float* W, int ldw, int col0, int k0, int K, bf16_t* WT, int dstrow0, const float* gain, LAS float* scr, int lane) {
    pg8::f32x4 wv[8];
#pragma unroll
    for (int i = 0; i < 8; ++i) { const int kk = 8 * i + (lane >> 3); wv[i] = *(const pg8::f32x4*)(W + (size_t)(k0 + kk) * ldw + col0 + (lane & 7) * 4); }
    const float gl = gain ? gain[k0 + lane] : 1.f;
#pragma unroll
    for (int i = 0; i < 8; ++i) { const int kk = 8 * i + (lane >> 3); const float gk = __shfl(gl, kk); LAS float* d = scr + kk * 33 + (lane & 7) * 4;
        d[0] = wv[i][0] * gk; d[1] = wv[i][1] * gk; d[2] = wv[i][2] * gk; d[3] = wv[i][3] * gk; }
    asm volatile("s_waitcnt lgkmcnt(0)" ::: "memory");
    const int c = lane & 7;
#pragma unroll
    for (int j = 0; j < 4; ++j) { const int n = (lane >> 3) + 8 * j; const LAS float* s = scr + (8 * c) * 33 + n;
        pg8::u32x4 o; o.x = pg8::cvt_pk_bf16(s[0 * 33], s[1 * 33]); o.y = pg8::cvt_pk_bf16(s[2 * 33], s[3 * 33]); o.z = pg8::cvt_pk_bf16(s[4 * 33], s[5 * 33]); o.w = pg8::cvt_pk_bf16(s[6 * 33], s[7 * 33]);
        *(pg8::u32x4*)(WT + (size_t)(dstrow0 + n) * K + k0 + 8 * c) = o; }
    asm volatile("s_waitcnt lgkmcnt(0)" ::: "memory");
}
struct ConvSeg { const float* src; const float* src2; const float* gain; bf16_t* dst; int ldw, col0, K, row0, nblk, kind; };
typedef const __attribute__((address_space(4))) MkArgs* KArgP;
__device__ __forceinline__ KArgP kargs() { KArgP p = (KArgP)__builtin_amdgcn_kernarg_segment_ptr(); asm volatile("" : "+s"(p)); return p; }
__device__ __forceinline__ ConvSeg conv_seg(KArgP ap, int si) {
    unsigned char* ws = ap->ws;
    bf16_t* W_GU = (bf16_t*)(ws + WS_WGU); bf16_t* W_D = (bf16_t*)(ws + WS_WD); bf16_t* W_IN = (bf16_t*)(ws + WS_WIN); bf16_t* W_G = (bf16_t*)(ws + WS_WG);
    bf16_t* W_UQ = (bf16_t*)(ws + WS_WUQ); bf16_t* W_UKV = (bf16_t*)(ws + WS_WUKV); bf16_t* W_BA = (bf16_t*)(ws + WS_WBA); bf16_t* W_BD = (bf16_t*)(ws + WS_WBD); bf16_t* W_O = (bf16_t*)(ws + WS_WO);
    switch (si) {
    case 0: return ConvSeg{ap->in[5], ap->in[6], ap->in[4], W_GU, DFF, 0, 1024, 0, 176, 1};
    case 1: return ConvSeg{ap->in[7], nullptr, nullptr, W_D, 1024, 0, DFF, 0, 32, 0};
    case 2: return ConvSeg{ap->in[9], nullptr, ap->in[8], W_IN, DIN, 0, 1024, 4608, 21, 0};
    case 3: return ConvSeg{nullptr, nullptr, nullptr, W_IN, 0, 0, 1024, 5280, 3, 2};
    case 4: return ConvSeg{ap->in[9], nullptr, ap->in[8], W_IN, DIN, 672, 1024, 0, 144, 0};
    case 5: return ConvSeg{ap->in[9], nullptr, ap->in[8], W_G, DIN, 5280, 1024, 0, 64, 0};
    case 6: return ConvSeg{ap->in[12], nullptr, ap->in[11], W_UQ, 768, 0, QLORA, 0, 24, 0};
    case 7: return ConvSeg{ap->in[14], nullptr, ap->in[13], W_UKV, 1024, 0, KVLORA, 0, 32, 0};
    case 8: return ConvSeg{ap->in[15], nullptr, nullptr, W_BA, 1024, 0, 512, 0, 32, 0};
    case 9: return ConvSeg{ap->in[16], nullptr, nullptr, W_BD, 1024, 0, 512, 0, 32, 0};
    case 10: return ConvSeg{ap->in[17], nullptr, nullptr, W_O, 1024, 0, 1024, 0, 32, 0};
    case 11: return ConvSeg{ap->in[19], ap->in[20], ap->in[18], W_GU, DFF, 0, 1024, 0, 176, 1};
    default: return ConvSeg{ap->in[21], nullptr, nullptr, W_D, 1024, 0, DFF, 0, 32, 0};
    }
}
__device__ __forceinline__ void conv_run(KArgP a, int s0, int s1, LAS float* scr, int gw, int ngw, int lane) {
    int base = 0;
    for (int si = s0; si < s1; ++si) { const ConvSeg sg = conv_seg(a, si); const int kt = sg.K / 64, nit = sg.nblk * kt;
        int it = gw - (base % ngw); if (it < 0) it += ngw;
        for (; it < nit; it += ngw) { const int b = it / kt, k0 = (it - b * kt) * 64;
            if (sg.kind == 2) { const int c = lane & 7;
#pragma unroll
                for (int j = 0; j < 4; ++j) { const int n = (lane >> 3) + 8 * j; *(pg8::u32x4*)(sg.dst + (size_t)(sg.row0 + 32 * b + n) * sg.K + k0 + 8 * c) = (pg8::u32x4){0u, 0u, 0u, 0u}; } }
            else if (sg.kind == 1) { const int tile = b >> 3, sub = b & 7; conv_item(sub < 4 ? sg.src : sg.src2, sg.ldw, tile * 128 + (sub & 3) * 32, k0, sg.K, sg.dst, sg.row0 + 32 * b, sg.gain, scr, lane); }
            else conv_item(sg.src, sg.ldw, sg.col0 + 32 * b, k0, sg.K, sg.dst, sg.row0 + 32 * b, sg.gain, scr, lane); }
        base += nit; }
}
__device__ __forceinline__ void xb_row(const float* xrow, bf16_t* orow, float* r0, int lane) {
    pg8::f32x4 v[4]; float s = 0.f;
#pragma unroll
    for (int j = 0; j < 4; ++j) { v[j] = *((const pg8::f32x4*)xrow + lane + 64 * j); s += pg8::dot4(v[j]); }
    s = wave_sum(s);
#pragma unroll
    for (int j = 0; j < 4; ++j) { pg8::u32x2 w; w.x = mk_pk2(v[j][0], v[j][1]); w.y = mk_pk2(v[j][2], v[j][3]); *((pg8::u32x2*)orow + lane + 64 * j) = w; }
    if (lane == 0) *r0 = rsqrtf(s * (1.f / 1024.f) + EPS);
}

struct MkConst { InvFreq ifr; };

#define XB_TMO      128
#define XB_XCNT(j)  (256  + 64 * (j))
#define XB_XSUB(j)  (1280 + 64 * (j))
#define XB_XGEN(j)  (2304 + 64 * (j))
#define XB_TOP      3328
#define XB_TOPGEN   3392
#define XCD_BAR_WORDS 3456
#define XB_SPIN_CAP (1u << 18)

__device__ __forceinline__ unsigned xb_ld(unsigned* p)              { return __hip_atomic_load(p, __ATOMIC_RELAXED, __HIP_MEMORY_SCOPE_AGENT); }
__device__ __forceinline__ unsigned xb_add(unsigned* p, unsigned v) { return __hip_atomic_fetch_add(p, v, __ATOMIC_RELAXED, __HIP_MEMORY_SCOPE_AGENT); }
__device__ __forceinline__ unsigned xb_xcc_id() { return (unsigned)__builtin_amdgcn_s_getreg((3 << 11) | 20) & 0xFu; }
#define XB_SPIN(cond, bar) do { unsigned _sp = 0; while (cond) { __builtin_amdgcn_s_sleep(1); \
    if ((++_sp & 255u) == 0u) { if (xb_ld(&(bar)[XB_TMO])) break; if (_sp > XB_SPIN_CAP) { atomicAdd(&(bar)[XB_TMO], 1u); break; } } } } while (0)

struct XcdBarrier {
    unsigned* bar; unsigned x;
    volatile LAS unsigned* st;
};

__device__ __forceinline__ XcdBarrier xcd_barrier_post(unsigned* bar, volatile LAS unsigned* st, bool leader) {
    XcdBarrier b; b.bar = bar; b.x = xb_xcc_id(); b.st = st;
    if (leader) (void)xb_add(&bar[XB_XCNT(b.x)], 1u);
    return b;
}
__device__ __forceinline__ void xcd_barrier_complete(unsigned* bar, unsigned x, unsigned& nloc, unsigned& nx) {
    const unsigned G = gridDim.x * gridDim.y * gridDim.z;
    unsigned sum, cnt, mine, sp = 0u;
    for (;;) {
        sum = 0u; cnt = 0u; mine = 0u;
#pragma unroll
        for (unsigned j = 0; j < 16; ++j) { const unsigned c = xb_ld(&bar[XB_XCNT(j)]); sum += c; cnt += (c > 0u) ? 1u : 0u; mine = (j == x) ? c : mine; }
        if (sum == G) break;
        __builtin_amdgcn_s_sleep(1);
        if ((++sp & 255u) == 0u) { if (xb_ld(&bar[XB_TMO])) break; if (sp > XB_SPIN_CAP) { atomicAdd(&bar[XB_TMO], 1u); break; } }
    }
    nloc = mine > 0u ? mine : 1u; nx = cnt > 0u ? cnt : 1u;
}

__device__ __forceinline__ void xcd_barrier(const XcdBarrier& b, bool leader) {
    asm volatile("s_waitcnt vmcnt(0)" ::: "memory");
    __syncthreads();
    if (leader) {
        unsigned* bar = b.bar;
        __builtin_amdgcn_s_waitcnt(0);
        unsigned nloc = b.st[0], nx = b.st[1];
        if (nloc == 0u) { xcd_barrier_complete(bar, b.x, nloc, nx); b.st[0] = nloc; b.st[1] = nx; }
        const unsigned old = xb_add(&bar[XB_XSUB(b.x)], 1u);
        const unsigned gen = old / nloc;
        if (old + 1u == (gen + 1u) * nloc) {
            __builtin_amdgcn_fence(__ATOMIC_RELEASE, "agent");
            asm volatile("s_waitcnt vmcnt(0)" ::: "memory");
            const unsigned og = xb_add(&bar[XB_TOP], 1u);
            const unsigned tg = og / nx;
            if (og + 1u == (tg + 1u) * nx) xb_add(&bar[XB_TOPGEN], 1u);
            else XB_SPIN(xb_ld(&bar[XB_TOPGEN]) == tg, bar);
            __builtin_amdgcn_fence(__ATOMIC_ACQUIRE, "agent");
            xb_add(&bar[XB_XGEN(b.x)], 1u);
            asm volatile("s_waitcnt vmcnt(0)" ::: "memory");
        } else {
            XB_SPIN(xb_ld(&bar[XB_XGEN(b.x)]) == gen, bar);
            __builtin_amdgcn_fence(__ATOMIC_ACQUIRE, "agent");
            asm volatile("s_waitcnt vmcnt(0)" ::: "memory");
        }
    }
    __syncthreads();
}

#define XB_LSUB(j)  (3456 + 64 * (j))
#define XB_LGEN(j)  (3968 + 64 * (j))
#define XB_MISM     4480
__device__ __forceinline__ void xcd_local_barrier(const XcdBarrier& b, int g, unsigned ngrp, bool leader) {
    asm volatile("s_waitcnt vmcnt(0)" ::: "memory");
    __syncthreads();
    if (leader) {
        unsigned* bar = b.bar;
        __builtin_amdgcn_s_waitcnt(0);
        const unsigned old = xb_add(&bar[XB_LSUB(g)], 1u);
        const unsigned gen = old / ngrp;
        if (old + 1u == (gen + 1u) * ngrp) xb_add(&bar[XB_LGEN(g)], 1u);
        else XB_SPIN(xb_ld(&bar[XB_LGEN(g)]) == gen, bar);
        __builtin_amdgcn_fence(__ATOMIC_ACQUIRE, "agent");
        asm volatile("s_waitcnt vmcnt(0)" ::: "memory");
    }
    __syncthreads();
}

__device__ __forceinline__ unsigned char* opq(unsigned char* p) { asm volatile("" : "+s"(p)); return p; }
#define WP(T, off) ((T*)(w + (off)))
constexpr int RS_TAB_OFF = 131072;
#define RT_PTR ((const LAS float*)(L + RS_TAB_OFF))
__device__ __forceinline__ void rs_fill(LAS unsigned char* L, const float* slots, int stride, int first, int n4, float inv_n, float mul, int group, int wave, int ln) {
    LAS float* tab = (LAS float*)(L + RS_TAB_OFF);
#pragma unroll 1
    for (int i = wave * 64 + ln; i < 2048; i += 512) { const float* p = slots + (size_t)(group * 2048 + i) * stride + first; float sacc = 0.f;
        for (int k = 0; k < n4; ++k) { const pg8::f32x4 v = *(const pg8::f32x4*)(p + 4 * k); sacc += (v[0] + v[1]) + (v[2] + v[3]); }
        tab[i] = rsqrtf(sacc * inv_n + 1e-6f) * mul; }
    __syncthreads();
}
__global__ void __launch_bounds__(NWAVES * 64, 2) mk_fwd(MkArgs args_in_kernarg, InvFreq ifr) {
#define args (*kargs())
    extern __shared__ __attribute__((aligned(16))) unsigned char lds[];
    LAS unsigned char* L = (LAS unsigned char*)lds;
    const int wave = __builtin_amdgcn_readfirstlane((int)threadIdx.x >> 6);
#define lane ((int)__builtin_amdgcn_mbcnt_hi(~0u, __builtin_amdgcn_mbcnt_lo(~0u, 0u)))
#define tid (wave * 64 + lane)
    const int G = gridDim.x, bx = blockIdx.x, vcu = (G % 8 == 0) ? (bx % 8) * (G / 8) + bx / 8 : bx;
    const int gw = vcu * NWAVES + wave, ngw = G * NWAVES;
    const int lo = args.ph_lo, hi = args.ph_hi;
#define IN(k) (lo <= (k) && (k) < hi)
    volatile LAS unsigned* bst = (volatile LAS unsigned*)(L + MK_LDS_BYTES - 64);
    const bool leader = (wave == 0) && (lane == 0);
    XcdBarrier bar; bar.bar = (unsigned*)(args.ws + WS_CTL) + 4096; bar.x = 0; bar.st = bst;
    if (hi - lo > 1) { if (leader) { bst[0] = 0u; bst[1] = 0u; } __syncthreads(); bar = xcd_barrier_post((unsigned*)(args.ws + WS_CTL) + 4096, bst, leader); }
#define SEAM(k) do { if (IN(k) && IN((k) + 1)) xcd_barrier(bar, leader); } while (0)
#define SEAML(k) do { if (IN(k) && IN((k) + 1)) { if (bst[2] != 0u) xcd_local_barrier(bar, bx & 7, (unsigned)(G >> 3), leader); else xcd_barrier(bar, leader); } } while (0)
    if (leader) { bst[2] = 0u; if (hi - lo > 1 && lo == 0 && bar.x != (unsigned)(bx & 7)) (void)xb_add(&bar.bar[XB_MISM], 1u); }

    if (IN(0)) { unsigned char* w = opq(args.ws); LAS float* scr = (LAS float*)(L + wave * 16384);
        conv_run(kargs(), 0, (G == 256) ? 1 : 11, scr, gw, ngw, lane);
        const float* x = args.in[0]; const int* pos = (const int*)args.in[1];
#pragma unroll 4
        for (int m = gw; m < S; m += ngw) xb_row(x + (size_t)m * DM, WP(bf16_t, WS_XB) + (size_t)m * DM, WP(float, WS_R0) + m, lane);
        float* CS = WP(float, WS_CS); float* SN = WP(float, WS_SN);
        for (int idx = (vcu * NWAVES * 64) + tid; idx < S * 16; idx += G * NWAVES * 64) { const float ang = (float)pos[idx >> 4] * ifr.f[idx & 15]; float c, s; sincos_acc(ang, c, s); CS[idx] = c; SN[idx] = s; }
        __syncthreads();
    }
    SEAM(0);
    if (IN(0) && IN(1)) { if (leader) bst[2] = (G == 256 && xb_ld(&bar.bar[XB_MISM]) == 0u) ? 1u : 0u; __syncthreads(); }
    if (IN(1)) { unsigned char* w = opq(args.ws); pg8::Gemm g{WP(bf16_t, WS_XB), WP(bf16_t, WS_WGU), S, 2 * DFF, DM, DM}; pg8::StaticOrder so; so.init(S, 2 * DFF, G, bx);
        pg8::EpiSwiglu E{WP(bf16_t, WS_H), WP(float, WS_R0), 0, RT_PTR}; pg8::gemm_phase<pg8::EpiSwiglu, pg8::StaticOrder, true, true>(L, g, so, E, wave);
        if (G == 256 && bx >= 128) { LAS float* scr = (LAS float*)(L + wave * 16384); conv_run(kargs(), 1, 11, scr, (bx - 128) * NWAVES + wave, 128 * NWAVES, lane); __syncthreads(); } }
    SEAM(1);
    if (IN(2)) { unsigned char* w = opq(args.ws); pg8::Gemm g{WP(bf16_t, WS_H), WP(bf16_t, WS_WD), S, DM, DFF, DFF}; pg8::StaticOrder so; so.init(S, DM, G, bx);
        pg8::EpiResid<true> E{nullptr, WP(bf16_t, WS_XB), WP(float, WS_SSQ1), 0.5f, 0.f}; pg8::gemm_phase<pg8::EpiResid<true>, pg8::StaticOrder, true, true>(L, g, so, E, wave); }
    SEAM(2);
    if (IN(3)) { unsigned char* w = opq(args.ws); pg8::Gemm g{WP(bf16_t, WS_XB), WP(bf16_t, WS_WIN), S, 5120, DM, DM}; pg8::StaticOrder so; so.init(S, 5120, G, bx);
        rs_fill(L, WP(const float, WS_SSQ1), 16, 0, 4, 1.f / 1024.f, 1.f, bx & 7, wave, lane); pg8::EpiProj E{WP(bf16_t, WS_LAT), WP(bf16_t, WS_QD), RT_PTR, WP(float, WS_SSQL), 0, 0}; pg8::gemm_phase<pg8::EpiProj, pg8::StaticOrder, true, true>(L, g, so, E, wave); }
    SEAM(3);
    if (IN(4)) {
        { unsigned char* w = opq(args.ws); pg8::Gemm g{WP(bf16_t, WS_XB), WP(bf16_t, WS_WIN) + (size_t)5120 * DM, S, 256, DM, DM}; pg8::StaticOrder so; so.init(S, 256, G, bx);
          rs_fill(L, WP(const float, WS_SSQ1), 16, 0, 4, 1.f / 1024.f, 1.f, bx & 7, wave, lane); pg8::EpiProj E{WP(bf16_t, WS_LAT), WP(bf16_t, WS_QD), RT_PTR, WP(float, WS_SSQL), 20, 0}; pg8::gemm_phase<pg8::EpiProj, pg8::StaticOrder, true, true>(L, g, so, E, wave); }
        unsigned char* w = opq(args.ws); const bool split = (G == 256); const int p0 = !split ? bx : (bx < 64 ? 1344 + bx : bx - 64), pst = !split ? G : (bx < 64 ? 64 : 192), pend = !split ? 1536 : (bx < 64 ? 1536 : 1344);
        dil::dil_phase((__attribute__((address_space(3))) char*)L, WP(bf16_t, WS_QD), WP(const bf16_t, WS_KD), WP(const bf16_t, WS_VD), args.in[2], WP(float, WS_LSE), p0, pst, pend, wave, lane); }
    SEAM(4);
    if (IN(5)) { unsigned char* w = opq(args.ws); LAS float* scr = (LAS float*)(L + wave * 16384);
        conv_run(kargs(), 11, 13, scr, gw, ngw, lane);
        const bf16_t* DO = WP(const bf16_t, WS_QD); const float* LSE = WP(const float, WS_LSE); const bf16_t* LAT = WP(const bf16_t, WS_LAT);
        const float* CS = WP(const float, WS_CS); const float* SN = WP(const float, WS_SN);
        bf16_t* KF = WP(bf16_t, WS_KF); bf16_t* DIL = WP(bf16_t, WS_DIL);
#pragma unroll 4
        for (int row = gw; row < S; row += ngw) {
            { const int j = lane >> 3, d0 = (lane & 7) * 8; const float* lp = LSE + (size_t)row * 24 + j;
              const float l0 = lp[0], l1 = lp[8], l2 = lp[16]; const float mx = fmaxf(l0, fmaxf(l1, l2));
              const float e0 = __expf(l0 - mx), e1 = __expf(l1 - mx), e2 = __expf(l2 - mx), inv = 1.f / (e0 + e1 + e2);
              const bf16_t* dp = DO + (size_t)row * 1536 + j * 64 + d0;
              const pg8::u32x4 a = *(const pg8::u32x4*)dp, b = *(const pg8::u32x4*)(dp + 512), c = *(const pg8::u32x4*)(dp + 1024);
              const float w0 = e0 * inv, w1 = e1 * inv, w2 = e2 * inv;
              const pg8::f32x4 o0 = pg8::bf4_lo((pg8::u32x2){a.x, a.y}) * w0 + pg8::bf4_lo((pg8::u32x2){b.x, b.y}) * w1 + pg8::bf4_lo((pg8::u32x2){c.x, c.y}) * w2;
              const pg8::f32x4 o1 = pg8::bf4_lo((pg8::u32x2){a.z, a.w}) * w0 + pg8::bf4_lo((pg8::u32x2){b.z, b.w}) * w1 + pg8::bf4_lo((pg8::u32x2){c.z, c.w}) * w2;
              *(pg8::u32x4*)(DIL + (size_t)row * 512 + j * 64 + d0) = pg8::pack8bf(o0, o1); }
            { const int h = lane >> 3, ii = (lane & 7) * 2; const bf16_t* lp = LAT + (size_t)row * 768 + 640;
              const unsigned xa = *(const unsigned*)(lp + ii), xb2 = *(const unsigned*)(lp + 16 + ii);
              const float x10 = __uint_as_float(xa << 16), x11 = __uint_as_float(xa & 0xffff0000u), x20 = __uint_as_float(xb2 << 16), x21 = __uint_as_float(xb2 & 0xffff0000u);
              const float c0 = CS[(size_t)row * 16 + ii], c1 = CS[(size_t)row * 16 + ii + 1], s0 = SN[(size_t)row * 16 + ii], s1 = SN[(size_t)row * 16 + ii + 1];
              *(unsigned*)(KF + (size_t)row * 768 + h * 96 + 64 + ii) = mk_pk2(x10 * c0 - x20 * s0, x11 * c1 - x21 * s1);
              *(unsigned*)(KF + (size_t)row * 768 + h * 96 + 80 + ii) = mk_pk2(x10 * s0 + x20 * c0, x11 * s1 + x21 * c1); }
        }
        __syncthreads();
        { unsigned char* w = opq(args.ws); pg8::Gemm g{WP(bf16_t, WS_LAT), WP(bf16_t, WS_WUQ), S, 768, QLORA, 768}; pg8::StaticOrder so; so.init(S, 768, G, bx);
          rs_fill(L, WP(const float, WS_SSQL), 32, 0, 3, 1.f / 384.f, 0.14724444602590306f, bx & 7, wave, lane); pg8::EpiQUp E{WP(bf16_t, WS_QF), RT_PTR, WP(float, WS_CS), WP(float, WS_SN)}; pg8::gemm_phase<pg8::EpiQUp, pg8::StaticOrder, true, true>(L, g, so, E, wave); }
        { unsigned char* w = opq(args.ws); pg8::Gemm g{WP(bf16_t, WS_LAT) + 384, WP(bf16_t, WS_WUKV), S, 1024, KVLORA, 768}; pg8::StaticOrder so; so.init(S, 1024, G, bx);
          rs_fill(L, WP(const float, WS_SSQL), 32, 12, 2, 1.f / 256.f, 1.f, bx & 7, wave, lane); pg8::EpiKVUp E{WP(bf16_t, WS_KF), WP(bf16_t, WS_VV), RT_PTR}; pg8::gemm_phase<pg8::EpiKVUp, pg8::StaticOrder, true, true>(L, g, so, E, wave); }
    }
    SEAM(5);
    if (IN(6)) { { unsigned char* w = opq(args.ws); mla::mla_phase((__attribute__((address_space(3))) char*)L, WP(const bf16_t, WS_QF), WP(const bf16_t, WS_KF), WP(const bf16_t, WS_VV), WP(bf16_t, WS_ATT), bx, G, wave, lane); }
        unsigned char* w = opq(args.ws); pg8::Gemm g{WP(bf16_t, WS_XB), WP(bf16_t, WS_WG), S, 2048, DM, DM}; pg8::StaticOrder so; so.init(S, 2048, G, bx);
        rs_fill(L, WP(const float, WS_SSQ1), 16, 0, 4, 1.f / 1024.f, 1.f, bx & 7, wave, lane); pg8::EpiGate E{WP(bf16_t, WS_G), args.in[10], RT_PTR}; pg8::gemm_phase<pg8::EpiGate, pg8::StaticOrder, true, true>(L, g, so, E, wave); }
    SEAM(6);
    if (IN(7)) { pg8::StaticOrder so; so.init(S, DM, G, bx);
        { unsigned char* w = opq(args.ws); pg8::Gemm g{WP(bf16_t, WS_ATT), WP(bf16_t, WS_WBA), S, DM, 512, 512}; pg8::EpiMerge<false> E{WP(bf16_t, WS_MG), WP(bf16_t, WS_G)}; pg8::gemm_phase<pg8::EpiMerge<false>, pg8::StaticOrder, true, true>(L, g, so, E, wave); }
        { unsigned char* w = opq(args.ws); pg8::Gemm g{WP(bf16_t, WS_DIL), WP(bf16_t, WS_WBD), S, DM, 512, 512}; pg8::EpiMerge<true> E{WP(bf16_t, WS_MG), WP(bf16_t, WS_G)}; pg8::gemm_phase<pg8::EpiMerge<true>, pg8::StaticOrder, true, true>(L, g, so, E, wave); } }
    SEAM(7);
    if (IN(8)) { unsigned char* w = opq(args.ws); pg8::Gemm g{WP(bf16_t, WS_MG), WP(bf16_t, WS_WO), S, DM, DM, DM}; pg8::StaticOrder so; so.init(S, DM, G, bx);
        pg8::EpiResid<true> E{nullptr, WP(bf16_t, WS_XB), WP(float, WS_SSQ2), 1.0f, 0.f}; pg8::gemm_phase<pg8::EpiResid<true>, pg8::StaticOrder, true, true>(L, g, so, E, wave); }
    SEAML(8);
    if (IN(9)) { unsigned char* w = opq(args.ws); pg8::Gemm g{WP(bf16_t, WS_XB), WP(bf16_t, WS_WGU), S, 2 * DFF, DM, DM}; pg8::StaticOrder so; so.init(S, 2 * DFF, G, bx);
        rs_fill(L, WP(const float, WS_SSQ2), 16, 0, 4, 1.f / 1024.f, 1.f, bx & 7, wave, lane); pg8::EpiSwiglu E{WP(bf16_t, WS_H), WP(float, WS_SSQ2), 1, RT_PTR}; pg8::gemm_phase<pg8::EpiSwiglu, pg8::StaticOrder, true, true>(L, g, so, E, wave); }
    SEAML(9);
    if (IN(10)) { unsigned char* w = opq(args.ws); pg8::Gemm g{WP(bf16_t, WS_H), WP(bf16_t, WS_WD), S, DM, DFF, DFF}; pg8::StaticOrder so; so.init(S, DM, G, bx);
        pg8::EpiFinal E{(const PGAS bf16_t*)WP(bf16_t, WS_XB), (PGAS float*)args.out, (const PGAS float*)args.in[3], (unsigned*)(w + 248 * MiB), (unsigned*)(w + WS_CTL) + 16384, 0.5f, 0.f};
        pg8::gemm_phase<pg8::EpiFinal, pg8::StaticOrder, true, true>(L, g, so, E, wave); }
#undef IN
#undef SEAM
#undef lane
#undef tid
}

#undef args
extern "C" void kernel_launch(void* const* d_in, const int* in_sizes, int n_in, void* d_out, int out_size, void* d_ws, size_t ws_size, hipStream_t stream) {
    float* R = (float*)d_out; unsigned char* ws = (unsigned char*)d_ws;
    if (ws_size < 256 * MiB || n_in != 22) { fprintf(stderr, "bad args: ws %zu n_in %d\n", ws_size, n_in); return; }
    static int grid = 0;
    if (grid == 0) {
        int dev = 0, cus = 0, per_cu = 0; (void)hipGetDevice(&dev); (void)hipDeviceGetAttribute(&cus, hipDeviceAttributeMultiprocessorCount, dev);
        if (hipFuncSetAttribute((const void*)mk_fwd, hipFuncAttributeMaxDynamicSharedMemorySize, MK_LDS_BYTES) != hipSuccess) fprintf(stderr, "hipFuncSetAttribute failed\n");
        if (hipOccupancyMaxActiveBlocksPerMultiprocessor(&per_cu, (const void*)mk_fwd, NWAVES * 64, MK_LDS_BYTES) != hipSuccess || per_cu < 1) { fprintf(stderr, "occupancy query: %d\n", per_cu); per_cu = 1; }
        (void)hipGetLastError();
        grid = cus * (per_cu < 1 ? 1 : per_cu);
        if (grid != 256) fprintf(stderr, "note: grid %d (per_cu %d)\n", grid, per_cu);
    }
    MkArgs a{}; for (int i = 0; i < 22; ++i) a.in[i] = (const float*)d_in[i]; a.out = R; a.ws = ws;
    InvFreq ifr; for (int i = 0; i < 16; ++i) ifr.f[i] = (float)(1.0 / pow(10000.0, (double)(2 * i) / 32.0));
    (void)hipMemsetAsync(ws + WS_CTL, 0, 131072, stream);
    a.ph_lo = 0; a.ph_hi = 11;
    void* kargs[] = {(void*)&a, (void*)&ifr};
    hipError_t le = hipLaunchCooperativeKernel((const void*)mk_fwd, dim3(grid), dim3(NWAVES * 64), kargs, MK_LDS_BYTES, stream);
    if (le != hipSuccess) fprintf(stderr, "cooperative launch failed: %s (grid %d)\n", hipGetErrorString(le), grid);
}
```

```cpp
#include <hip/hip_runtime.h>
#include <cstdio>
#include <cstdint>

typedef unsigned short bf16_t;
constexpr int S = 16384, DM = 1024, DFF = 2816, DIN = 7328;
constexpr int NH = 8, DQK = 96, DNOPE = 64, DROPE = 32, DV = 64, QLORA = 384, KVLORA = 256;
constexpr int DH = 64, NG = 3, HPG = 8;
constexpr float EPS = 1e-6f;

__device__ __forceinline__ float bf2f(bf16_t v) { return __uint_as_float(((unsigned)v) << 16); }
__device__ __forceinline__ bf16_t f2bf(float f) { unsigned u = __float_as_uint(f); return (bf16_t)((u + 0x7fffu + ((u >> 16) & 1u)) >> 16); }
__device__ __forceinline__ float ldf(const float* p) { return *p; }
__device__ __forceinline__ float ldf(const bf16_t* p) { return bf2f(*p); }
__device__ __forceinline__ float wave_sum(float v) {
#pragma unroll
    for (int o = 1; o < 64; o <<= 1) v += __shfl_xor(v, o);
    return v;
}

__device__ __forceinline__ void sincos_acc(float angf, float& c, float& s) {
    const double a = (double)angf;
    const double k = rint(a * 0.63661977236758134308);
    const double r = fma(-k, 1.5707963267948966192, a) - k * 6.123233995736766e-17;
    const double r2 = r * r;
    double sp = r * (1.0 + r2 * (-1.0 / 6 + r2 * (1.0 / 120 + r2 * (-1.0 / 5040 + r2 * (1.0 / 362880 + r2 * (-1.0 / 39916800 + r2 * (1.0 / 6227020800.0)))))));
    double cp = 1.0 + r2 * (-0.5 + r2 * (1.0 / 24 + r2 * (-1.0 / 720 + r2 * (1.0 / 40320 + r2 * (-1.0 / 3628800 + r2 * (1.0 / 479001600.0 + r2 * (-1.0 / 87178291200.0)))))));
    const int q = ((int)k) & 3;
    double ss = (q & 1) ? cp : sp, cc = (q & 1) ? sp : cp;
    if (q == 1) cc = -cc; if (q == 2) { ss = -ss; cc = -cc; } if (q == 3) ss = -ss;
    c = (float)cc; s = (float)ss;
}
struct InvFreq { float f[16]; };
namespace pg8 {
#define PG8_LAS __attribute__((address_space(3)))
typedef unsigned short bf16_t;
typedef short bf16x8 __attribute__((ext_vector_type(8)));
typedef float f32x4 __attribute__((ext_vector_type(4)));
typedef unsigned u32x4 __attribute__((ext_vector_type(4)));
constexpr int BM = 256, BK = 64, HALF = 128, HTB = HALF * BK * 2  , STAGE_BYTES = 8 * HTB, NXCD = 8, WGM = 8;

__host__ __device__ __forceinline__ int lds_byte(int r, int c) { const int st = (r >> 4) * 2 + (c >> 5), rr = r & 15, cc = c & 31, ob = rr * 64 + cc * 2; return st * 1024 + (ob ^ (((ob >> 9) & 1) << 5)); }
__host__ __device__ __forceinline__ void stage_rc(int b, int& R, int& C) { const int st = b / 1024, sb = b % 1024, swz = sb ^ (((sb >> 9) & 1) << 5); R = (st >> 1) * 16 + swz / 64; C = (st & 1) * 32 + (swz % 64) / 2; }
__host__ __device__ __forceinline__ int perm32(int rho) { const int n = rho >> 4, i = rho & 15; return 8 * (i >> 2) + 4 * n + (i & 3); }

struct Unit { int pm, pn; };
struct Gemm { const bf16_t* A; const bf16_t* Bt; int M, N, K, lda; };

struct StaticOrder {
    int nM, nN, nwg, G, c;
    __host__ __device__ void init(int M, int N, int G_, int c_) { nM = M / BM; nN = N / BM; nwg = nM * nN; G = G_; c = c_; }
    __host__ __device__ bool next(int i, Unit& u) const {
        const long L = (long)i * G + c; if (L >= nwg) return false;
        int wgid = (int)L; { const int q = nwg / NXCD, r = nwg % NXCD, xcd = wgid % NXCD, off = wgid / NXCD; wgid = (xcd < r ? xcd * (q + 1) : r * (q + 1) + (xcd - r) * q) + off; }
        const int nig = WGM * nN, gid = wgid / nig, fm = gid * WGM, gsz = (nM - fm) < WGM ? (nM - fm) : WGM;
        u.pm = fm + ((wgid % nig) % gsz); u.pn = (wgid % nig) / gsz; return true;
    }
    __device__ __forceinline__ void a_ready(const Unit&) const {}
    __device__ __forceinline__ void done(const Unit&) const {}
};

__device__ __forceinline__ unsigned cvt_pk_bf16(float lo, float hi) { unsigned r; asm volatile("v_cvt_pk_bf16_f32 %0, %1, %2" : "=v"(r) : "v"(lo), "v"(hi)); return r; }
template <class Epi, class Sched, bool ALIGN_EPI = false, bool SP2 = false>
__device__ __forceinline__ void gemm_phase(PG8_LAS unsigned char* lds, const Gemm g, const Sched& S, const Epi& E, const int wid) {
    int lane_ = (int)__builtin_amdgcn_mbcnt_hi(~0u, __builtin_amdgcn_mbcnt_lo(~0u, 0u)); asm volatile("" : "+v"(lane_));
    const int lane = lane_, tid = wid * 64 + lane, wr = wid >> 2, wc = wid & 3, fr = lane & 15, fq = lane >> 4;
    int K_ = g.K; asm volatile("" : "+s"(K_)); const int K = K_, nt = K / BK;
    unsigned voffA[2], voffB[2];
#pragma unroll
    for (int i = 0; i < 2; ++i) { int R, C; stage_rc(tid * 16 + i * 8192, R, C); const int Rb = Epi::PERM ? ((R & ~31) + perm32(R & 31)) : R;
        voffA[i] = (unsigned)(R * g.lda + C) * 2u; voffB[i] = (unsigned)(Rb * K + C) * 2u; }
    const size_t kstep = (size_t)(BK * 2);
    const size_t hstepB = (size_t)HALF * K * 2, hstepA = (size_t)HALF * g.lda * 2;
    const size_t tstepB = 2 * hstepB, tstepA = 2 * hstepA;
    const unsigned ldsw = (unsigned)wid * 1024u;
    const int aoff = lds_byte(wr * 64 + fr, fq * 8), boff = lds_byte(wc * 32 + fr, fq * 8);
#define PG8_SA(b, h) (((b) * 2 + (h)) * HTB)
#define PG8_SB(b, h) ((4 + (b) * 2 + (h)) * HTB)
#define PG8_STAGE(bufoff, gbase, voff) do { _Pragma("unroll") for (int _i = 0; _i < 2; ++_i) \
        __builtin_amdgcn_global_load_lds((const unsigned*)((const char*)(gbase) + (voff)[_i]), (PG8_LAS unsigned*)(lds + (bufoff) + ldsw + _i * 8192), 16, 0, 0); } while (0)
#define PG8_LDA(dst, b, h) do { _Pragma("unroll") for (int m = 0; m < 4; ++m) _Pragma("unroll") for (int k = 0; k < 2; ++k) dst[m][k] = *(const PG8_LAS bf16x8*)(lds + PG8_SA(b, h) + aoff + m * 2048 + k * 1024); } while (0)
#define PG8_LDB(dst, b, h) do { _Pragma("unroll") for (int n = 0; n < 2; ++n) _Pragma("unroll") for (int k = 0; k < 2; ++k) dst[n][k] = *(const PG8_LAS bf16x8*)(lds + PG8_SB(b, h) + boff + n * 2048 + k * 1024); } while (0)
#define PG8_MMA(ai, bj, At, Bt) do { __builtin_amdgcn_s_setprio(1); _Pragma("unroll") for (int m = 0; m < 4; ++m) _Pragma("unroll") for (int n = 0; n < 2; ++n) _Pragma("unroll") for (int k = 0; k < 2; ++k) \
        acc[ai][bj][m][n] = __builtin_amdgcn_mfma_f32_16x16x32_bf16(Bt[n][k], At[m][k], acc[ai][bj][m][n], 0, 0, 0); __builtin_amdgcn_s_setprio(0); } while (0)
#define PG8_WAIT_V(n) asm volatile("s_waitcnt vmcnt(" #n ")" ::: "memory")
#define PG8_WAIT_L(n) asm volatile("s_waitcnt lgkmcnt(" #n ")" ::: "memory")
#define PG8_BAR __builtin_amdgcn_s_barrier()
#define PG8_SCHED __builtin_amdgcn_sched_barrier(0)
    Unit cur, nxt; int ui = 0;
    if (!S.next(0, cur)) return;
    f32x4 acc[2][2][4][2];
#pragma unroll
    for (int a = 0; a < 2; ++a)
#pragma unroll
        for (int b = 0; b < 2; ++b)
#pragma unroll
            for (int m = 0; m < 4; ++m)
#pragma unroll
                for (int n = 0; n < 2; ++n) acc[a][b][m][n] = (f32x4){0.f, 0.f, 0.f, 0.f};
    bf16x8 At[4][2], B0[2][2], B1[2][2];
    const char* cA = (const char*)g.A + (size_t)cur.pm * tstepA; const char* cB = (const char*)g.Bt + (size_t)cur.pn * tstepB;
    S.a_ready(cur);
    if constexpr (SP2) {
        PG8_STAGE(PG8_SB(0, 0), cB, voffB); PG8_STAGE(PG8_SB(0, 1), cB + hstepB, voffB); PG8_STAGE(PG8_SA(0, 0), cA, voffA); PG8_STAGE(PG8_SA(0, 1), cA + hstepA, voffA);
        if (wr == 1) PG8_BAR;
        PG8_WAIT_V(2); PG8_BAR;
        PG8_STAGE(PG8_SB(1, 0), cB + kstep, voffB); PG8_STAGE(PG8_SA(1, 0), cA + kstep, voffA); PG8_STAGE(PG8_SB(1, 1), cB + hstepB + kstep, voffB);
        PG8_WAIT_V(6); PG8_BAR;
    } else {
        PG8_STAGE(PG8_SB(0, 0), cB, voffB); PG8_STAGE(PG8_SA(0, 0), cA, voffA); PG8_STAGE(PG8_SB(0, 1), cB + hstepB, voffB); PG8_STAGE(PG8_SA(0, 1), cA + hstepA, voffA);
        if (wr == 1) PG8_BAR;
        PG8_WAIT_V(4); PG8_BAR;
        PG8_STAGE(PG8_SB(1, 0), cB + kstep, voffB); PG8_STAGE(PG8_SA(1, 0), cA + kstep, voffA); PG8_STAGE(PG8_SB(1, 1), cB + hstepB + kstep, voffB);
        PG8_WAIT_V(6); PG8_BAR;
    }
    for (;;) {
        const bool has_next = S.next(ui + 1, nxt);
        const char* nA = has_next ? (const char*)g.A + (size_t)nxt.pm * tstepA : cA; const char* nB = has_next ? (const char*)g.Bt + (size_t)nxt.pn * tstepB : cB;
        for (int t = 0; t < nt; t += 2) {
            const bool last = (t == nt - 2);
            const char* a1 = cA + (size_t)(t + 1) * kstep;
            const char* a2 = last ? nA : cA + (size_t)(t + 2) * kstep; const char* b2 = last ? nB : cB + (size_t)(t + 2) * kstep;
            const char* a3 = a2 + kstep; const char* b3 = b2 + kstep;
            if (last && has_next) S.a_ready(nxt);
            if constexpr (SP2) {
            PG8_LDB(B0, 0, 0); PG8_LDB(B1, 0, 1); PG8_SCHED; PG8_LDA(At, 0, 0); PG8_STAGE(PG8_SA(1, 1), a1 + hstepA, voffA);
            PG8_WAIT_V(8); PG8_WAIT_L(0); PG8_BAR; PG8_MMA(0, 0, At, B0); PG8_MMA(0, 1, At, B1); PG8_BAR; PG8_SCHED;
            PG8_LDA(At, 0, 1); PG8_STAGE(PG8_SB(0, 0), b2, voffB); PG8_STAGE(PG8_SB(0, 1), b2 + hstepB, voffB); PG8_STAGE(PG8_SA(0, 0), a2, voffA);
            PG8_WAIT_V(8); PG8_WAIT_L(0); PG8_BAR; PG8_MMA(1, 0, At, B0); PG8_MMA(1, 1, At, B1); PG8_BAR; PG8_SCHED;
            PG8_LDB(B0, 1, 0); PG8_LDB(B1, 1, 1); PG8_SCHED; PG8_LDA(At, 1, 0); PG8_STAGE(PG8_SA(0, 1), a2 + hstepA, voffA);
            PG8_WAIT_V(8); PG8_WAIT_L(0); PG8_BAR; PG8_MMA(0, 0, At, B0); PG8_MMA(0, 1, At, B1); PG8_BAR; PG8_SCHED;
            PG8_LDA(At, 1, 1); PG8_STAGE(PG8_SB(1, 0), b3, voffB); PG8_STAGE(PG8_SB(1, 1), b3 + hstepB, voffB); PG8_STAGE(PG8_SA(1, 0), a3, voffA);
            PG8_WAIT_V(8); PG8_WAIT_L(0); PG8_BAR; PG8_MMA(1, 0, At, B0); PG8_MMA(1, 1, At, B1); PG8_BAR; PG8_SCHED;
            } else {
            PG8_LDB(B0, 0, 0); PG8_SCHED; PG8_LDA(At, 0, 0); PG8_STAGE(PG8_SA(1, 1), a1 + hstepA, voffA);
            PG8_WAIT_L(8); PG8_BAR; PG8_WAIT_L(0); PG8_MMA(0, 0, At, B0); PG8_BAR; PG8_SCHED;
            PG8_LDB(B1, 0, 1); PG8_STAGE(PG8_SB(0, 0), b2, voffB);
            PG8_BAR; PG8_WAIT_L(0); PG8_MMA(0, 1, At, B1); PG8_BAR;
            PG8_LDA(At, 0, 1); PG8_STAGE(PG8_SA(0, 0), a2, voffA);
            PG8_BAR; PG8_WAIT_L(0); PG8_MMA(1, 0, At, B0); PG8_BAR; PG8_SCHED;
            PG8_STAGE(PG8_SB(0, 1), b2 + hstepB, voffB);
            PG8_WAIT_V(6); PG8_BAR; PG8_MMA(1, 1, At, B1); PG8_BAR;
            PG8_LDB(B0, 1, 0); PG8_SCHED; PG8_LDA(At, 1, 0); PG8_STAGE(PG8_SA(0, 1), a2 + hstepA, voffA);
            PG8_WAIT_L(8); PG8_BAR; PG8_WAIT_L(0); PG8_MMA(0, 0, At, B0); PG8_BAR; PG8_SCHED;
            PG8_LDB(B1, 1, 1); PG8_STAGE(PG8_SB(1, 0), b3, voffB);
            PG8_BAR; PG8_WAIT_L(0); PG8_MMA(0, 1, At, B1); PG8_BAR;
            PG8_LDA(At, 1, 1); PG8_STAGE(PG8_SA(1, 0), a3, voffA);
            PG8_BAR; PG8_WAIT_L(0); PG8_MMA(1, 0, At, B0); PG8_BAR; PG8_SCHED;
            PG8_STAGE(PG8_SB(1, 1), b3 + hstepB, voffB);
            PG8_WAIT_V(6); PG8_BAR; PG8_MMA(1, 1, At, B1); PG8_BAR;
            }
        }
        if constexpr (ALIGN_EPI) { if (wr == 0) PG8_BAR; }
        if constexpr (!Epi::AFTER_DRAIN) { E(acc, cur, wr, wc, fr, fq); S.done(cur); }
        if (!has_next) break;
#pragma unroll
        for (int a = 0; a < 2; ++a)
#pragma unroll
            for (int b = 0; b < 2; ++b)
#pragma unroll
                for (int m = 0; m < 4; ++m)
#pragma unroll
                    for (int n = 0; n < 2; ++n) acc[a][b][m][n] = (f32x4){0.f, 0.f, 0.f, 0.f};
        cur = nxt; cA = nA; cB = nB; ++ui;
        if constexpr (ALIGN_EPI) { if (wr == 1) PG8_BAR; }
    }
    PG8_WAIT_V(0);
    if constexpr (!ALIGN_EPI) { if (wr == 0) PG8_BAR; }
    PG8_BAR;
    if constexpr (Epi::AFTER_DRAIN) { E.fused(acc, cur, wr, wc, fr, fq, lds, wid, lane); S.done(cur); }
#undef PG8_SA
#undef PG8_SB
#undef PG8_STAGE
#undef PG8_LDA
#undef PG8_LDB
#undef PG8_MMA
#undef PG8_WAIT_V
#undef PG8_WAIT_L
#undef PG8_BAR
#undef PG8_SCHED
}
}
namespace pg8 {
typedef unsigned u32x2 __attribute__((ext_vector_type(2)));
constexpr int S_ = 16384;
__device__ __forceinline__ float hsum4(f32x4 a) { return (a[0] + a[1]) + (a[2] + a[3]); }
__device__ __forceinline__ float dot4(f32x4 a) { return (a[0] * a[0] + a[1] * a[1]) + (a[2] * a[2] + a[3] * a[3]); }
__device__ __forceinline__ float sumslots(const float* p, int n4) { float s = 0.f; for (int i = 0; i < n4; ++i) s += hsum4(*(const f32x4*)(p + 4 * i)); return s; }
__device__ __forceinline__ u32x4 pack8bf(f32x4 a, f32x4 b) { u32x4 w; w.x = cvt_pk_bf16(a[0], a[1]); w.y = cvt_pk_bf16(a[2], a[3]); w.z = cvt_pk_bf16(b[0], b[1]); w.w = cvt_pk_bf16(b[2], b[3]); return w; }
__device__ __forceinline__ float silu_mul(float g, float u) { const float e = __builtin_amdgcn_exp2f(g * -1.4426950408889634f); return g * __builtin_amdgcn_rcpf(1.f + e) * u; }
__device__ __forceinline__ float sigmoidf_(float z) { const float e = __builtin_amdgcn_exp2f(z * -1.4426950408889634f); return __builtin_amdgcn_rcpf(1.f + e); }
__device__ __forceinline__ f32x4 bf4_lo(u32x2 w) { return (f32x4){__uint_as_float(w.x << 16), __uint_as_float(w.x & 0xffff0000u), __uint_as_float(w.y << 16), __uint_as_float(w.y & 0xffff0000u)}; }

struct EpiSwiglu { static constexpr bool PERM = true, AFTER_DRAIN = false;
    bf16_t* H; const float* rs; int rs_slots; const __attribute__((address_space(3))) float* rt;
    __device__ __forceinline__ void operator()(const f32x4 (&acc)[2][2][4][2], const Unit& u, int wr, int wc, int fr, int fq) const {
        const int row0 = u.pm * BM + wr * 64 + fr, col0 = u.pn * 128 + wc * 32 + 8 * fq;
#pragma unroll
        for (int ai = 0; ai < 2; ++ai)
#pragma unroll
            for (int m = 0; m < 4; ++m) { const int row = row0 + ai * HALF + m * 16;
                const float r = rs_slots ? rt[row & 2047] : rs[row];
                f32x4 h0, h1;
#pragma unroll
                for (int e = 0; e < 4; ++e) { h0[e] = silu_mul(acc[ai][0][m][0][e] * r, acc[ai][1][m][0][e] * r); h1[e] = silu_mul(acc[ai][0][m][1][e] * r, acc[ai][1][m][1][e] * r); }
                *(u32x4*)(H + (size_t)row * 2816 + col0) = pack8bf(h0, h1); }
    }
};
template <bool BASE_BF16> struct EpiResid { static constexpr bool PERM = true, AFTER_DRAIN = false;
    const float* basef; bf16_t* xb; float* ssq; float scale; float pad;
    __device__ __forceinline__ void operator()(const f32x4 (&acc)[2][2][4][2], const Unit& u, int wr, int wc, int fr, int fq) const {
        const int row0 = u.pm * BM + wr * 64 + fr, col0 = u.pn * BM + wc * 32 + 8 * fq;
#pragma unroll
        for (int ai = 0; ai < 2; ++ai)
#pragma unroll
            for (int m = 0; m < 4; ++m) { const int row = row0 + ai * HALF + m * 16; float q = 0.f;
#pragma unroll
                for (int bj = 0; bj < 2; ++bj) { const size_t off = (size_t)row * 1024 + col0 + bj * HALF; f32x4 b0, b1;
                    if (BASE_BF16) { const u32x4 bw = *(const u32x4*)(xb + off); b0 = bf4_lo((u32x2){bw.x, bw.y}); b1 = bf4_lo((u32x2){bw.z, bw.w}); }
                    else { b0 = *(const f32x4*)(basef + off); b1 = *(const f32x4*)(basef + off + 4); }
                    const f32x4 v0 = b0 + acc[ai][bj][m][0] * scale, v1 = b1 + acc[ai][bj][m][1] * scale;
                    *(u32x4*)(xb + off) = pack8bf(v0, v1); q += dot4(v0) + dot4(v1); }
                q += __shfl_xor(q, 16); q += __shfl_xor(q, 32);
                if (fq == 0) ssq[(size_t)row * 16 + u.pn * 4 + wc] = q; }
    }
};
struct EpiProj { static constexpr bool PERM = true, AFTER_DRAIN = false;
    bf16_t* LAT; bf16_t* QKV; const __attribute__((address_space(3))) float* rt; float* ssql; int pn_base; int pad;
    __device__ __forceinline__ void operator()(const f32x4 (&acc)[2][2][4][2], const Unit& u, int wr, int wc, int fr, int fq) const {
        const int pe = u.pn + pn_base, lt = pe - 18; const int row0 = u.pm * BM + wr * 64 + fr; const bool lat = pe >= 18;
        const int t = pe, w = t / 6, cc = (t - w * 6) * 256;
        bf16_t* dst = lat ? LAT + lt * 256 : QKV + (size_t)w * ((size_t)S_ * 1536) + cc; const int ld = lat ? 768 : 1536;
#pragma unroll
        for (int ai = 0; ai < 2; ++ai)
#pragma unroll
            for (int m = 0; m < 4; ++m) { const int row = row0 + ai * HALF + m * 16;
                const float r = rt[row & 2047];
#pragma unroll
                for (int bj = 0; bj < 2; ++bj) { const f32x4 v0 = acc[ai][bj][m][0] * r, v1 = acc[ai][bj][m][1] * r;
                    *(u32x4*)(dst + (size_t)row * ld + bj * HALF + wc * 32 + 8 * fq) = pack8bf(v0, v1);
                    if (lat) { float q = dot4(v0) + dot4(v1); q += __shfl_xor(q, 16); q += __shfl_xor(q, 32); if (fq == 0) ssql[(size_t)row * 32 + lt * 8 + bj * 4 + wc] = q; } } }
    }
};
struct EpiGate { static constexpr bool PERM = true, AFTER_DRAIN = false;
    bf16_t* G; const float* b; const __attribute__((address_space(3))) float* rt;
    __device__ __forceinline__ void operator()(const f32x4 (&acc)[2][2][4][2], const Unit& u, int wr, int wc, int fr, int fq) const {
        const int row0 = u.pm * BM + wr * 64 + fr, col0 = u.pn * BM + wc * 32 + 8 * fq;
#pragma unroll
        for (int ai = 0; ai < 2; ++ai)
#pragma unroll
            for (int m = 0; m < 4; ++m) { const int row = row0 + ai * HALF + m * 16;
                const float r = rt[row & 2047];
#pragma unroll
                for (int bj = 0; bj < 2; ++bj) { const f32x4 b0 = *(const f32x4*)(b + col0 + bj * HALF), b1 = *(const f32x4*)(b + col0 + bj * HALF + 4);
                    f32x4 v0 = acc[ai][bj][m][0] * r + b0, v1 = acc[ai][bj][m][1] * r + b1;
#pragma unroll
                    for (int e = 0; e < 4; ++e) { v0[e] = sigmoidf_(v0[e]); v1[e] = sigmoidf_(v1[e]); }
                    *(u32x4*)(G + (size_t)row * 2048 + col0 + bj * HALF) = pack8bf(v0, v1); } }
    }
};
template <bool SECOND> struct EpiMerge { static constexpr bool PERM = true, AFTER_DRAIN = false;
    bf16_t* MG; const bf16_t* G;
    __device__ __forceinline__ void operator()(const f32x4 (&acc)[2][2][4][2], const Unit& u, int wr, int wc, int fr, int fq) const {
        const int row0 = u.pm * BM + wr * 64 + fr, col0 = u.pn * BM + wc * 32 + 8 * fq;
        const __attribute__((address_space(1))) bf16_t* Gg = (const __attribute__((address_space(1))) bf16_t*)G; __attribute__((address_space(1))) bf16_t* Mg = (__attribute__((address_space(1))) bf16_t*)MG;
#pragma unroll
        for (int ai = 0; ai < 2; ++ai) {
            u32x4 gw[4][2], pw[4][2];
#pragma unroll
            for (int m = 0; m < 4; ++m)
#pragma unroll
                for (int bj = 0; bj < 2; ++bj) { const int row = row0 + ai * HALF + m * 16, col = col0 + bj * HALF;
                    gw[m][bj] = *(const __attribute__((address_space(1))) u32x4*)(Gg + (size_t)row * 2048 + (SECOND ? 1024 : 0) + col);
                    if (SECOND) pw[m][bj] = *(const __attribute__((address_space(1))) u32x4*)(Mg + (size_t)row * 1024 + col); }
#pragma unroll
            for (int m = 0; m < 4; ++m)
#pragma unroll
                for (int bj = 0; bj < 2; ++bj) { const int row = row0 + ai * HALF + m * 16, col = col0 + bj * HALF; const u32x4 g4 = gw[m][bj];
                    f32x4 v0 = bf4_lo((u32x2){g4.x, g4.y}) * acc[ai][bj][m][0], v1 = bf4_lo((u32x2){g4.z, g4.w}) * acc[ai][bj][m][1];
                    if (SECOND) { const u32x4 p4 = pw[m][bj]; v0 += bf4_lo((u32x2){p4.x, p4.y}); v1 += bf4_lo((u32x2){p4.z, p4.w}); }
                    *(__attribute__((address_space(1))) u32x4*)(Mg + (size_t)row * 1024 + col) = pack8bf(v0, v1); } }
    }
};
struct EpiQUp { static constexpr bool PERM = false, AFTER_DRAIN = false;
    bf16_t* QF; const __attribute__((address_space(3))) float* rt; const float* cs; const float* sn;
    __device__ __forceinline__ void operator()(const f32x4 (&acc)[2][2][4][2], const Unit& u, int wr, int wc, int fr, int fq) const {
        const int row0 = u.pm * BM + wr * 64 + fr;
#pragma unroll
        for (int ai = 0; ai < 2; ++ai)
#pragma unroll
            for (int m = 0; m < 4; ++m) { const int row = row0 + ai * HALF + m * 16;
                const float r = rt[row & 2047];
#pragma unroll
                for (int bj = 0; bj < 2; ++bj) { const int cg = u.pn * BM + bj * HALF + wc * 32; const bool rope = (cg % 96) == 64;
                    f32x4 x1 = acc[ai][bj][m][0] * r, x2 = acc[ai][bj][m][1] * r;
                    if (rope) { const f32x4 c = *(const f32x4*)(cs + (size_t)row * 16 + 4 * fq), s = *(const f32x4*)(sn + (size_t)row * 16 + 4 * fq);
                        const f32x4 y1 = x1 * c - x2 * s, y2 = x1 * s + x2 * c; x1 = y1; x2 = y2; }
                    u32x2 w1, w2; w1.x = cvt_pk_bf16(x1[0], x1[1]); w1.y = cvt_pk_bf16(x1[2], x1[3]); w2.x = cvt_pk_bf16(x2[0], x2[1]); w2.y = cvt_pk_bf16(x2[2], x2[3]);
                    const bool oddq = (fq & 1) != 0; const u32x2 snd = oddq ? w1 : w2; u32x2 rcv; rcv.x = (unsigned)__shfl_xor((int)snd.x, 16); rcv.y = (unsigned)__shfl_xor((int)snd.y, 16);
                    const u32x4 ov = oddq ? (u32x4){rcv.x, rcv.y, w2.x, w2.y} : (u32x4){w1.x, w1.y, rcv.x, rcv.y};
                    *(u32x4*)(QF + (size_t)row * 768 + cg + 4 * fq + (oddq ? 12 : 0)) = ov; }
                asm volatile("" ::: "memory"); }
    }
};
struct EpiKVUp { static constexpr bool PERM = true, AFTER_DRAIN = false;
    bf16_t* KF; bf16_t* VV; const __attribute__((address_space(3))) float* rt;
    __device__ __forceinline__ void operator()(const f32x4 (&acc)[2][2][4][2], const Unit& u, int wr, int wc, int fr, int fq) const {
        const int row0 = u.pm * BM + wr * 64 + fr;
#pragma unroll
        for (int ai = 0; ai < 2; ++ai)
#pragma unroll
            for (int m = 0; m < 4; ++m) { const int row = row0 + ai * HALF + m * 16;
                const float r = rt[row & 2047];
#pragma unroll
                for (int bj = 0; bj < 2; ++bj) { const int h = u.pn * 2 + bj, d = wc * 32 + 8 * fq;
                    bf16_t* dst = (wc < 2) ? KF + (size_t)row * 768 + h * 96 + d : VV + (size_t)row * 512 + h * 64 + (d - 64);
                    *(u32x4*)dst = pack8bf(acc[ai][bj][m][0] * r, acc[ai][bj][m][1] * r); }
                asm volatile("" ::: "memory"); }
    }
};
#define PGAS __attribute__((address_space(1)))
struct EpiFinal { static constexpr bool PERM = true, AFTER_DRAIN = false;
    const PGAS bf16_t* base; PGAS float* out; const PGAS float* gfin; unsigned* slots; unsigned* cnt; float scale; float pad;
    __device__ __forceinline__ void operator()(f32x4 (&acc)[2][2][4][2], const Unit& u, int wr, int wc, int fr, int fq) const {
        const int row0 = u.pm * BM + wr * 64 + fr, col0 = u.pn * BM + wc * 32 + 8 * fq;
        { u32x4 bw[2][4][2];
#pragma unroll
          for (int ai = 0; ai < 2; ++ai)
#pragma unroll
            for (int m = 0; m < 4; ++m)
#pragma unroll
                for (int bj = 0; bj < 2; ++bj) bw[ai][m][bj] = *(const PGAS u32x4*)(base + (size_t)(row0 + ai * HALF + m * 16) * 1024 + col0 + bj * HALF);
#pragma unroll
          for (int ai = 0; ai < 2; ++ai)
#pragma unroll
            for (int m = 0; m < 4; ++m) { const int row = row0 + ai * HALF + m * 16; float q = 0.f;
#pragma unroll
                for (int bj = 0; bj < 2; ++bj) { const u32x4 w = bw[ai][m][bj];
                    const f32x4 v0 = bf4_lo((u32x2){w.x, w.y}) + acc[ai][bj][m][0] * scale, v1 = bf4_lo((u32x2){w.z, w.w}) + acc[ai][bj][m][1] * scale;
                    acc[ai][bj][m][0] = v0; acc[ai][bj][m][1] = v1; q += dot4(v0) + dot4(v1); }
                q += __shfl_xor(q, 16); q += __shfl_xor(q, 32);
                if (fq == 0) __hip_atomic_store(slots + (size_t)row * 16 + u.pn * 4 + wc, __float_as_uint(q), __ATOMIC_RELAXED, __HIP_MEMORY_SCOPE_AGENT); } }
        asm volatile("s_waitcnt vmcnt(0)" ::: "memory");
        unsigned* c = cnt + 64 * u.pm;
        if (fr == 0 && fq == 0) __hip_atomic_fetch_add(c, 1u, __ATOMIC_RELAXED, __HIP_MEMORY_SCOPE_AGENT);
        { unsigned sp = 0; while ((unsigned)__builtin_amdgcn_readfirstlane(__hip_atomic_load(c, __ATOMIC_RELAXED, __HIP_MEMORY_SCOPE_AGENT)) < 32u) { __builtin_amdgcn_s_sleep(2); if (++sp > (1u << 22)) break; } }
        asm volatile("" ::: "memory");
        unsigned long long sw[2][4][2];
#pragma unroll
        for (int ai = 0; ai < 2; ++ai)
#pragma unroll
            for (int m = 0; m < 4; ++m) { const unsigned long long* sl = (const unsigned long long*)(slots + (size_t)(row0 + ai * HALF + m * 16) * 16 + 4 * fq);
                sw[ai][m][0] = __hip_atomic_load(sl, __ATOMIC_RELAXED, __HIP_MEMORY_SCOPE_AGENT); sw[ai][m][1] = __hip_atomic_load(sl + 1, __ATOMIC_RELAXED, __HIP_MEMORY_SCOPE_AGENT); }
#pragma unroll
        for (int ai = 0; ai < 2; ++ai)
#pragma unroll
            for (int m = 0; m < 4; ++m) { const int row = row0 + ai * HALF + m * 16;
                float ss = (__uint_as_float((unsigned)sw[ai][m][0]) + __uint_as_float((unsigned)(sw[ai][m][0] >> 32))) + (__uint_as_float((unsigned)sw[ai][m][1]) + __uint_as_float((unsigned)(sw[ai][m][1] >> 32)));
                ss += __shfl_xor(ss, 16); ss += __shfl_xor(ss, 32);
                const float r = rsqrtf(ss * (1.f / 1024.f) + 1e-6f);
#pragma unroll
                for (int bj = 0; bj < 2; ++bj) { const size_t off = (size_t)row * 1024 + col0 + bj * HALF;
                    const f32x4 g0 = *(const PGAS f32x4*)(gfin + col0 + bj * HALF), g1 = *(const PGAS f32x4*)(gfin + col0 + bj * HALF + 4);
                    *(PGAS f32x4*)(out + off) = acc[ai][bj][m][0] * r * g0; *(PGAS f32x4*)(out + off + 4) = acc[ai][bj][m][1] * r * g1; } }
    }
};
}

namespace mla {
#define MLAS __attribute__((address_space(3)))
#define MGAS __attribute__((address_space(1)))
constexpr int NW = 8, QBLK = 32, KVBLK = 64, QB = NW * QBLK, QS = 768, KS = 768, VS = 512, OS = 512, NSTEP = 6;
constexpr int SHM_V = KVBLK * 64 * 2, SHM_K = KVBLK * 256;
constexpr int LDS_BYTES = 2 * SHM_V + 2 * SHM_K + NW * 64 * 4;
constexpr float SCALE = 0.10206207261596575f, THR = 8.f;
constexpr unsigned WIN = 0x40000000u;
typedef short bf16x8 __attribute__((ext_vector_type(8)));
typedef short s16x4 __attribute__((ext_vector_type(4)));
typedef float f32x16 __attribute__((ext_vector_type(16)));
typedef unsigned u32x4 __attribute__((ext_vector_type(4)));
#define MLA_KSWZ(row, colB) ((row) * 256 + ((colB) ^ (((row) & 7) << 4)))
#define MLA_SBAR() __builtin_amdgcn_sched_barrier(0)
__device__ __forceinline__ int v_st(int k, int c) { const int kk = (k & ~0xC) | ((k & 4) << 1) | ((k & 8) >> 1); return ((kk >> 3) * 2 + (c >> 5)) * 512 + ((kk & 7) * 32 + (c & 31)) * 2; }
__device__ __forceinline__ int v_rd_base(int lane) { return ((lane & 3) << 3) | (((lane >> 2) & 3) << 6) | (((lane >> 4) & 1) << 5) | (((lane >> 5) & 1) << 8); }
__device__ __forceinline__ int crow(int r, int hi) { return (r & 3) + 8 * (r >> 2) + 4 * hi; }
__device__ __forceinline__ unsigned cvtpk(float lo, float hi) { unsigned r; asm volatile("v_cvt_pk_bf16_f32 %0, %1, %2" : "=v"(r) : "v"(lo), "v"(hi)); return r; }
__device__ __forceinline__ void mask_tile(f32x16& p0, f32x16& p1, int dq) {
    const float NEG = -__builtin_inff();
#pragma unroll
    for (int r = 0; r < 16; ++r) { const int c = (r & 3) + 8 * (r >> 2);
        if ((unsigned)(dq - c) >= WIN) p0[r] = NEG;
        if ((unsigned)(dq - c - 32) >= WIN) p1[r] = NEG; }
}
__device__ __forceinline__ void partialSM(f32x16& p0, f32x16& p1, float& m_reg, float& mn, float& alpha) {
    float pm_[4] = {p0[0], p0[1], p0[2], p0[3]};
#pragma unroll
    for (int r = 4; r < 16; ++r) pm_[r & 3] = fmaxf(pm_[r & 3], p0[r]);
#pragma unroll
    for (int r = 0; r < 16; ++r) pm_[r & 3] = fmaxf(pm_[r & 3], p1[r]);
    float pmax = fmaxf(fmaxf(pm_[0], pm_[1]), fmaxf(pm_[2], pm_[3]));
    { auto rr = __builtin_amdgcn_permlane32_swap(__float_as_uint(pmax), __float_as_uint(pmax), false, false);
      pmax = fmaxf(__uint_as_float(rr[0]), __uint_as_float(rr[1])); }
    constexpr float C2 = 1.4426950408889634f * SCALE;
    if (__builtin_expect(__all((pmax - m_reg) * SCALE <= THR), 1)) { mn = m_reg; alpha = 1.f; }
    else { mn = fmaxf(m_reg, pmax); alpha = __builtin_amdgcn_exp2f((m_reg - mn) * C2); m_reg = mn; }
    const float mnL = -mn * C2;
#pragma unroll
    for (int r = 0; r < 16; ++r) p0[r] = fmaf(p0[r], C2, mnL);
#pragma unroll
    for (int r = 0; r < 16; ++r) p1[r] = fmaf(p1[r], C2, mnL);
#pragma unroll
    for (int r = 0; r < 16; ++r) p0[r] = __builtin_amdgcn_exp2f(p0[r]);
}
__device__ __forceinline__ void finishSM(f32x16& p0, f32x16& p1, float alpha, float& l_reg, bf16x8& pa0, bf16x8& pa1, bf16x8& pa2, bf16x8& pa3) {
#pragma unroll
    for (int r = 0; r < 16; ++r) p1[r] = __builtin_amdgcn_exp2f(p1[r]);
    float ps_[4] = {0.f, 0.f, 0.f, 0.f};
#pragma unroll
    for (int r = 0; r < 16; ++r) ps_[r & 3] += p0[r];
#pragma unroll
    for (int r = 0; r < 16; ++r) ps_[r & 3] += p1[r];
    float ps = (ps_[0] + ps_[1]) + (ps_[2] + ps_[3]);
    { auto rr = __builtin_amdgcn_permlane32_swap(__float_as_uint(ps), __float_as_uint(ps), false, false);
      ps = __uint_as_float(rr[0]) + __uint_as_float(rr[1]); }
    l_reg = l_reg * alpha + ps;
#define MLA_PK4(P, B_, OUT) do { unsigned a0 = cvtpk(P[B_+0], P[B_+1]), a1 = cvtpk(P[B_+2], P[B_+3]);                          \
        unsigned b0 = cvtpk(P[B_+4], P[B_+5]), b1 = cvtpk(P[B_+6], P[B_+7]);                                             \
        auto r0 = __builtin_amdgcn_permlane32_swap(a0, b0, false, false); auto r1 = __builtin_amdgcn_permlane32_swap(a1, b1, false, false); \
        u32x4 w = {r0[0], r1[0], r0[1], r1[1]}; OUT = *reinterpret_cast<bf16x8*>(&w); } while (0)
    MLA_PK4(p0, 0, pa0); MLA_PK4(p0, 8, pa1); MLA_PK4(p1, 0, pa2); MLA_PK4(p1, 8, pa3);
#undef MLA_PK4
}
template <int KB>
__device__ __forceinline__ void qkt(f32x16& p0, f32x16& p1, const MLAS char* K_lds, int r32, int hi, const bf16x8* qr) {
    p0 = f32x16{}; p1 = f32x16{};
    const MLAS char* kb[4];
#pragma unroll
    for (int dd = 0; dd < 4; ++dd) kb[dd] = K_lds + KB * SHM_K + MLA_KSWZ(r32, (dd * 16 + hi * 8) * 2);
#pragma unroll
    for (int d0 = 0; d0 < NSTEP; ++d0) { const MLAS char* a = kb[d0 & 3] + (d0 >> 2) * 128;
        bf16x8 b0 = *(const MLAS bf16x8*)(a);
        bf16x8 b1 = *(const MLAS bf16x8*)(a + 32 * 256);
        p0 = __builtin_amdgcn_mfma_f32_32x32x16_bf16(b0, qr[d0], p0, 0, 0, 0);
        p1 = __builtin_amdgcn_mfma_f32_32x32x16_bf16(b1, qr[d0], p1, 0, 0, 0);
        if (d0 == 2) __builtin_amdgcn_sched_barrier(0); }
}
template <int VB>
__device__ __forceinline__ void pv_tile(f32x16* o, int vb0, bf16x8 pa0, bf16x8 pa1, bf16x8 pa2, bf16x8 pa3) {
#define MLA_TRRD(dst, off) asm volatile("ds_read_b64_tr_b16 %0, %1 offset:%2" : "=&v"(dst) : "v"(vb0), "i"(off) : "memory")
#define MLA_PV_D0(d0) do { s16x4 l0, l1, l2, l3, h0, h1, h2, h3; constexpr int b_ = VB * SHM_V + (d0) * 512;     \
        MLA_TRRD(l0, b_); MLA_TRRD(h0, b_ + 1024); MLA_TRRD(l1, b_ + 2048); MLA_TRRD(h1, b_ + 3072); MLA_TRRD(l2, b_ + 4096); MLA_TRRD(h2, b_ + 5120); MLA_TRRD(l3, b_ + 6144); MLA_TRRD(h3, b_ + 7168); \
        asm volatile("s_waitcnt lgkmcnt(0)" ::: "memory"); MLA_SBAR();   \
        o[d0] = __builtin_amdgcn_mfma_f32_32x32x16_bf16(pa0, (bf16x8){l0[0], l0[1], l0[2], l0[3], h0[0], h0[1], h0[2], h0[3]}, o[d0], 0, 0, 0);   \
        o[d0] = __builtin_amdgcn_mfma_f32_32x32x16_bf16(pa1, (bf16x8){l1[0], l1[1], l1[2], l1[3], h1[0], h1[1], h1[2], h1[3]}, o[d0], 0, 0, 0);   \
        o[d0] = __builtin_amdgcn_mfma_f32_32x32x16_bf16(pa2, (bf16x8){l2[0], l2[1], l2[2], l2[3], h2[0], h2[1], h2[2], h2[3]}, o[d0], 0, 0, 0);   \
        o[d0] = __builtin_amdgcn_mfma_f32_32x32x16_bf16(pa3, (bf16x8){l3[0], l3[1], l3[2], l3[3], h3[0], h3[1], h3[2], h3[3]}, o[d0], 0, 0, 0); } while (0)
    MLA_PV_D0(0); MLA_PV_D0(1);
#undef MLA_PV_D0
#undef MLA_TRRD
}
__device__ __forceinline__ void qkt_rt(f32x16& p0, f32x16& p1, const MLAS char* K_s, int r32, int hi, const bf16x8* qr) {
    p0 = f32x16{}; p1 = f32x16{};
    const MLAS char* kb[6];
#pragma unroll
    for (int d0 = 0; d0 < 6; ++d0) kb[d0] = K_s + r32 * 256 + (((2 * d0 + hi) ^ (r32 & 15)) << 4);
    bf16x8 f0[3], f1[3], g0[3], g1[3];
#pragma unroll
    for (int d0 = 0; d0 < 3; ++d0) { const MLAS char* a = kb[d0]; f0[d0] = *(const MLAS bf16x8*)(a); f1[d0] = *(const MLAS bf16x8*)(a + 32 * 256); }
    __builtin_amdgcn_sched_barrier(0);
#pragma unroll
    for (int d0 = 3; d0 < 6; ++d0) { const MLAS char* a = kb[d0]; g0[d0 - 3] = *(const MLAS bf16x8*)(a); g1[d0 - 3] = *(const MLAS bf16x8*)(a + 32 * 256); }
#pragma unroll
    for (int d0 = 0; d0 < 3; ++d0) { p0 = __builtin_amdgcn_mfma_f32_32x32x16_bf16(f0[d0], qr[d0], p0, 0, 0, 0); p1 = __builtin_amdgcn_mfma_f32_32x32x16_bf16(f1[d0], qr[d0], p1, 0, 0, 0); }
    __builtin_amdgcn_sched_barrier(0);
#pragma unroll
    for (int d0 = 3; d0 < 6; ++d0) { p0 = __builtin_amdgcn_mfma_f32_32x32x16_bf16(g0[d0 - 3], qr[d0], p0, 0, 0, 0); p1 = __builtin_amdgcn_mfma_f32_32x32x16_bf16(g1[d0 - 3], qr[d0], p1, 0, 0, 0); }
}
__device__ __forceinline__ void pv_rt(f32x16* o, int vb, bf16x8 pa0, bf16x8 pa1, bf16x8 pa2, bf16x8 pa3) {
#define MLA_TRRD(dst, off) asm volatile("ds_read_b64_tr_b16 %0, %1 offset:%2" : "=&v"(dst) : "v"(vb), "i"(off) : "memory")
    s16x4 l0, l1, l2, l3, h0, h1, h2, h3, m0, m1, m2, m3, n0, n1, n2, n3;
    MLA_TRRD(l0, 0); MLA_TRRD(h0, 1024); MLA_TRRD(l1, 2048); MLA_TRRD(h1, 3072); MLA_TRRD(l2, 4096); MLA_TRRD(h2, 5120); MLA_TRRD(l3, 6144); MLA_TRRD(h3, 7168);
    MLA_TRRD(m0, 512); MLA_TRRD(n0, 1536); MLA_TRRD(m1, 2560); MLA_TRRD(n1, 3584); MLA_TRRD(m2, 4608); MLA_TRRD(n2, 5632); MLA_TRRD(m3, 6656); MLA_TRRD(n3, 7680);
    asm volatile("s_waitcnt lgkmcnt(8)" ::: "memory"); MLA_SBAR();
    o[0] = __builtin_amdgcn_mfma_f32_32x32x16_bf16(pa0, (bf16x8){l0[0], l0[1], l0[2], l0[3], h0[0], h0[1], h0[2], h0[3]}, o[0], 0, 0, 0);
    o[0] = __builtin_amdgcn_mfma_f32_32x32x16_bf16(pa1, (bf16x8){l1[0], l1[1], l1[2], l1[3], h1[0], h1[1], h1[2], h1[3]}, o[0], 0, 0, 0);
    o[0] = __builtin_amdgcn_mfma_f32_32x32x16_bf16(pa2, (bf16x8){l2[0], l2[1], l2[2], l2[3], h2[0], h2[1], h2[2], h2[3]}, o[0], 0, 0, 0);
    o[0] = __builtin_amdgcn_mfma_f32_32x32x16_bf16(pa3, (bf16x8){l3[0], l3[1], l3[2], l3[3], h3[0], h3[1], h3[2], h3[3]}, o[0], 0, 0, 0);
    asm volatile("s_waitcnt lgkmcnt(0)" ::: "memory"); MLA_SBAR();
    o[1] = __builtin_amdgcn_mfma_f32_32x32x16_bf16(pa0, (bf16x8){m0[0], m0[1], m0[2], m0[3], n0[0], n0[1], n0[2], n0[3]}, o[1], 0, 0, 0);
    o[1] = __builtin_amdgcn_mfma_f32_32x32x16_bf16(pa1, (bf16x8){m1[0], m1[1], m1[2], m1[3], n1[0], n1[1], n1[2], n1[3]}, o[1], 0, 0, 0);
    o[1] = __builtin_amdgcn_mfma_f32_32x32x16_bf16(pa2, (bf16x8){m2[0], m2[1], m2[2], m2[3], n2[0], n2[1], n2[2], n2[3]}, o[1], 0, 0, 0);
    o[1] = __builtin_amdgcn_mfma_f32_32x32x16_bf16(pa3, (bf16x8){m3[0], m3[1], m3[2], m3[3], n3[0], n3[1], n3[2], n3[3]}, o[1], 0, 0, 0);
#undef MLA_TRRD
}
struct BlockRef { const MGAS bf16_t* Q; const MGAS bf16_t* K; const MGAS bf16_t* V; MGAS bf16_t* O; int P0; };
constexpr int KRING = 0, VRING = 3 * SHM_K, WSF_OFF = VRING + 4 * SHM_V, LDS_BYTES2 = WSF_OFF + NW * 64 * 4;
#define MLA_VMC(n) asm volatile("s_waitcnt vmcnt(" #n ")" ::: "memory")
#define MLA_BARX() asm volatile("s_waitcnt lgkmcnt(0)\n\ts_barrier" ::: "memory")
__device__ __forceinline__ void block2(const BlockRef& cur, MLAS char* lds, int wid, int lane) {
    const int r32 = lane & 31, hi = lane >> 5;
    const int NT = (cur.P0 + QB - 1) / KVBLK + 1;
    const int qlo = cur.P0 + wid * QBLK, qm = qlo + r32 - 4 * hi;
    MLAS char* K_lds = lds + KRING; MLAS char* V_lds = lds + VRING;
    MLAS float* wsf = (MLAS float*)(lds + WSF_OFF) + wid * 64; MLAS float* li_l = wsf; MLAS float* al_l = wsf + 32;
    unsigned kso[2];
#pragma unroll
    for (int i = 0; i < 2; ++i) { const int row = 4 * (2 * wid + i) + (lane >> 4), c = (lane & 15) ^ (row & 15), ce = c < 12 ? c : c - 4; kso[i] = (unsigned)(row * KS * 2 + ce * 16); }
    unsigned vso; { const int kk = wid * 8 + ((lane & 31) >> 2), k = (kk & ~0xC) | ((kk & 4) << 1) | ((kk & 8) >> 1), c = (lane >> 5) * 32 + (lane & 3) * 8; vso = (unsigned)(k * VS * 2 + c * 2); }
    const MGAS char* Kb = (const MGAS char*)cur.K; const MGAS char* Vb = (const MGAS char*)cur.V;
#define MLA_DMA(t, koff, voff) do { const MGAS char* kt_ = Kb + (size_t)(t) * (KVBLK * KS * 2); const MGAS char* vt_ = Vb + (size_t)(t) * (KVBLK * VS * 2);          \
        __builtin_amdgcn_global_load_lds((const MGAS unsigned*)(kt_ + kso[0]), (MLAS unsigned*)(K_lds + (koff) + (2 * wid) * 1024), 16, 0, 0);                          \
        __builtin_amdgcn_global_load_lds((const MGAS unsigned*)(kt_ + kso[1]), (MLAS unsigned*)(K_lds + (koff) + (2 * wid + 1) * 1024), 16, 0, 0);                      \
        __builtin_amdgcn_global_load_lds((const MGAS unsigned*)(vt_ + vso), (MLAS unsigned*)(V_lds + (voff) + wid * 1024), 16, 0, 0); } while (0)
    bf16x8 qr[NSTEP];
#pragma unroll
    for (int d0 = 0; d0 < NSTEP; ++d0) qr[d0] = *(const MGAS bf16x8*)(cur.Q + (size_t)(wid * QBLK + r32) * QS + d0 * 16 + hi * 8);
    float m_reg = -1e30f, l_reg = 0; f32x16 o[2] = {};
    const int vb0 = (int)(unsigned)(__UINTPTR_TYPE__)V_lds + v_rd_base(lane);
#define MLA_RESC(a) do { if (__any((a) < 1.f)) { if (hi == 0) al_l[r32] = (a); asm volatile("s_waitcnt lgkmcnt(0)" ::: "memory");              \
                     _Pragma("unroll") for (int d_ = 0; d_ < 2; ++d_) _Pragma("unroll") for (int r = 0; r < 16; ++r) o[d_][r] *= al_l[crow(r, hi)]; } } while (0)
#define MLA_MASKT(P0_, P1_, t) do { const int kb_ = (t) * KVBLK; if (__builtin_expect(__builtin_amdgcn_readfirstlane((int)(kb_ + KVBLK - 1 > qlo)) != 0, 0)) { asm volatile("" ::: "memory"); mask_tile(P0_, P1_, qm - kb_); } } while (0)
    f32x16 pA0, pA1, pB0, pB1; float mnA, mnB, alA, alB; bf16x8 pa0, pa1, pa2, pa3;
    int kc = 0, vc = 0;
#define MLA_KNEXT(x) ((x) == 2 * SHM_K ? 0 : (x) + SHM_K)
#define MLA_VNEXT(x) (((x) + SHM_V) & (4 * SHM_V - 1))
    MLA_DMA(0, 0, 0); MLA_DMA(1, SHM_K, SHM_V);
    MLA_VMC(3); MLA_BARX();
    MLA_SBAR(); qkt_rt(pA0, pA1, K_lds + kc, r32, hi, qr);
    MLA_MASKT(pA0, pA1, 0); partialSM(pA0, pA1, m_reg, mnA, alA);
    MLA_DMA(2, 2 * SHM_K, 2 * SHM_V);
    MLA_RESC(alA);
    MLA_VMC(3); MLA_BARX();
#define MLA_STEP(PX0, PX1, mnX, alX, PY0, PY1, alY, t) do {                                                                        \
        const int kp_ = kc, vp_ = vc; kc = MLA_KNEXT(kc); vc = MLA_VNEXT(vc);                \
        MLA_SBAR(); qkt_rt(PX0, PX1, K_lds + kc, r32, hi, qr);                                                                    \
        finishSM(PY0, PY1, alY, l_reg, pa0, pa1, pa2, pa3); MLA_SBAR();                                                            \
        pv_rt(o, vb0 + vp_, pa0, pa1, pa2, pa3); MLA_MASKT(PX0, PX1, (t)); partialSM(PX0, PX1, m_reg, mnX, alX);                    \
        if ((t) + 2 < NT) { MLA_DMA((t) + 2, kp_, MLA_VNEXT(MLA_VNEXT(vc))); }              \
        MLA_RESC(alX);                                                                                                             \
        if ((t) + 1 < NT) { if ((t) + 2 < NT) MLA_VMC(3); else MLA_VMC(0); MLA_BARX(); } } while (0)
    int t = 1;
    for (; t + 1 < NT; t += 2) {
        MLA_STEP(pB0, pB1, mnB, alB, pA0, pA1, alA, t);
        MLA_STEP(pA0, pA1, mnA, alA, pB0, pB1, alB, t + 1);
    }
    MLA_STEP(pB0, pB1, mnB, alB, pA0, pA1, alA, NT - 1);
    MLA_SBAR(); finishSM(pB0, pB1, alB, l_reg, pa0, pa1, pa2, pa3); MLA_SBAR(); pv_rt(o, vb0 + vc, pa0, pa1, pa2, pa3);
    if (hi == 0) li_l[r32] = l_reg; asm volatile("s_waitcnt lgkmcnt(0)" ::: "memory");
    MGAS bf16_t* Ow = cur.O + (size_t)(wid * QBLK) * OS;
#pragma unroll
    for (int r = 0; r < 16; ++r) { const int orow = crow(r, hi); const float rl = __builtin_amdgcn_rcpf(li_l[orow]);
#pragma unroll
        for (int d0 = 0; d0 < 2; ++d0) { const float v = o[d0][r] * rl; const float vn = __shfl_xor(v, 1);
            if ((r32 & 1) == 0) *(MGAS unsigned*)(Ow + (size_t)orow * OS + d0 * 32 + r32) = cvtpk(v, vn); } }
    MLA_BARX();
#undef MLA_RESC
#undef MLA_MASKT
#undef MLA_STEP
#undef MLA_DMA
}
constexpr int K5_SLOT = 16384, V5_SLOT = 8192, L5_K = 0, L5_V = 4 * K5_SLOT, L5_WS = L5_V + 4 * V5_SLOT, L5_OST = L5_WS + NW * 256, L5_BYTES = L5_OST + NW * 4096;
constexpr float THR5 = 8.f;
typedef const MLAS char* lcp;
typedef short v4i16_t __attribute__((ext_vector_type(4)));
__device__ __forceinline__ s16x4 vtr5(lcp p) { return __builtin_bit_cast(s16x4, __builtin_amdgcn_ds_read_tr16_b64_v4i16((MLAS v4i16_t*)p)); }
__device__ __forceinline__ unsigned cvtpk5(float lo, float hi) { unsigned r; asm("v_cvt_pk_bf16_f32 %0, %1, %2" : "=v"(r) : "v"(lo), "v"(hi)); return r; }
#define MX3(a, b, c) __builtin_fmaxf(__builtin_fmaxf((a), (b)), (c))
__device__ __forceinline__ float halfmax5(const f32x16& p0, const f32x16& p1) {
    float a = MX3(p0[0], p0[1], p1[0]), b = MX3(p0[2], p0[3], p1[1]); a = MX3(a, p1[2], p1[3]);
#pragma unroll
    for (int r = 4; r < 16; r += 4) { a = MX3(a, p0[r], p0[r + 1]); b = MX3(b, p0[r + 2], p0[r + 3]); a = MX3(a, p1[r], p1[r + 1]); b = MX3(b, p1[r + 2], p1[r + 3]); }
    return __builtin_fmaxf(a, b); }
__device__ __forceinline__ float mergehalves5(float m) { auto rr = __builtin_amdgcn_permlane32_swap(__float_as_uint(m), __float_as_uint(m), false, false);
    return __builtin_fmaxf(__uint_as_float(rr[0]), __uint_as_float(rr[1])); }
__device__ __forceinline__ float rowmax5(const f32x16& p0, const f32x16& p1) { return mergehalves5(halfmax5(p0, p1)); }
#undef MX3
__device__ __forceinline__ void cmask5(f32x16& p0, f32x16& p1, int jb, int qrel, int hi) {
    int dq = qrel - 64 * jb - 4 * hi; asm volatile("" : "+v"(dq)); const float NEG = -__builtin_inff();
#pragma unroll
    for (int r = 0; r < 16; ++r) { const int c = (r & 3) + 8 * (r >> 2); if (c > dq) p0[r] = NEG; if (c + 32 > dq) p1[r] = NEG; } }
__device__ __forceinline__ void block5(const BlockRef& cur, MLAS char* lds, int wid, int lane) {
    asm volatile("" : "+v"(lane));
    const int r32 = lane & 31, hi = lane >> 5;
    const int q0 = cur.P0, NT = (q0 + QB) / KVBLK;
    MLAS float* wsf = (MLAS float*)(lds + L5_WS) + wid * 64;
    unsigned kso[2];
#pragma unroll
    for (int i = 0; i < 2; ++i) { const int row = 4 * (2 * wid + i) + (lane >> 4), c = (lane & 15) ^ (row & 15), ce = c < 12 ? c : c - 4; kso[i] = (unsigned)(row * KS * 2 + ce * 16); }
    const unsigned vso = (unsigned)(((16 * (wid & 3) + (lane >> 2)) * VS + (wid >> 2) * 32 + (lane & 3) * 8) * 2);
    const MGAS char* Kb = (const MGAS char*)cur.K; const MGAS char* Vb = (const MGAS char*)cur.V;
    const unsigned ldsa = (unsigned)(__UINTPTR_TYPE__)lds;
#define GLDS16(base, off, la) do { unsigned sv_; asm volatile("s_mov_b32 %0, m0\n\ts_mov_b32 m0, %3\n\ts_nop 0\n\tglobal_load_lds_dwordx4 %1, %2\n\ts_mov_b32 m0, %0" : "=&s"(sv_) : "v"(off), "s"(base), "s"(la) : "memory"); } while (0)
#define DMA_K(t, slot) do { const MGAS char* kt_ = Kb + (size_t)(t) * (KVBLK * KS * 2); const unsigned la_ = (unsigned)__builtin_amdgcn_readfirstlane((int)(ldsa + L5_K + (slot) + (2 * wid) * 1024));  \
        GLDS16(kt_, kso[0], la_); GLDS16(kt_, kso[1], la_ + 1024u); } while (0)
#define DMA_V(t, slot) do { const MGAS char* vt_ = Vb + (size_t)(t) * (KVBLK * VS * 2); const unsigned la_ = (unsigned)__builtin_amdgcn_readfirstlane((int)(ldsa + L5_V + (slot) + wid * 1024));        \
        GLDS16(vt_, vso, la_); } while (0)
#define WAIT_BAR(N) asm volatile("s_waitcnt vmcnt(" #N ") lgkmcnt(0)\n\ts_barrier" ::: "memory")
#define SBAR() __builtin_amdgcn_sched_barrier(0)
#define PIN(x) asm volatile("" : "+v"(x))
#define MFMA(a, b, c) __builtin_amdgcn_mfma_f32_32x32x16_bf16(a, b, c, 0, 0, 0)
    int kofs[6];
#pragma unroll
    for (int d0 = 0; d0 < 6; ++d0) kofs[d0] = r32 * 256 + (((2 * d0 + hi) ^ (r32 & 15)) << 4);
    const lcp kb0 = (lcp)lds + L5_K;
    const lcp vp0 = (lcp)lds + L5_V + ((lane >> 4) & 1) * 32 + (lane & 3) * 8 + (4 * hi + ((lane & 15) >> 2)) * 64;
#define KLD(j, ks) kf[j] = *(const MLAS bf16x8*)(kb0 + (ks) + kofs[(j) >> 1] + ((j) & 1) * 8192)
    DMA_K(0, 0); DMA_V(0, 0); DMA_K(1, K5_SLOT);
    bf16x8 qr[6];
#pragma unroll
    for (int d0 = 0; d0 < 6; ++d0) qr[d0] = *(const MGAS bf16x8*)((const MGAS char*)cur.Q + (unsigned)(((wid * QBLK + r32) * QS + hi * 8) * 2) + d0 * 32);
    float mhat = 0.f, l_reg = 0.f; f32x16 o[2]; o[0] = f32x16{}; o[1] = f32x16{}; f32x16 negm;
    const int qrel = wid * QBLK + r32; bool resc = false;
    f32x16 pA0, pA1, pB0, pB1; bf16x8 kf[12]; s16x4 vlo[8], vhi[8]; u32x4 pw0, pw1, pw2, pw3;
    constexpr bool lag = false;
#define VSL(j) (((j) & 3) * V5_SLOT)
#define RESC() do { if (resc) { _Pragma("unroll") for (int d_ = 0; d_ < 2; ++d_) _Pragma("unroll") for (int r = 0; r < 16; ++r) o[d_][r] *= wsf[crow(r, hi)]; } } while (0)
    DMA_K(2, 2 * K5_SLOT);
    WAIT_BAR(5);
#pragma unroll
    for (int j = 0; j < 12; ++j) KLD(j, 0);
    pA0 = MFMA(kf[0], qr[0], f32x16{}); pA1 = MFMA(kf[1], qr[0], f32x16{});
#pragma unroll
    for (int d0 = 1; d0 < 6; ++d0) { pA0 = MFMA(kf[2 * d0], qr[d0], pA0); pA1 = MFMA(kf[2 * d0 + 1], qr[d0], pA1); }
    if (NT == 4) cmask5(pA0, pA1, 0, qrel, hi);
    { const float rm = rowmax5(pA0, pA1); mhat = rm;
#pragma unroll
      for (int r = 0; r < 16; ++r) { pA0[r] = __builtin_amdgcn_exp2f(pA0[r] - rm); pA1[r] = r < 4 ? __builtin_amdgcn_exp2f(pA1[r] - rm) : pA1[r] - rm; }
#pragma unroll
      for (int r = 0; r < 16; ++r) negm[r] = -mhat;
      PIN(negm); }
    WAIT_BAR(0);
    DMA_K(3, 3 * K5_SLOT); DMA_V(1, VSL(1));
    if (lag) { if (4 < NT) DMA_K(4, 0); DMA_V(2, VSL(2)); }
    KLD(0, K5_SLOT); KLD(1, K5_SLOT); KLD(2, K5_SLOT); KLD(3, K5_SLOT);
#define PKW(P, i) cvtpk5(P[i], P[i + 1])
#define PAF(k) __builtin_bit_cast(bf16x8, pw##k)
#define VFR(i) (bf16x8){vlo[i][0], vlo[i][1], vlo[i][2], vlo[i][3], vhi[i][0], vhi[i][1], vhi[i][2], vhi[i][3]}
#define VRD(i) do { vlo[i] = vtr5(vp_ + (((i) >> 2) * 4096 + ((i) & 3) * 1024)); vhi[i] = vtr5(vp_ + (((i) >> 2) * 4096 + ((i) & 3) * 1024 + 512)); } while (0)
#define EX(v) __builtin_amdgcn_exp2f(v)
#define GAPE(j, MF, P, i) do { KLD((j) + 4, ks_); SBAR(); MF; P[i] = EX(P[i]); P[(i) + 1] = EX(P[(i) + 1]); P[(i) + 2] = EX(P[(i) + 2]); PIN(P); SBAR(); } while (0)
#define GAPA(RD, MF, a0, a1, a2, a3, W0, W1, PW) do { RD; SBAR(); MF; sacc += a0; sacc += a1; sacc += a2; sacc += a3; W0; W1; PIN(PW); PIN(sacc); SBAR(); } while (0)
#define GAPB3(MF, X, i0, Y, i1, Z, i2) do { MF; X[i0] = EX(X[i0]); Y[i1] = EX(Y[i1]); Z[i2] = EX(Z[i2]); PIN(X); PIN(Z); SBAR(); } while (0)
#define GAPB4(MF, X, i) do { MF; X[i] = EX(X[i]); X[(i) + 1] = EX(X[(i) + 1]); X[(i) + 2] = EX(X[(i) + 2]); X[(i) + 3] = EX(X[(i) + 3]); PIN(X); SBAR(); } while (0)
#define KPRE(G, j) do { if (G) { KLD(j, kn_); } } while (0)
#define STEP(C0, C1, P0, P1, t, TS, MASK, GK, GV, GL, GK2, GV2) do { SBAR();                                                                                                                                                           \
    const int ks_ = ((TS) & 3) * K5_SLOT, kn_ = (((TS) + 1) & 3) * K5_SLOT; const lcp vp_ = vp0 + VSL((TS) + 3);                                                                  \
    GAPE(0, C0 = MFMA(kf[0], qr[0], negm), P1, 4);                                                                                                                        \
    GAPE(1, C1 = MFMA(kf[1], qr[0], negm), P1, 7);                                                                                                                        \
    GAPE(2, C0 = MFMA(kf[2], qr[1], C0),   P1, 10);                                                                                                                       \
    GAPE(3, C1 = MFMA(kf[3], qr[1], C1),   P1, 13);                                                                                                                       \
    float sacc = P0[0] + P0[1];                                                                                                                                           \
    GAPA(KLD(8, ks_),  C0 = MFMA(kf[4], qr[2], C0),  P0[2], P0[3], P0[4], P0[5],     pw0[0] = PKW(P0, 0),  pw0[1] = PKW(P0, 2),  pw0);                                     \
    GAPA(KLD(9, ks_),  C1 = MFMA(kf[5], qr[2], C1),  P0[6], P0[7], P0[8], P0[9],     pw0[2] = PKW(P0, 4),  pw0[3] = PKW(P0, 6),  pw0);                                     \
    GAPA(KLD(10, ks_), C0 = MFMA(kf[6], qr[3], C0),  P0[10], P0[11], P0[12], P0[13], pw1[0] = PKW(P0, 8),  pw1[1] = PKW(P0, 10), pw1);                                     \
    GAPA(KLD(11, ks_), C1 = MFMA(kf[7], qr[3], C1),  P0[14], P0[15], P1[0], P1[1],   pw1[2] = PKW(P0, 12), pw1[3] = PKW(P0, 14), pw1);                                     \
    GAPA((void)0,      C0 = MFMA(kf[8], qr[4], C0),  P1[2], P1[3], P1[4], P1[5],     pw2[0] = PKW(P1, 0),  pw2[1] = PKW(P1, 2),  pw2);                                     \
    GAPA((void)0,      C1 = MFMA(kf[9], qr[4], C1),  P1[6], P1[7], P1[8], P1[9],     pw2[2] = PKW(P1, 4),  pw2[3] = PKW(P1, 6),  pw2);                                     \
    GAPA(VRD(0),       C0 = MFMA(kf[10], qr[5], C0), P1[10], P1[11], P1[12], P1[13], pw3[0] = PKW(P1, 8),  pw3[1] = PKW(P1, 10), pw3);                                     \
    GAPA(VRD(4),       C1 = MFMA(kf[11], qr[5], C1), P1[14], P1[15], 0.f, 0.f,       pw3[2] = PKW(P1, 12), pw3[3] = PKW(P1, 14), pw3);                                     \
    l_reg += sacc;                                                                                                                                                        \
    if (!lag) { if (GK) DMA_K((t) + 3, (((TS) + 3) & 3) * K5_SLOT); if (GV) DMA_V((t) + 1, VSL((TS) + 1)); }                                          \
    else { ENDW(t); if (GK2) DMA_K((t) + 4, ((TS) & 3) * K5_SLOT); if (GV2) DMA_V((t) + 2, VSL((TS) + 2)); }                                           \
    VRD(1); VRD(5); SBAR();                                                                                                                                               \
    o[0] = MFMA(PAF(0), VFR(0), o[0]); o[1] = MFMA(PAF(0), VFR(4), o[1]);                                                     \
    if (MASK) cmask5(C0, C1, (t) - (NT - 4), qrel, hi);                                                                                                                   \
    { const float hm = halfmax5(C0, C1); resc = false;                                                                      \
      if (__builtin_expect(__any(hm > THR5), 0)) { const float rm = mergehalves5(hm); const float dl = __builtin_fmaxf(rm, 0.f); mhat += dl;     \
          _Pragma("unroll") for (int r = 0; r < 16; ++r) { C0[r] -= dl; C1[r] -= dl; }                                                                                    \
          _Pragma("unroll") for (int r = 0; r < 16; ++r) negm[r] = -mhat;                                                                                                 \
          PIN(negm);                                                                                                                                                      \
          const float f = __builtin_amdgcn_exp2f(-dl); l_reg *= f; if (hi == 0) wsf[r32] = f; resc = true; } }                                                            \
    SBAR();                                                                                                                                                               \
    VRD(2); KPRE(GL, 0); GAPB4(o[0] = MFMA(PAF(1), VFR(1), o[0]), C0, 0);                                                                                                 \
    VRD(6); KPRE(GL, 1); GAPB4(o[1] = MFMA(PAF(1), VFR(5), o[1]), C0, 4);                                                                                                 \
    VRD(3); KPRE(GL, 2); GAPB3(o[0] = MFMA(PAF(2), VFR(2), o[0]), C0, 8, C0, 9, C0, 10);                                                                                  \
    VRD(7); KPRE(GL, 3); GAPB3(o[1] = MFMA(PAF(2), VFR(6), o[1]), C0, 11, C0, 12, C0, 13);                                                                                \
    GAPB3(o[0] = MFMA(PAF(3), VFR(3), o[0]), C0, 14, C0, 15, C1, 0);                                                                                                      \
    GAPB3(o[1] = MFMA(PAF(3), VFR(7), o[1]), C1, 1, C1, 2, C1, 3);                                                                                                        \
    } while (0)
#define ENDW(tt) do { if ((tt) + 3 < NT) { WAIT_BAR(3); } else if ((tt) + 2 < NT) { WAIT_BAR(1); } else { WAIT_BAR(0); } } while (0)
#define ENDL(tt) do { if (!lag) ENDW(tt); } while (0)
    int t = 1;
    for (; t + 7 < NT; t += 4) {
        STEP(pB0, pB1, pA0, pA1, t,     1, false, true, true, true, true, true); ENDL(t);     RESC();
        STEP(pA0, pA1, pB0, pB1, t + 1, 2, false, true, true, true, true, true); ENDL(t + 1); RESC();
        STEP(pB0, pB1, pA0, pA1, t + 2, 3, false, true, true, true, true, true); ENDL(t + 2); RESC();
        STEP(pA0, pA1, pB0, pB1, t + 3, 0, false, true, true, true, true, true); ENDL(t + 3); RESC();
    }
    for (; t + 1 < NT; t += 2) {
        STEP(pB0, pB1, pA0, pA1, t, t, true, (t + 3 < NT), (t + 1 < NT), (t + 1 < NT), (t + 4 < NT), (t + 2 < NT));                 ENDL(t);     RESC();
        STEP(pA0, pA1, pB0, pB1, t + 1, t + 1, true, (t + 4 < NT), (t + 2 < NT), (t + 2 < NT), (t + 5 < NT), (t + 3 < NT));         ENDL(t + 1); RESC();
    }
    STEP(pB0, pB1, pA0, pA1, NT - 1, NT - 1, true, false, false, false, false, false); ENDL(NT - 1); RESC();
    {
#pragma unroll
      for (int r = 4; r < 16; ++r) pB1[r] = __builtin_amdgcn_exp2f(pB1[r]);
      float sacc = pB0[0] + pB0[1];
#pragma unroll
      for (int r = 2; r < 16; ++r) sacc += pB0[r];
#pragma unroll
      for (int r = 0; r < 16; ++r) sacc += pB1[r];
      l_reg += sacc;
      pw0 = (u32x4){PKW(pB0, 0), PKW(pB0, 2), PKW(pB0, 4), PKW(pB0, 6)}; pw1 = (u32x4){PKW(pB0, 8), PKW(pB0, 10), PKW(pB0, 12), PKW(pB0, 14)};
      pw2 = (u32x4){PKW(pB1, 0), PKW(pB1, 2), PKW(pB1, 4), PKW(pB1, 6)}; pw3 = (u32x4){PKW(pB1, 8), PKW(pB1, 10), PKW(pB1, 12), PKW(pB1, 14)};
      const lcp vp_ = vp0 + VSL(NT - 1);
      VRD(0); VRD(1); VRD(2); VRD(3); VRD(4); VRD(5); VRD(6); VRD(7);
      o[0] = MFMA(PAF(0), VFR(0), o[0]); o[1] = MFMA(PAF(0), VFR(4), o[1]); o[0] = MFMA(PAF(1), VFR(1), o[0]); o[1] = MFMA(PAF(1), VFR(5), o[1]);
      o[0] = MFMA(PAF(2), VFR(2), o[0]); o[1] = MFMA(PAF(2), VFR(6), o[1]); o[0] = MFMA(PAF(3), VFR(3), o[0]); o[1] = MFMA(PAF(3), VFR(7), o[1]); }
    { auto rr = __builtin_amdgcn_permlane32_swap(__float_as_uint(l_reg), __float_as_uint(l_reg), false, false); l_reg = __uint_as_float(rr[0]) + __uint_as_float(rr[1]); }
    if (hi == 0) wsf[32 + r32] = l_reg;
    MGAS bf16_t* Ow = cur.O + (size_t)(wid * QBLK) * OS; MLAS bf16_t* stg = (MLAS bf16_t*)(lds + L5_OST) + wid * 2048;
#pragma unroll
    for (int r = 0; r < 16; ++r) { const int orow = crow(r, hi); const float rl = __builtin_amdgcn_rcpf(wsf[32 + orow]);
#pragma unroll
        for (int d0 = 0; d0 < 2; ++d0) stg[orow * 64 + d0 * 32 + r32] = (bf16_t)cvtpk5(o[d0][r] * rl, 0.f); }
#pragma unroll
    for (int i = 0; i < 4; ++i) { const int row = i * 8 + (lane >> 3), ch = lane & 7; *(MGAS u32x4*)((MGAS char*)Ow + (unsigned)((row * OS + ch * 8) * 2)) = *(const MLAS u32x4*)(stg + row * 64 + ch * 8); }
    asm volatile("s_waitcnt lgkmcnt(0)\n\ts_barrier" ::: "memory");
#undef DMA_K
#undef DMA_V
#undef GLDS16
#undef WAIT_BAR
#undef SBAR
#undef PIN
#undef MFMA
#undef KLD
#undef VSL
#undef ENDL
#undef RESC
#undef PKW
#undef PAF
#undef VFR
#undef VRD
#undef GAPA
#undef GAPE
#undef GAPB3
#undef GAPB4
#undef EX
#undef GAPB
#undef KPRE
#undef STEP
#undef ENDW
}
__device__ __forceinline__ void mla_phase(MLAS char* lds, const bf16_t* QF_, const bf16_t* KF_, const bf16_t* VV_, bf16_t* ATT_, int bx, int nwg, int wid, int lane) {
    const MGAS bf16_t* QF = (const MGAS bf16_t*)QF_; const MGAS bf16_t* KF = (const MGAS bf16_t*)KF_; const MGAS bf16_t* VV = (const MGAS bf16_t*)VV_; MGAS bf16_t* ATT = (MGAS bf16_t*)ATT_;
    for (int item = bx; item < 256; item += nwg) { const int h = item & 7, x = item >> 3;
#pragma unroll 1
        for (int pass = 0; pass < 2; ++pass) { const int qb = pass ? 63 - x : x;
            BlockRef b{QF + (size_t)(qb * QB) * QS + h * 96, KF + h * 96, VV + h * 64, ATT + (size_t)(qb * QB) * OS + h * 64, qb * QB};
            block5(b, lds, wid, lane); }
        asm volatile("s_waitcnt vmcnt(0)" ::: "memory"); __syncthreads(); }
}
}

namespace dil {
#define DLAS __attribute__((address_space(3)))
#define DGAS __attribute__((address_space(1)))
typedef short bf16x8 __attribute__((ext_vector_type(8)));
typedef short s16x4 __attribute__((ext_vector_type(4)));
typedef float f32x16 __attribute__((ext_vector_type(16)));
typedef unsigned u32x4 __attribute__((ext_vector_type(4)));
constexpr int ITEM_LDS = 65536, K_OFF = 0, V_OFF = 32768, BIAS_OFF = 131072, WSF_OFF = 131072 + 2048;
constexpr int LDS_BYTES = WSF_OFF + 8 * 128;
constexpr float LOG2E = 1.4426950408889634f, LN2 = 0.6931471805599453f;
__device__ __forceinline__ int v_st(int k, int c) { const int kk = (k & ~0xC) | ((k & 4) << 1) | ((k & 8) >> 1); return ((kk >> 3) * 2 + (c >> 5)) * 512 + ((kk & 7) * 32 + (c & 31)) * 2; }
__device__ __forceinline__ int v_rd_base(int lane) { return ((lane & 3) << 3) | (((lane >> 2) & 3) << 6) | (((lane >> 4) & 1) << 5) | (((lane >> 5) & 1) << 8); }
__device__ __forceinline__ int crow(int r, int hi) { return (r & 3) + 8 * (r >> 2) + 4 * hi; }
__device__ __forceinline__ unsigned cvtpk(float lo, float hi) { unsigned r; asm volatile("v_cvt_pk_bf16_f32 %0, %1, %2" : "=v"(r) : "v"(lo), "v"(hi)); return r; }
__device__ __forceinline__ int t5b(int dist) { if (dist < 16) return dist; const int large = 16 + (int)(logf((float)dist / 16.f) / 4.852030263919617f * 16.f); return large < 31 ? large : 31; }
struct Item { int hd, r, ph, nbk; };
__device__ __forceinline__ Item decode(int id) { Item it; it.hd = id >> 7; const int blk = id & 127, g = it.hd >> 3; it.r = g == 0 ? 1 : (g == 1 ? 4 : 16);
    const int nblk = 128 / it.r; it.ph = blk / nblk; it.nbk = blk - it.ph * nblk; return it; }

__device__ __forceinline__ void dil_phase(DLAS char* lds, bf16_t* QD_, const bf16_t* KD_, const bf16_t* VD_, const float* rel_bias, float* LSE_, int pr0, int prstep, int prend, int wid, int lane) {
    DGAS bf16_t* QD = (DGAS bf16_t*)QD_; const DGAS bf16_t* KD = (const DGAS bf16_t*)KD_; const DGAS bf16_t* VD = (const DGAS bf16_t*)VD_; DGAS float* LSE = (DGAS float*)LSE_;
    const int tid = wid * 64 + lane, r32 = lane & 31, hi = lane >> 5, w4 = wid & 3, wi = wid >> 2;
    for (int pr = pr0; pr < prend; pr += prstep) {
#pragma unroll 1
        for (int ii = 0; ii < 2; ++ii) { const Item it = decode(2 * pr + ii);
            DLAS char* Kl = lds + ii * ITEM_LDS + K_OFF; DLAS char* Vl = lds + ii * ITEM_LDS + V_OFF;
            bf16x8 kv[4], vv[4];
#pragma unroll
            for (int c = 0; c < 4; ++c) { const int idx = c * 512 + tid, row = idx >> 3, ch = idx & 7; const int srow = (it.nbk - 1) * 128 + row;
                const size_t off = ((size_t)(srow * it.r + it.ph)) * 1536 + it.hd * 64 + ch * 8;
                if (srow >= 0) { kv[c] = *(const DGAS bf16x8*)(KD + off); vv[c] = *(const DGAS bf16x8*)(VD + off); } else { kv[c] = bf16x8{}; vv[c] = bf16x8{}; } }
#pragma unroll
            for (int c = 0; c < 4; ++c) { const int idx = c * 512 + tid, row = idx >> 3, ch = idx & 7;
                *(DLAS bf16x8*)(Kl + row * 128 + ((ch ^ ((row >> 1) & 7)) * 16)) = kv[c];
                *(DLAS bf16x8*)(Vl + v_st(row, ch * 8)) = vv[c]; }
            if (tid < 256) { const int st = tid - 35;
                ((DLAS float*)(lds + BIAS_OFF + ii * 1024))[tid] = (st >= 0 && st <= 128) ? rel_bias[t5b(st * it.r) * 24 + it.hd] * LOG2E : -__builtin_inff(); }
        }
        __syncthreads();
        { const Item it = decode(2 * pr + wi);
            const DLAS char* Kl = lds + wi * ITEM_LDS + K_OFF; const DLAS float* bias = (const DLAS float*)(lds + BIAS_OFF + wi * 1024);
            DLAS float* wsf = (DLAS float*)(lds + WSF_OFF + wid * 128);
            const int qtok = ((it.nbk * 128 + 32 * w4 + r32) * it.r + it.ph);
            bf16x8 qr[4];
#pragma unroll
            for (int d0 = 0; d0 < 4; ++d0) qr[d0] = *(const DGAS bf16x8*)(QD + (size_t)qtok * 1536 + it.hd * 64 + d0 * 16 + hi * 8);
            f32x16 p[5];
            const DLAS char* kb[4];
#pragma unroll
            for (int d0 = 0; d0 < 4; ++d0) kb[d0] = Kl + (32 * w4 + r32) * 128 + (((2 * d0 + hi) ^ ((r32 >> 1) & 7)) * 16);
#pragma unroll
            for (int b = 0; b < 5; ++b) { p[b] = f32x16{};
#pragma unroll
                for (int d0 = 0; d0 < 4; ++d0) p[b] = __builtin_amdgcn_mfma_f32_32x32x16_bf16(*(const DLAS bf16x8*)(kb[d0] + b * 4096), qr[d0], p[b], 0, 0, 0); }
            { const DLAS char* tb = (const DLAS char*)bias + 4 * (4 + r32 - 4 * hi);
#pragma unroll
              for (int b = 0; b < 5; ++b)
#pragma unroll
                for (int r = 0; r < 16; ++r) { const int c = 32 * b + (r & 3) + 8 * (r >> 2); p[b][r] = fmaf(p[b][r], 0.125f * LOG2E, *(const DLAS float*)(tb + 4 * (159 - c))); } }
            if (it.nbk == 0) {
                int lim = 128 - 32 * w4 - 4 * hi; asm volatile("" : "+v"(lim));
#pragma unroll
                for (int b = 0; b < 4; ++b)
#pragma unroll
                    for (int r = 0; r < 16; ++r) { const int c = 32 * b + (r & 3) + 8 * (r >> 2); if (c < lim) p[b][r] = -__builtin_inff(); } }
            float mx;
            { float m0 = fmaxf(fmaxf(p[0][0], p[0][1]), p[0][2]), m1 = fmaxf(fmaxf(p[0][3], p[0][4]), p[0][5]);
#pragma unroll
              for (int r = 6; r < 16; r += 2) { if ((r >> 1) & 1) m0 = fmaxf(fmaxf(m0, p[0][r]), p[0][r + 1]); else m1 = fmaxf(fmaxf(m1, p[0][r]), p[0][r + 1]); }
#pragma unroll
              for (int b = 1; b < 5; ++b)
#pragma unroll
                for (int r = 0; r < 16; r += 4) { m0 = fmaxf(fmaxf(m0, p[b][r]), p[b][r + 1]); m1 = fmaxf(fmaxf(m1, p[b][r + 2]), p[b][r + 3]); }
              mx = fmaxf(m0, m1); }
            { auto rr = __builtin_amdgcn_permlane32_swap(__float_as_uint(mx), __float_as_uint(mx), false, false); mx = fmaxf(__uint_as_float(rr[0]), __uint_as_float(rr[1])); }
            float den = 0.f;
#pragma unroll
            for (int b = 0; b < 5; ++b)
#pragma unroll
                for (int r = 0; r < 16; ++r) { const float e = __builtin_amdgcn_exp2f(p[b][r] - mx); p[b][r] = e; den += e; }
            { auto rr = __builtin_amdgcn_permlane32_swap(__float_as_uint(den), __float_as_uint(den), false, false); den = __uint_as_float(rr[0]) + __uint_as_float(rr[1]); }
            if (hi == 0) { wsf[r32] = __builtin_amdgcn_rcpf(den); LSE[(size_t)qtok * 24 + it.hd] = mx * LN2 + __logf(den); }
            bf16x8 pa[5][2];
#define DIL_PK4(P, B_, OUT) do { unsigned a0 = cvtpk(P[B_+0], P[B_+1]), a1 = cvtpk(P[B_+2], P[B_+3]);                          \
        unsigned b0 = cvtpk(P[B_+4], P[B_+5]), b1 = cvtpk(P[B_+6], P[B_+7]);                                             \
        auto r0 = __builtin_amdgcn_permlane32_swap(a0, b0, false, false); auto r1 = __builtin_amdgcn_permlane32_swap(a1, b1, false, false); \
        u32x4 w_ = {r0[0], r1[0], r0[1], r1[1]}; OUT = *reinterpret_cast<bf16x8*>(&w_); } while (0)
#pragma unroll
            for (int b = 0; b < 5; ++b) { DIL_PK4(p[b], 0, pa[b][0]); DIL_PK4(p[b], 8, pa[b][1]); }
#undef DIL_PK4
            f32x16 o[2] = {};
            const int vb0 = (int)(unsigned)(__UINTPTR_TYPE__)(lds + wi * ITEM_LDS + V_OFF) + v_rd_base(lane) + 4 * w4 * 1024;
#define DIL_TRRD(dst, off) asm volatile("ds_read_b64_tr_b16 %0, %1 offset:%2" : "=&v"(dst) : "v"(vb0), "i"(off) : "memory")
#define DIL_PV(b, d0) do { s16x4 l0, h0, l1, h1; constexpr int o_ = (4 * (b)) * 1024 + (d0) * 512;                                         \
        DIL_TRRD(l0, o_); DIL_TRRD(h0, o_ + 1024); DIL_TRRD(l1, o_ + 2048); DIL_TRRD(h1, o_ + 3072);                                        \
        asm volatile("s_waitcnt lgkmcnt(0)" ::: "memory"); __builtin_amdgcn_sched_barrier(0);                                               \
        o[d0] = __builtin_amdgcn_mfma_f32_32x32x16_bf16(pa[b][0], (bf16x8){l0[0], l0[1], l0[2], l0[3], h0[0], h0[1], h0[2], h0[3]}, o[d0], 0, 0, 0);   \
        o[d0] = __builtin_amdgcn_mfma_f32_32x32x16_bf16(pa[b][1], (bf16x8){l1[0], l1[1], l1[2], l1[3], h1[0], h1[1], h1[2], h1[3]}, o[d0], 0, 0, 0); } while (0)
            DIL_PV(0, 0); DIL_PV(0, 1); DIL_PV(1, 0); DIL_PV(1, 1); DIL_PV(2, 0); DIL_PV(2, 1); DIL_PV(3, 0); DIL_PV(3, 1); DIL_PV(4, 0); DIL_PV(4, 1);
#undef DIL_PV
#undef DIL_TRRD
            asm volatile("s_waitcnt lgkmcnt(0)" ::: "memory");
            __syncthreads();
            { DLAS bf16_t* stg = (DLAS bf16_t*)(lds + wi * ITEM_LDS + K_OFF + w4 * 4096);
#pragma unroll
              for (int r = 0; r < 16; ++r) { const int orow = crow(r, hi); const float rd = wsf[orow];
#pragma unroll
                  for (int d0 = 0; d0 < 2; ++d0) stg[orow * 64 + d0 * 32 + r32] = (bf16_t)cvtpk(o[d0][r] * rd, 0.f); }
              asm volatile("s_waitcnt lgkmcnt(0)" ::: "memory");
#pragma unroll
              for (int i = 0; i < 4; ++i) { const int row = i * 8 + (lane >> 3), ch = lane & 7; const int otok = (it.nbk * 128 + 32 * w4 + row) * it.r + it.ph;
                  *(DGAS u32x4*)(QD + (size_t)otok * 1536 + it.hd * 64 + ch * 8) = *(const DLAS u32x4*)(stg + row * 64 + ch * 8); } }
        }
        __syncthreads();
    }
}
}

#define LAS __attribute__((address_space(3)))
constexpr size_t MiB = 1u << 20;
constexpr int NWAVES = 8, MK_LDS_BYTES = 147456;
constexpr size_t WS_CTL = 0, WS_R0 = 1 * MiB, WS_CS = 2 * MiB, WS_SN = 3 * MiB, WS_SSQ1 = 4 * MiB, WS_SSQ2 = 5 * MiB, WS_SSQL = 6 * MiB, WS_LSE = 8 * MiB;
constexpr size_t WS_WGU = 10 * MiB, WS_WD = 21 * MiB, WS_WIN = 27 * MiB, WS_WG = 38 * MiB, WS_WUQ = 42 * MiB, WS_WUKV = 43 * MiB, WS_WBA = 44 * MiB, WS_WBD = 45 * MiB, WS_WO = 46 * MiB;
constexpr size_t WS_XB = 48 * MiB, WS_ACT = 80 * MiB;
constexpr size_t WS_H = 80 * MiB, WS_QD = 80 * MiB, WS_KD = 128 * MiB, WS_VD = 176 * MiB, WS_LAT = 224 * MiB;
constexpr size_t WS_G = 80 * MiB, WS_QF = 144 * MiB, WS_KF = 168 * MiB, WS_VV = 192 * MiB, WS_DIL = 208 * MiB, WS_ATT = 224 * MiB, WS_MG = 176 * MiB;
constexpr size_t WS_CQN = 80 * MiB, WS_CKVN = 92 * MiB;

struct MkArgs { const float* in[22]; float* out; unsigned char* ws; int ph_lo, ph_hi; };

__device__ __forceinline__ unsigned mk_pk2(float lo, float hi) { return (unsigned)f2bf(lo) | ((unsigned)f2bf(hi) << 16); }
__device__ __forceinline__ void conv_item(const float* W, int ldw, int col0, int k0, int K, bf16_t* WT, int dstrow0, const float* gain, LAS float* scr, int lane) {
    pg8::f32x4 wv[8];
#pragma unroll
    for (int i = 0; i < 8; ++i) { const int kk = 8 * i + (lane >> 3); wv[i] = *(const pg8::f32x4*)(W + (size_t)(k0 + kk) * ldw + col0 + (lane & 7) * 4); }
    const float gl = gain ? gain[k0 + lane] : 1.f;
#pragma unroll
    for (int i = 0; i < 8; ++i) { const int kk = 8 * i + (lane >> 3); const float gk = __shfl(gl, kk); LAS float* d = scr + kk * 33 + (lane & 7) * 4;
        d[0] = wv[i][0] * gk; d[1] = wv[i][1] * gk; d[2] = wv[i][2] * gk; d[3] = wv[i][3] * gk; }
    asm volatile("s_waitcnt lgkmcnt(0)" ::: "memory");
    const int c = lane & 7;
#pragma unroll
    for (int j = 0; j < 4; ++j) { const int n = (lane >> 3) + 8 * j; const LAS float* s = scr + (8 * c) * 33 + n;
        pg8::u32x4 o; o.x = pg8::cvt_pk_bf16(s[0 * 33], s[1 * 33]); o.y = pg8::cvt_pk_bf16(s[2 * 33], s[3 * 33]); o.z = pg8::cvt_pk_bf16(s[4 * 33], s[5 * 33]); o.w = pg8::cvt_pk_bf16(s[6 * 33], s[7 * 33]);
        *(pg8::u32x4*)(WT + (size_t)(dstrow0 + n) * K + k0 + 8 * c) = o; }
    asm volatile("s_waitcnt lgkmcnt(0)" ::: "memory");
}
struct ConvSeg { const float* src; const float* src2; const float* gain; bf16_t* dst; int ldw, col0, K, row0, nblk, kind; };
typedef const __attribute__((address_space(4))) MkArgs* KArgP;
__device__ __forceinline__ KArgP kargs() { KArgP p = (KArgP)__builtin_amdgcn_kernarg_segment_ptr(); asm volatile("" : "+s"(p)); return p; }
__device__ __forceinline__ ConvSeg conv_seg(KArgP ap, int si) {
    unsigned char* ws = ap->ws;
    bf16_t* W_GU = (bf16_t*)(ws + WS_WGU); bf16_t* W_D = (bf16_t*)(ws + WS_WD); bf16_t* W_IN = (bf16_t*)(ws + WS_WIN); bf16_t* W_G = (bf16_t*)(ws + WS_WG);
    bf16_t* W_UQ = (bf16_t*)(ws + WS_WUQ); bf16_t* W_UKV = (bf16_t*)(ws + WS_WUKV); bf16_t* W_BA = (bf16_t*)(ws + WS_WBA); bf16_t* W_BD = (bf16_t*)(ws + WS_WBD); bf16_t* W_O = (bf16_t*)(ws + WS_WO);
    switch (si) {
    case 0: return ConvSeg{ap->in[5], ap->in[6], ap->in[4], W_GU, DFF, 0, 1024, 0, 176, 1};
    case 1: return ConvSeg{ap->in[7], nullptr, nullptr, W_D, 1024, 0, DFF, 0, 32, 0};
    case 2: return ConvSeg{ap->in[9], nullptr, ap->in[8], W_IN, DIN, 0, 1024, 4608, 21, 0};
    case 3: return ConvSeg{nullptr, nullptr, nullptr, W_IN, 0, 0, 1024, 5280, 3, 2};
    case 4: return ConvSeg{ap->in[9], nullptr, ap->in[8], W_IN, DIN, 672, 1024, 0, 144, 0};
    case 5: return ConvSeg{ap->in[9], nullptr, ap->in[8], W_G, DIN, 5280, 1024, 0, 64, 0};
    case 6: return ConvSeg{ap->in[12], nullptr, ap->in[11], W_UQ, 768, 0, QLORA, 0, 24, 0};
    case 7: return ConvSeg{ap->in[14], nullptr, ap->in[13], W_UKV, 1024, 0, KVLORA, 0, 32, 0};
    case 8: return ConvSeg{ap->in[15], nullptr, nullptr, W_BA, 1024, 0, 512, 0, 32, 0};
    case 9: return ConvSeg{ap->in[16], nullptr, nullptr, W_BD, 1024, 0, 512, 0, 32, 0};
    case 10: return ConvSeg{ap->in[17], nullptr, nullptr, W_O, 1024, 0, 1024, 0, 32, 0};
    case 11: return ConvSeg{ap->in[19], ap->in[20], ap->in[18], W_GU, DFF, 0, 1024, 0, 176, 1};
    default: return ConvSeg{ap->in[21], nullptr, nullptr, W_D, 1024, 0, DFF, 0, 32, 0};
    }
}
__device__ __forceinline__ void conv_run(KArgP a, int s0, int s1, LAS float* scr, int gw, int ngw, int lane) {
    int base = 0;
    for (int si = s0; si < s1; ++si) { const ConvSeg sg = conv_seg(a, si); const int kt = sg.K / 64, nit = sg.nblk * kt;
        int it = gw - (base % ngw); if (it < 0) it += ngw;
        for (; it < nit; it += ngw) { const int b = it / kt, k0 = (it - b * kt) * 64;
            if (sg.kind == 2) { const int c = lane & 7;
#pragma unroll
                for (int j = 0; j < 4; ++j) { const int n = (lane >> 3) + 8 * j; *(pg8::u32x4*)(sg.dst + (size_t)(sg.row0 + 32 * b + n) * sg.K + k0 + 8 * c) = (pg8::u32x4){0u, 0u, 0u, 0u}; } }
            else if (sg.kind == 1) { const int tile = b >> 3, sub = b & 7; conv_item(sub < 4 ? sg.src : sg.src2, sg.ldw, tile * 128 + (sub & 3) * 32, k0, sg.K, sg.dst, sg.row0 + 32 * b, sg.gain, scr, lane); }
            else conv_item(sg.src, sg.ldw, sg.col0 + 32 * b, k0, sg.K, sg.dst, sg.row0 + 32 * b, sg.gain, scr, lane); }
        base += nit; }
}
__device__ __forceinline__ void xb_row(const float* xrow, bf16_t* orow, float* r0, int lane) {
    pg8::f32x4 v[4]; float s = 0.f;
#pragma unroll
    for (int j = 0; j < 4; ++j) { v[j] = *((const pg8::f32x4*)xrow + lane + 64 * j); s += pg8::dot4(v[j]); }
    s = wave_sum(s);
#pragma unroll
    for (int j = 0; j < 4; ++j) { pg8::u32x2 w; w.x = mk_pk2(v[j][0], v[j][1]); w.y = mk_pk2(v[j][2], v[j][3]); *((pg8::u32x2*)orow + lane + 64 * j) = w; }
    if (lane == 0) *r0 = rsqrtf(s * (1.f / 1024.f) + EPS);
}

struct MkConst { InvFreq ifr; };

#define XB_TMO      128
#define XB_XCNT(j)  (256  + 64 * (j))
#define XB_XSUB(j)  (1280 + 64 * (j))
#define XB_XGEN(j)  (2304 + 64 * (j))
#define XB_TOP      3328
#define XB_TOPGEN   3392
#define XCD_BAR_WORDS 3456
#define XB_SPIN_CAP (1u << 18)

__device__ __forceinline__ unsigned xb_ld(unsigned* p)              { return __hip_atomic_load(p, __ATOMIC_RELAXED, __HIP_MEMORY_SCOPE_AGENT); }
__device__ __forceinline__ unsigned xb_add(unsigned* p, unsigned v) { return __hip_atomic_fetch_add(p, v, __ATOMIC_RELAXED, __HIP_MEMORY_SCOPE_AGENT); }
__device__ __forceinline__ unsigned xb_xcc_id() { return (unsigned)__builtin_amdgcn_s_getreg((3 << 11) | 20) & 0xFu; }
#define XB_SPIN(cond, bar) do { unsigned _sp = 0; while (cond) { __builtin_amdgcn_s_sleep(1); \
    if ((++_sp & 255u) == 0u) { if (xb_ld(&(bar)[XB_TMO])) break; if (_sp > XB_SPIN_CAP) { atomicAdd(&(bar)[XB_TMO], 1u); break; } } } } while (0)

struct XcdBarrier {
    unsigned* bar; unsigned x;
    volatile LAS unsigned* st;
};

__device__ __forceinline__ XcdBarrier xcd_barrier_post(unsigned* bar, volatile LAS unsigned* st, bool leader) {
    XcdBarrier b; b.bar = bar; b.x = xb_xcc_id(); b.st = st;
    if (leader) (void)xb_add(&bar[XB_XCNT(b.x)], 1u);
    return b;
}
__device__ __forceinline__ void xcd_barrier_complete(unsigned* bar, unsigned x, unsigned& nloc, unsigned& nx) {
    const unsigned G = gridDim.x * gridDim.y * gridDim.z;
    unsigned sum, cnt, mine, sp = 0u;
    for (;;) {
        sum = 0u; cnt = 0u; mine = 0u;
#pragma unroll
        for (unsigned j = 0; j < 16; ++j) { const unsigned c = xb_ld(&bar[XB_XCNT(j)]); sum += c; cnt += (c > 0u) ? 1u : 0u; mine = (j == x) ? c : mine; }
        if (sum == G) break;
        __builtin_amdgcn_s_sleep(1);
        if ((++sp & 255u) == 0u) { if (xb_ld(&bar[XB_TMO])) break; if (sp > XB_SPIN_CAP) { atomicAdd(&bar[XB_TMO], 1u); break; } }
    }
    nloc = mine > 0u ? mine : 1u; nx = cnt > 0u ? cnt : 1u;
}

__device__ __forceinline__ void xcd_barrier(const XcdBarrier& b, bool leader) {
    asm volatile("s_waitcnt vmcnt(0)" ::: "memory");
    __syncthreads();
    if (leader) {
        unsigned* bar = b.bar;
        __builtin_amdgcn_s_waitcnt(0);
        unsigned nloc = b.st[0], nx = b.st[1];
        if (nloc == 0u) { xcd_barrier_complete(bar, b.x, nloc, nx); b.st[0] = nloc; b.st[1] = nx; }
        const unsigned old = xb_add(&bar[XB_XSUB(b.x)], 1u);
        const unsigned gen = old / nloc;
        if (old + 1u == (gen + 1u) * nloc) {
            __builtin_amdgcn_fence(__ATOMIC_RELEASE, "agent");
            asm volatile("s_waitcnt vmcnt(0)" ::: "memory");
            const unsigned og = xb_add(&bar[XB_TOP], 1u);
            const unsigned tg = og / nx;
            if (og + 1u == (tg + 1u) * nx) xb_add(&bar[XB_TOPGEN], 1u);
            else XB_SPIN(xb_ld(&bar[XB_TOPGEN]) == tg, bar);
            __builtin_amdgcn_fence(__ATOMIC_ACQUIRE, "agent");
            xb_add(&bar[XB_XGEN(b.x)], 1u);
            asm volatile("s_waitcnt vmcnt(0)" ::: "memory");
        } else {
            XB_SPIN(xb_ld(&bar[XB_XGEN(b.x)]) == gen, bar);
            __builtin_amdgcn_fence(__ATOMIC_ACQUIRE, "agent");
            asm volatile("s_waitcnt vmcnt(0)" ::: "memory");
        }
    }
    __syncthreads();
}

#define XB_LSUB(j)  (3456 + 64 * (j))
#define XB_LGEN(j)  (3968 + 64 * (j))
#define XB_MISM     4480
__device__ __forceinline__ void xcd_local_barrier(const XcdBarrier& b, int g, unsigned ngrp, bool leader) {
    asm volatile("s_waitcnt vmcnt(0)" ::: "memory");
    __syncthreads();
    if (leader) {
        unsigned* bar = b.bar;
        __builtin_amdgcn_s_waitcnt(0);
        const unsigned old = xb_add(&bar[XB_LSUB(g)], 1u);
        const unsigned gen = old / ngrp;
        if (old + 1u == (gen + 1u) * ngrp) xb_add(&bar[XB_LGEN(g)], 1u);
        else XB_SPIN(xb_ld(&bar[XB_LGEN(g)]) == gen, bar);
        __builtin_amdgcn_fence(__ATOMIC_ACQUIRE, "agent");
        asm volatile("s_waitcnt vmcnt(0)" ::: "memory");
    }
    __syncthreads();
}

__device__ __forceinline__ unsigned char* opq(unsigned char* p) { asm volatile("" : "+s"(p)); return p; }
#define WP(T, off) ((T*)(w + (off)))
constexpr int RS_TAB_OFF = 131072;
#define RT_PTR ((const LAS float*)(L + RS_TAB_OFF))
template <int N4>
__device__ __forceinline__ void rs_fill_t(LAS unsigned char* L, const float* slots_, int stride, int first, float inv_n, float mul, int group, int wave, int ln) {
    LAS float* tab = (LAS float*)(L + RS_TAB_OFF); const __attribute__((address_space(1))) float* slots = (const __attribute__((address_space(1))) float*)slots_;
    pg8::f32x4 v[4][N4];
#pragma unroll
    for (int j = 0; j < 4; ++j) { const __attribute__((address_space(1))) float* p = slots + (size_t)(group * 2048 + j * 512 + wave * 64 + ln) * stride + first;
#pragma unroll
        for (int k = 0; k < N4; ++k) v[j][k] = *(const __attribute__((address_space(1))) pg8::f32x4*)(p + 4 * k); }
#pragma unroll
    for (int j = 0; j < 4; ++j) { float sacc = 0.f;
#pragma unroll
        for (int k = 0; k < N4; ++k) sacc += (v[j][k][0] + v[j][k][1]) + (v[j][k][2] + v[j][k][3]);
        tab[j * 512 + wave * 64 + ln] = rsqrtf(sacc * inv_n + 1e-6f) * mul; }
    __syncthreads();
}
__device__ __forceinline__ void rs_fill(LAS unsigned char* L, const float* slots, int stride, int first, int n4, float inv_n, float mul, int group, int wave, int ln) {
    if (n4 == 4) rs_fill_t<4>(L, slots, stride, first, inv_n, mul, group, wave, ln); else if (n4 == 3) rs_fill_t<3>(L, slots, stride, first, inv_n, mul, group, wave, ln); else rs_fill_t<2>(L, slots, stride, first, inv_n, mul, group, wave, ln);
}
__global__ void __launch_bounds__(NWAVES * 64, 2) mk_fwd(MkArgs args_in_kernarg, InvFreq ifr) {
#define args (*kargs())
    extern __shared__ __attribute__((aligned(16))) unsigned char lds[];
    LAS unsigned char* L = (LAS unsigned char*)lds;
    const int wave = __builtin_amdgcn_readfirstlane((int)threadIdx.x >> 6);
#define lane ((int)__builtin_amdgcn_mbcnt_hi(~0u, __builtin_amdgcn_mbcnt_lo(~0u, 0u)))
#define tid (wave * 64 + lane)
    const int G = gridDim.x, bx = blockIdx.x, vcu = (G % 8 == 0) ? (bx % 8) * (G / 8) + bx / 8 : bx;
    const int gw = vcu * NWAVES + wave, ngw = G * NWAVES;
    const int lo = args.ph_lo, hi = args.ph_hi;
#define IN(k) (lo <= (k) && (k) < hi)
    volatile LAS unsigned* bst = (volatile LAS unsigned*)(L + MK_LDS_BYTES - 64);
    const bool leader = (wave == 0) && (lane == 0);
    XcdBarrier bar; bar.bar = (unsigned*)(args.ws + WS_CTL) + 4096; bar.x = 0; bar.st = bst;
    if (hi - lo > 1) { if (leader) { bst[0] = 0u; bst[1] = 0u; } __syncthreads(); bar = xcd_barrier_post((unsigned*)(args.ws + WS_CTL) + 4096, bst, leader); }
#define SEAM(k) do { if (IN(k) && IN((k) + 1)) xcd_barrier(bar, leader); } while (0)
#define SEAML(k) do { if (IN(k) && IN((k) + 1)) { if (bst[2] != 0u) xcd_local_barrier(bar, bx & 7, (unsigned)(G >> 3), leader); else xcd_barrier(bar, leader); } } while (0)
    if (leader) { bst[2] = 0u; if (hi - lo > 1 && lo == 0 && bar.x != (unsigned)(bx & 7)) (void)xb_add(&bar.bar[XB_MISM], 1u); }

    if (IN(0)) { unsigned char* w = opq(args.ws); LAS float* scr = (LAS float*)(L + wave * 16384);
        conv_run(kargs(), 0, (G == 256) ? 1 : 11, scr, gw, ngw, lane);
        const float* x = args.in[0]; const int* pos = (const int*)args.in[1];
#pragma unroll 4
        for (int m = gw; m < S; m += ngw) xb_row(x + (size_t)m * DM, WP(bf16_t, WS_XB) + (size_t)m * DM, WP(float, WS_R0) + m, lane);
        float* CS = WP(float, WS_CS); float* SN = WP(float, WS_SN);
        for (int idx = (vcu * NWAVES * 64) + tid; idx < S * 16; idx += G * NWAVES * 64) { const float ang = (float)pos[idx >> 4] * ifr.f[idx & 15]; float c, s; sincos_acc(ang, c, s); CS[idx] = c; SN[idx] = s; }
        __syncthreads();
    }
    SEAM(0);
    if (IN(0) && IN(1)) { if (leader) bst[2] = (G == 256 && xb_ld(&bar.bar[XB_MISM]) == 0u) ? 1u : 0u; __syncthreads(); }
    if (IN(1)) { unsigned char* w = opq(args.ws); pg8::Gemm g{WP(bf16_t, WS_XB), WP(bf16_t, WS_WGU), S, 2 * DFF, DM, DM}; pg8::StaticOrder so; so.init(S, 2 * DFF, G, bx);
        pg8::EpiSwiglu E{WP(bf16_t, WS_H), WP(float, WS_R0), 0, RT_PTR}; pg8::gemm_phase<pg8::EpiSwiglu, pg8::StaticOrder, true, true>(L, g, so, E, wave);
        if (G == 256 && bx >= 128) { LAS float* scr = (LAS float*)(L + wave * 16384); conv_run(kargs(), 1, 11, scr, (bx - 128) * NWAVES + wave, 128 * NWAVES, lane); __syncthreads(); } }
    SEAM(1);
    if (IN(2)) { unsigned char* w = opq(args.ws); pg8::Gemm g{WP(bf16_t, WS_H), WP(bf16_t, WS_WD), S, DM, DFF, DFF}; pg8::StaticOrder so; so.init(S, DM, G, bx);
        pg8::EpiResid<true> E{nullptr, WP(bf16_t, WS_XB), WP(float, WS_SSQ1), 0.5f, 0.f}; pg8::gemm_phase<pg8::EpiResid<true>, pg8::StaticOrder, true, true>(L, g, so, E, wave); }
    SEAM(2);
    if (IN(3)) { unsigned char* w = opq(args.ws); pg8::Gemm g{WP(bf16_t, WS_XB), WP(bf16_t, WS_WIN), S, 5120, DM, DM}; pg8::StaticOrder so; so.init(S, 5120, G, bx);
        rs_fill(L, WP(const float, WS_SSQ1), 16, 0, 4, 1.f / 1024.f, 1.f, bx & 7, wave, lane); pg8::EpiProj E{WP(bf16_t, WS_LAT), WP(bf16_t, WS_QD), RT_PTR, WP(float, WS_SSQL), 0, 0}; pg8::gemm_phase<pg8::EpiProj, pg8::StaticOrder, true, true>(L, g, so, E, wave); }
    SEAM(3);
    if (IN(4)) {
        { unsigned char* w = opq(args.ws); pg8::Gemm g{WP(bf16_t, WS_XB), WP(bf16_t, WS_WIN) + (size_t)5120 * DM, S, 256, DM, DM}; pg8::StaticOrder so; so.init(S, 256, G, bx);
          rs_fill(L, WP(const float, WS_SSQ1), 16, 0, 4, 1.f / 1024.f, 1.f, bx & 7, wave, lane); pg8::EpiProj E{WP(bf16_t, WS_LAT), WP(bf16_t, WS_QD), RT_PTR, WP(float, WS_SSQL), 20, 0}; pg8::gemm_phase<pg8::EpiProj, pg8::StaticOrder, true, true>(L, g, so, E, wave); }
        unsigned char* w = opq(args.ws); const bool split = (G == 256); const int p0 = !split ? bx : (bx < 64 ? 1344 + bx : bx - 64), pst = !split ? G : (bx < 64 ? 64 : 192), pend = !split ? 1536 : (bx < 64 ? 1536 : 1344);
        dil::dil_phase((__attribute__((address_space(3))) char*)L, WP(bf16_t, WS_QD), WP(const bf16_t, WS_KD), WP(const bf16_t, WS_VD), args.in[2], WP(float, WS_LSE), p0, pst, pend, wave, lane); }
    SEAM(4);
    if (IN(5)) { unsigned char* w = opq(args.ws); LAS float* scr = (LAS float*)(L + wave * 16384);
        conv_run(kargs(), 11, 13, scr, gw, ngw, lane);
        const bf16_t* DO = WP(const bf16_t, WS_QD); const float* LSE = WP(const float, WS_LSE); const bf16_t* LAT = WP(const bf16_t, WS_LAT);
        const float* CS = WP(const float, WS_CS); const float* SN = WP(const float, WS_SN);
        bf16_t* KF = WP(bf16_t, WS_KF); bf16_t* DIL = WP(bf16_t, WS_DIL);
#pragma unroll 4
        for (int row = gw; row < S; row += ngw) {
            { const int j = lane >> 3, d0 = (lane & 7) * 8; const float* lp = LSE + (size_t)row * 24 + j;
              const float l0 = lp[0], l1 = lp[8], l2 = lp[16]; const float mx = fmaxf(l0, fmaxf(l1, l2));
              const float e0 = __expf(l0 - mx), e1 = __expf(l1 - mx), e2 = __expf(l2 - mx), inv = 1.f / (e0 + e1 + e2);
              const bf16_t* dp = DO + (size_t)row * 1536 + j * 64 + d0;
              const pg8::u32x4 a = *(const pg8::u32x4*)dp, b = *(const pg8::u32x4*)(dp + 512), c = *(const pg8::u32x4*)(dp + 1024);
              const float w0 = e0 * inv, w1 = e1 * inv, w2 = e2 * inv;
              const pg8::f32x4 o0 = pg8::bf4_lo((pg8::u32x2){a.x, a.y}) * w0 + pg8::bf4_lo((pg8::u32x2){b.x, b.y}) * w1 + pg8::bf4_lo((pg8::u32x2){c.x, c.y}) * w2;
              const pg8::f32x4 o1 = pg8::bf4_lo((pg8::u32x2){a.z, a.w}) * w0 + pg8::bf4_lo((pg8::u32x2){b.z, b.w}) * w1 + pg8::bf4_lo((pg8::u32x2){c.z, c.w}) * w2;
              *(pg8::u32x4*)(DIL + (size_t)row * 512 + j * 64 + d0) = pg8::pack8bf(o0, o1); }
            { const int h = lane >> 3, ii = (lane & 7) * 2; const bf16_t* lp = LAT + (size_t)row * 768 + 640;
              const unsigned xa = *(const unsigned*)(lp + ii), xb2 = *(const unsigned*)(lp + 16 + ii);
              const float x10 = __uint_as_float(xa << 16), x11 = __uint_as_float(xa & 0xffff0000u), x20 = __uint_as_float(xb2 << 16), x21 = __uint_as_float(xb2 & 0xffff0000u);
              const float c0 = CS[(size_t)row * 16 + ii], c1 = CS[(size_t)row * 16 + ii + 1], s0 = SN[(size_t)row * 16 + ii], s1 = SN[(size_t)row * 16 + ii + 1];
              *(unsigned*)(KF + (size_t)row * 768 + h * 96 + 64 + ii) = mk_pk2(x10 * c0 - x20 * s0, x11 * c1 - x21 * s1);
              *(unsigned*)(KF + (size_t)row * 768 + h * 96 + 80 + ii) = mk_pk2(x10 * s0 + x20 * c0, x11 * s1 + x21 * c1); }
        }
        __syncthreads();
        { unsigned char* w = opq(args.ws); pg8::Gemm g{WP(bf16_t, WS_LAT), WP(bf16_t, WS_WUQ), S, 768, QLORA, 768}; pg8::StaticOrder so; so.init(S, 768, G, bx);
          rs_fill(L, WP(const float, WS_SSQL), 32, 0, 3, 1.f / 384.f, 0.14724444602590306f, bx & 7, wave, lane); pg8::EpiQUp E{WP(bf16_t, WS_QF), RT_PTR, WP(float, WS_CS), WP(float, WS_SN)}; pg8::gemm_phase<pg8::EpiQUp, pg8::StaticOrder, true, true>(L, g, so, E, wave); }
        { unsigned char* w = opq(args.ws); pg8::Gemm g{WP(bf16_t, WS_LAT) + 384, WP(bf16_t, WS_WUKV), S, 1024, KVLORA, 768}; pg8::StaticOrder so; so.init(S, 1024, G, bx);
          rs_fill(L, WP(const float, WS_SSQL), 32, 12, 2, 1.f / 256.f, 1.f, bx & 7, wave, lane); pg8::EpiKVUp E{WP(bf16_t, WS_KF), WP(bf16_t, WS_VV), RT_PTR}; pg8::gemm_phase<pg8::EpiKVUp, pg8::StaticOrder, true, true>(L, g, so, E, wave); }
    }
    SEAM(5);
    if (IN(6)) { { unsigned char* w = opq(args.ws); mla::mla_phase((__attribute__((address_space(3))) char*)L, WP(const bf16_t, WS_QF), WP(const bf16_t, WS_KF), WP(const bf16_t, WS_VV), WP(bf16_t, WS_ATT), bx, G, wave, lane); }
        unsigned char* w = opq(args.ws); pg8::Gemm g{WP(bf16_t, WS_XB), WP(bf16_t, WS_WG), S, 2048, DM, DM}; pg8::StaticOrder so; so.init(S, 2048, G, bx);
        rs_fill(L, WP(const float, WS_SSQ1), 16, 0, 4, 1.f / 1024.f, 1.f, bx & 7, wave, lane); pg8::EpiGate E{WP(bf16_t, WS_G), args.in[10], RT_PTR}; pg8::gemm_phase<pg8::EpiGate, pg8::StaticOrder, true, true>(L, g, so, E, wave); }
    SEAM(6);
    if (IN(7)) { pg8::StaticOrder so; so.init(S, DM, G, bx);
        { unsigned char* w = opq(args.ws); pg8::Gemm g{WP(bf16_t, WS_ATT), WP(bf16_t, WS_WBA), S, DM, 512, 512}; pg8::EpiMerge<false> E{WP(bf16_t, WS_MG), WP(bf16_t, WS_G)}; pg8::gemm_phase<pg8::EpiMerge<false>, pg8::StaticOrder, true, true>(L, g, so, E, wave); }
        { unsigned char* w = opq(args.ws); pg8::Gemm g{WP(bf16_t, WS_DIL), WP(bf16_t, WS_WBD), S, DM, 512, 512}; pg8::EpiMerge<true> E{WP(bf16_t, WS_MG), WP(bf16_t, WS_G)}; pg8::gemm_phase<pg8::EpiMerge<true>, pg8::StaticOrder, true, true>(L, g, so, E, wave); } }
    SEAM(7);
    if (IN(8)) { unsigned char* w = opq(args.ws); pg8::Gemm g{WP(bf16_t, WS_MG), WP(bf16_t, WS_WO), S, DM, DM, DM}; pg8::StaticOrder so; so.init(S, DM, G, bx);
        pg8::EpiResid<true> E{nullptr, WP(bf16_t, WS_XB), WP(float, WS_SSQ2), 1.0f, 0.f}; pg8::gemm_phase<pg8::EpiResid<true>, pg8::StaticOrder, true, true>(L, g, so, E, wave); }
    SEAML(8);
    if (IN(9)) { unsigned char* w = opq(args.ws); pg8::Gemm g{WP(bf16_t, WS_XB), WP(bf16_t, WS_WGU), S, 2 * DFF, DM, DM}; pg8::StaticOrder so; so.init(S, 2 * DFF, G, bx);
        rs_fill(L, WP(const float, WS_SSQ2), 16, 0, 4, 1.f / 1024.f, 1.f, bx & 7, wave, lane); pg8::EpiSwiglu E{WP(bf16_t, WS_H), WP(float, WS_SSQ2), 1, RT_PTR}; pg8::gemm_phase<pg8::EpiSwiglu, pg8::StaticOrder, true, true>(L, g, so, E, wave); }
    SEAML(9);
    if (IN(10)) { unsigned char* w = opq(args.ws); pg8::Gemm g{WP(bf16_t, WS_H), WP(bf16_t, WS_WD), S, DM, DFF, DFF}; pg8::StaticOrder so; so.init(S, DM, G, bx);
        pg8::EpiFinal E{(const PGAS bf16_t*)WP(bf16_t, WS_XB), (PGAS float*)args.out, (const PGAS float*)args.in[3], (unsigned*)(w + 248 * MiB), (unsigned*)(w + WS_CTL) + 16384, 0.5f, 0.f};
        pg8::gemm_phase<pg8::EpiFinal, pg8::StaticOrder, true, true>(L, g, so, E, wave); }
#undef IN
#undef SEAM
#undef lane
#undef tid
}

#undef args
extern "C" void kernel_launch(void* const* d_in, const int* in_sizes, int n_in, void* d_out, int out_size, void* d_ws, size_t ws_size, hipStream_t stream) {
    float* R = (float*)d_out; unsigned char* ws = (unsigned char*)d_ws;
    if (ws_size < 256 * MiB || n_in != 22) { fprintf(stderr, "bad args: ws %zu n_in %d\n", ws_size, n_in); return; }
    static int grid = 0;
    if (grid == 0) {
        int dev = 0, cus = 0, per_cu = 0; (void)hipGetDevice(&dev); (void)hipDeviceGetAttribute(&cus, hipDeviceAttributeMultiprocessorCount, dev);
        if (hipFuncSetAttribute((const void*)mk_fwd, hipFuncAttributeMaxDynamicSharedMemorySize, MK_LDS_BYTES) != hipSuccess) fprintf(stderr, "hipFuncSetAttribute failed\n");
        if (hipOccupancyMaxActiveBlocksPerMultiprocessor(&per_cu, (const void*)mk_fwd, NWAVES * 64, MK_LDS_BYTES) != hipSuccess || per_cu < 1) { fprintf(stderr, "occupancy query: %d\n", per_cu); per_cu = 1; }
        (void)hipGetLastError();
        grid = cus * (per_cu < 1 ? 1 : per_cu);
        if (grid != 256) fprintf(stderr, "note: grid %d (per_cu %d)\n", grid, per_cu);
    }
    MkArgs a{}; for (int i = 0; i < 22; ++i) a.in[i] = (const float*)d_in[i]; a.out = R; a.ws = ws;
    InvFreq ifr; for (int i = 0; i < 16; ++i) ifr.f[i] = (float)(1.0 / pow(10000.0, (double)(2 * i) / 32.0));
    (void)hipMemsetAsync(ws + WS_CTL, 0, 131072, stream);
    a.ph_lo = 0; a.ph_hi = 11;
    void* kargs[] = {(void*)&a, (void*)&ifr};
    hipError_t le = hipLaunchCooperativeKernel((const void*)mk_fwd, dim3(grid), dim3(NWAVES * 64), kargs, MK_LDS_BYTES, stream);
    if (le != hipSuccess) fprintf(stderr, "cooperative launch failed: %s (grid %d)\n", hipGetErrorString(le), grid);
}
```

```cpp
#include <hip/hip_runtime.h>
#include <cstdio>
#include <cstdint>

typedef unsigned short bf16_t;
constexpr int S = 16384, DM = 1024, DFF = 2816, DIN = 7328;
constexpr int NH = 8, DQK = 96, DNOPE = 64, DROPE = 32, DV = 64, QLORA = 384, KVLORA = 256;
constexpr int DH = 64, NG = 3, HPG = 8;
constexpr float EPS = 1e-6f;

__device__ __forceinline__ float bf2f(bf16_t v) { return __uint_as_float(((unsigned)v) << 16); }
__device__ __forceinline__ bf16_t f2bf(float f) { unsigned u = __float_as_uint(f); return (bf16_t)((u + 0x7fffu + ((u >> 16) & 1u)) >> 16); }
__device__ __forceinline__ float ldf(const float* p) { return *p; }
__device__ __forceinline__ float ldf(const bf16_t* p) { return bf2f(*p); }
__device__ __forceinline__ float wave_sum(float v) {
#pragma unroll
    for (int o = 1; o < 64; o <<= 1) v += __shfl_xor(v, o);
    return v;
}

__device__ __forceinline__ void sincos_acc(float angf, float& c, float& s) {
    const double a = (double)angf;
    const double k = rint(a * 0.63661977236758134308);
    const double r = fma(-k, 1.5707963267948966192, a) - k * 6.123233995736766e-17;
    const double r2 = r * r;
    double sp = r * (1.0 + r2 * (-1.0 / 6 + r2 * (1.0 / 120 + r2 * (-1.0 / 5040 + r2 * (1.0 / 362880 + r2 * (-1.0 / 39916800 + r2 * (1.0 / 6227020800.0)))))));
    double cp = 1.0 + r2 * (-0.5 + r2 * (1.0 / 24 + r2 * (-1.0 / 720 + r2 * (1.0 / 40320 + r2 * (-1.0 / 3628800 + r2 * (1.0 / 479001600.0 + r2 * (-1.0 / 87178291200.0)))))));
    const int q = ((int)k) & 3;
    double ss = (q & 1) ? cp : sp, cc = (q & 1) ? sp : cp;
    if (q == 1) cc = -cc; if (q == 2) { ss = -ss; cc = -cc; } if (q == 3) ss = -ss;
    c = (float)cc; s = (float)ss;
}
struct InvFreq { float f[16]; };
namespace pg8 {
#define PG8_LAS __attribute__((address_space(3)))
typedef unsigned short bf16_t;
typedef short bf16x8 __attribute__((ext_vector_type(8)));
typedef float f32x4 __attribute__((ext_vector_type(4)));
typedef unsigned u32x4 __attribute__((ext_vector_type(4)));
constexpr int BM = 256, BK = 64, HALF = 128, HTB = HALF * BK * 2  , STAGE_BYTES = 8 * HTB, NXCD = 8, WGM = 8;

__host__ __device__ __forceinline__ int lds_byte(int r, int c) { const int st = (r >> 4) * 2 + (c >> 5), rr = r & 15, cc = c & 31, ob = rr * 64 + cc * 2; return st * 1024 + (ob ^ (((ob >> 9) & 1) << 5)); }
__host__ __device__ __forceinline__ void stage_rc(int b, int& R, int& C) { const int st = b / 1024, sb = b % 1024, swz = sb ^ (((sb >> 9) & 1) << 5); R = (st >> 1) * 16 + swz / 64; C = (st & 1) * 32 + (swz % 64) / 2; }
__host__ __device__ __forceinline__ int perm32(int rho) { const int n = rho >> 4, i = rho & 15; return 8 * (i >> 2) + 4 * n + (i & 3); }

struct Unit { int pm, pn; };
struct Gemm { const bf16_t* A; const bf16_t* Bt; int M, N, K, lda; };

struct StaticOrder {
    int nM, nN, nwg, G, c;
    __host__ __device__ void init(int M, int N, int G_, int c_) { nM = M / BM; nN = N / BM; nwg = nM * nN; G = G_; c = c_; }
    __host__ __device__ bool next(int i, Unit& u) const {
        const long L = (long)i * G + c; if (L >= nwg) return false;
        int wgid = (int)L; { const int q = nwg / NXCD, r = nwg % NXCD, xcd = wgid % NXCD, off = wgid / NXCD; wgid = (xcd < r ? xcd * (q + 1) : r * (q + 1) + (xcd - r) * q) + off; }
        const int nig = WGM * nN, gid = wgid / nig, fm = gid * WGM, gsz = (nM - fm) < WGM ? (nM - fm) : WGM;
        u.pm = fm + ((wgid % nig) % gsz); u.pn = (wgid % nig) / gsz; return true;
    }
    __device__ __forceinline__ void a_ready(const Unit&) const {}
    __device__ __forceinline__ void done(const Unit&) const {}
};

__device__ __forceinline__ unsigned cvt_pk_bf16(float lo, float hi) { unsigned r; asm volatile("v_cvt_pk_bf16_f32 %0, %1, %2" : "=v"(r) : "v"(lo), "v"(hi)); return r; }
template <class Epi, class Sched, bool ALIGN_EPI = false, bool SP2 = false>
__device__ __forceinline__ void gemm_phase(PG8_LAS unsigned char* lds, const Gemm g, const Sched& S, const Epi& E, const int wid) {
    int lane_ = (int)__builtin_amdgcn_mbcnt_hi(~0u, __builtin_amdgcn_mbcnt_lo(~0u, 0u)); asm volatile("" : "+v"(lane_));
    const int lane = lane_, tid = wid * 64 + lane, wr = wid >> 2, wc = wid & 3, fr = lane & 15, fq = lane >> 4;
    int K_ = g.K; asm volatile("" : "+s"(K_)); const int K = K_, nt = K / BK;
    unsigned voffA[2], voffB[2];
#pragma unroll
    for (int i = 0; i < 2; ++i) { int R, C; stage_rc(tid * 16 + i * 8192, R, C); const int Rb = Epi::PERM ? ((R & ~31) + perm32(R & 31)) : R;
        voffA[i] = (unsigned)(R * g.lda + C) * 2u; voffB[i] = (unsigned)(Rb * K + C) * 2u; }
    const size_t kstep = (size_t)(BK * 2);
    const size_t hstepB = (size_t)HALF * K * 2, hstepA = (size_t)HALF * g.lda * 2;
    const size_t tstepB = 2 * hstepB, tstepA = 2 * hstepA;
    const unsigned ldsw = (unsigned)wid * 1024u;
    const int aoff = lds_byte(wr * 64 + fr, fq * 8), boff = lds_byte(wc * 32 + fr, fq * 8);
#define PG8_SA(b, h) (((b) * 2 + (h)) * HTB)
#define PG8_SB(b, h) ((4 + (b) * 2 + (h)) * HTB)
#define PG8_STAGE(bufoff, gbase, voff) do { _Pragma("unroll") for (int _i = 0; _i < 2; ++_i) \
        __builtin_amdgcn_global_load_lds((const unsigned*)((const char*)(gbase) + (voff)[_i]), (PG8_LAS unsigned*)(lds + (bufoff) + ldsw + _i * 8192), 16, 0, 0); } while (0)
#define PG8_LDA(dst, b, h) do { _Pragma("unroll") for (int m = 0; m < 4; ++m) _Pragma("unroll") for (int k = 0; k < 2; ++k) dst[m][k] = *(const PG8_LAS bf16x8*)(lds + PG8_SA(b, h) + aoff + m * 2048 + k * 1024); } while (0)
#define PG8_LDB(dst, b, h) do { _Pragma("unroll") for (int n = 0; n < 2; ++n) _Pragma("unroll") for (int k = 0; k < 2; ++k) dst[n][k] = *(const PG8_LAS bf16x8*)(lds + PG8_SB(b, h) + boff + n * 2048 + k * 1024); } while (0)
#define PG8_MMA(ai, bj, At, Bt) do { __builtin_amdgcn_s_setprio(1); _Pragma("unroll") for (int m = 0; m < 4; ++m) _Pragma("unroll") for (int n = 0; n < 2; ++n) _Pragma("unroll") for (int k = 0; k < 2; ++k) \
        acc[ai][bj][m][n] = __builtin_amdgcn_mfma_f32_16x16x32_bf16(Bt[n][k], At[m][k], acc[ai][bj][m][n], 0, 0, 0); __builtin_amdgcn_s_setprio(0); } while (0)
#define PG8_WAIT_V(n) asm volatile("s_waitcnt vmcnt(" #n ")" ::: "memory")
#define PG8_WAIT_L(n) asm volatile("s_waitcnt lgkmcnt(" #n ")" ::: "memory")
#define PG8_BAR __builtin_amdgcn_s_barrier()
#define PG8_SCHED __builtin_amdgcn_sched_barrier(0)
    Unit cur, nxt; int ui = 0;
    if (!S.next(0, cur)) return;
    f32x4 acc[2][2][4][2];
#pragma unroll
    for (int a = 0; a < 2; ++a)
#pragma unroll
        for (int b = 0; b < 2; ++b)
#pragma unroll
            for (int m = 0; m < 4; ++m)
#pragma unroll
                for (int n = 0; n < 2; ++n) acc[a][b][m][n] = (f32x4){0.f, 0.f, 0.f, 0.f};
    bf16x8 At[4][2], B0[2][2], B1[2][2];
    const char* cA = (const char*)g.A + (size_t)cur.pm * tstepA; const char* cB = (const char*)g.Bt + (size_t)cur.pn * tstepB;
    S.a_ready(cur);
    if constexpr (SP2) {
        PG8_STAGE(PG8_SB(0, 0), cB, voffB); PG8_STAGE(PG8_SB(0, 1), cB + hstepB, voffB); PG8_STAGE(PG8_SA(0, 0), cA, voffA); PG8_STAGE(PG8_SA(0, 1), cA + hstepA, voffA);
        if (wr == 1) PG8_BAR;
        PG8_WAIT_V(2); PG8_BAR;
        PG8_STAGE(PG8_SB(1, 0), cB + kstep, voffB); PG8_STAGE(PG8_SA(1, 0), cA + kstep, voffA); PG8_STAGE(PG8_SB(1, 1), cB + hstepB + kstep, voffB);
        PG8_WAIT_V(6); PG8_BAR;
    } else {
        PG8_STAGE(PG8_SB(0, 0), cB, voffB); PG8_STAGE(PG8_SA(0, 0), cA, voffA); PG8_STAGE(PG8_SB(0, 1), cB + hstepB, voffB); PG8_STAGE(PG8_SA(0, 1), cA + hstepA, voffA);
        if (wr == 1) PG8_BAR;
        PG8_WAIT_V(4); PG8_BAR;
        PG8_STAGE(PG8_SB(1, 0), cB + kstep, voffB); PG8_STAGE(PG8_SA(1, 0), cA + kstep, voffA); PG8_STAGE(PG8_SB(1, 1), cB + hstepB + kstep, voffB);
        PG8_WAIT_V(6); PG8_BAR;
    }
    for (;;) {
        const bool has_next = S.next(ui + 1, nxt);
        const char* nA = has_next ? (const char*)g.A + (size_t)nxt.pm * tstepA : cA; const char* nB = has_next ? (const char*)g.Bt + (size_t)nxt.pn * tstepB : cB;
        for (int t = 0; t < nt; t += 2) {
            const bool last = (t == nt - 2);
            const char* a1 = cA + (size_t)(t + 1) * kstep;
            const char* a2 = last ? nA : cA + (size_t)(t + 2) * kstep; const char* b2 = last ? nB : cB + (size_t)(t + 2) * kstep;
            const char* a3 = a2 + kstep; const char* b3 = b2 + kstep;
            if (last && has_next) S.a_ready(nxt);
            if constexpr (SP2) {
            PG8_LDB(B0, 0, 0); PG8_LDB(B1, 0, 1); PG8_SCHED; PG8_LDA(At, 0, 0); PG8_STAGE(PG8_SA(1, 1), a1 + hstepA, voffA);
            PG8_WAIT_V(8); PG8_WAIT_L(0); PG8_BAR; PG8_MMA(0, 0, At, B0); PG8_MMA(0, 1, At, B1); PG8_BAR; PG8_SCHED;
            PG8_LDA(At, 0, 1); PG8_STAGE(PG8_SB(0, 0), b2, voffB); PG8_STAGE(PG8_SB(0, 1), b2 + hstepB, voffB); PG8_STAGE(PG8_SA(0, 0), a2, voffA);
            PG8_WAIT_V(8); PG8_WAIT_L(0); PG8_BAR; PG8_MMA(1, 0, At, B0); PG8_MMA(1, 1, At, B1); PG8_BAR; PG8_SCHED;
            PG8_LDB(B0, 1, 0); PG8_LDB(B1, 1, 1); PG8_SCHED; PG8_LDA(At, 1, 0); PG8_STAGE(PG8_SA(0, 1), a2 + hstepA, voffA);
            PG8_WAIT_V(8); PG8_WAIT_L(0); PG8_BAR; PG8_MMA(0, 0, At, B0); PG8_MMA(0, 1, At, B1); PG8_BAR; PG8_SCHED;
            PG8_LDA(At, 1, 1); PG8_STAGE(PG8_SB(1, 0), b3, voffB); PG8_STAGE(PG8_SB(1, 1), b3 + hstepB, voffB); PG8_STAGE(PG8_SA(1, 0), a3, voffA);
            PG8_WAIT_V(8); PG8_WAIT_L(0); PG8_BAR; PG8_MMA(1, 0, At, B0); PG8_MMA(1, 1, At, B1); PG8_BAR; PG8_SCHED;
            } else {
            PG8_LDB(B0, 0, 0); PG8_SCHED; PG8_LDA(At, 0, 0); PG8_STAGE(PG8_SA(1, 1), a1 + hstepA, voffA);
            PG8_WAIT_L(8); PG8_BAR; PG8_WAIT_L(0); PG8_MMA(0, 0, At, B0); PG8_BAR; PG8_SCHED;
            PG8_LDB(B1, 0, 1); PG8_STAGE(PG8_SB(0, 0), b2, voffB);
            PG8_BAR; PG8_WAIT_L(0); PG8_MMA(0, 1, At, B1); PG8_BAR;
            PG8_LDA(At, 0, 1); PG8_STAGE(PG8_SA(0, 0), a2, voffA);
            PG8_BAR; PG8_WAIT_L(0); PG8_MMA(1, 0, At, B0); PG8_BAR; PG8_SCHED;
            PG8_STAGE(PG8_SB(0, 1), b2 + hstepB, voffB);
            PG8_WAIT_V(6); PG8_BAR; PG8_MMA(1, 1, At, B1); PG8_BAR;
            PG8_LDB(B0, 1, 0); PG8_SCHED; PG8_LDA(At, 1, 0); PG8_STAGE(PG8_SA(0, 1), a2 + hstepA, voffA);
            PG8_WAIT_L(8); PG8_BAR; PG8_WAIT_L(0); PG8_MMA(0, 0, At, B0); PG8_BAR; PG8_SCHED;
            PG8_LDB(B1, 1, 1); PG8_STAGE(PG8_SB(1, 0), b3, voffB);
            PG8_BAR; PG8_WAIT_L(0); PG8_MMA(0, 1, At, B1); PG8_BAR;
            PG8_LDA(At, 1, 1); PG8_STAGE(PG8_SA(1, 0), a3, voffA);
            PG8_BAR; PG8_WAIT_L(0); PG8_MMA(1, 0, At, B0); PG8_BAR; PG8_SCHED;
            PG8_STAGE(PG8_SB(1, 1), b3 + hstepB, voffB);
            PG8_WAIT_V(6); PG8_BAR; PG8_MMA(1, 1, At, B1); PG8_BAR;
            }
        }
        if constexpr (ALIGN_EPI) { if (wr == 0) PG8_BAR; }
        if constexpr (!Epi::AFTER_DRAIN) { E(acc, cur, wr, wc, fr, fq); S.done(cur); }
        if (!has_next) break;
#pragma unroll
        for (int a = 0; a < 2; ++a)
#pragma unroll
            for (int b = 0; b < 2; ++b)
#pragma unroll
                for (int m = 0; m < 4; ++m)
#pragma unroll
                    for (int n = 0; n < 2; ++n) acc[a][b][m][n] = (f32x4){0.f, 0.f, 0.f, 0.f};
        cur = nxt; cA = nA; cB = nB; ++ui;
        if constexpr (ALIGN_EPI) { if (wr == 1) PG8_BAR; }
    }
    PG8_WAIT_V(0);
    if constexpr (!ALIGN_EPI) { if (wr == 0) PG8_BAR; }
    PG8_BAR;
    if constexpr (Epi::AFTER_DRAIN) { E.fused(acc, cur, wr, wc, fr, fq, lds, wid, lane); S.done(cur); }
#undef PG8_SA
#undef PG8_SB
#undef PG8_STAGE
#undef PG8_LDA
#undef PG8_LDB
#undef PG8_MMA
#undef PG8_WAIT_V
#undef PG8_WAIT_L
#undef PG8_BAR
#undef PG8_SCHED
}
}
namespace pg8 {
typedef unsigned u32x2 __attribute__((ext_vector_type(2)));
constexpr int S_ = 16384;
__device__ __forceinline__ float hsum4(f32x4 a) { return (a[0] + a[1]) + (a[2] + a[3]); }
__device__ __forceinline__ float dot4(f32x4 a) { return (a[0] * a[0] + a[1] * a[1]) + (a[2] * a[2] + a[3] * a[3]); }
__device__ __forceinline__ float sumslots(const float* p, int n4) { float s = 0.f; for (int i = 0; i < n4; ++i) s += hsum4(*(const f32x4*)(p + 4 * i)); return s; }
__device__ __forceinline__ u32x4 pack8bf(f32x4 a, f32x4 b) { u32x4 w; w.x = cvt_pk_bf16(a[0], a[1]); w.y = cvt_pk_bf16(a[2], a[3]); w.z = cvt_pk_bf16(b[0], b[1]); w.w = cvt_pk_bf16(b[2], b[3]); return w; }
__device__ __forceinline__ float silu_mul(float g, float u) { const float e = __builtin_amdgcn_exp2f(g * -1.4426950408889634f); return g * __builtin_amdgcn_rcpf(1.f + e) * u; }
__device__ __forceinline__ float sigmoidf_(float z) { const float e = __builtin_amdgcn_exp2f(z * -1.4426950408889634f); return __builtin_amdgcn_rcpf(1.f + e); }
__device__ __forceinline__ f32x4 bf4_lo(u32x2 w) { return (f32x4){__uint_as_float(w.x << 16), __uint_as_float(w.x & 0xffff0000u), __uint_as_float(w.y << 16), __uint_as_float(w.y & 0xffff0000u)}; }

struct EpiSwiglu { static constexpr bool PERM = true, AFTER_DRAIN = false;
    bf16_t* H; const float* rs; int rs_slots; const __attribute__((address_space(3))) float* rt;
    __device__ __forceinline__ void operator()(const f32x4 (&acc)[2][2][4][2], const Unit& u, int wr, int wc, int fr, int fq) const {
        const int row0 = u.pm * BM + wr * 64 + fr, col0 = u.pn * 128 + wc * 32 + 8 * fq;
#pragma unroll
        for (int ai = 0; ai < 2; ++ai)
#pragma unroll
            for (int m = 0; m < 4; ++m) { const int row = row0 + ai * HALF + m * 16;
                const float r = rs_slots ? rt[row & 2047] : rs[row];
                f32x4 h0, h1;
#pragma unroll
                for (int e = 0; e < 4; ++e) { h0[e] = silu_mul(acc[ai][0][m][0][e] * r, acc[ai][1][m][0][e] * r); h1[e] = silu_mul(acc[ai][0][m][1][e] * r, acc[ai][1][m][1][e] * r); }
                *(u32x4*)(H + (size_t)row * 2816 + col0) = pack8bf(h0, h1); }
    }
};
template <bool BASE_BF16> struct EpiResid { static constexpr bool PERM = true, AFTER_DRAIN = false;
    const float* basef; bf16_t* xb; float* ssq; float scale; float pad;
    __device__ __forceinline__ void operator()(const f32x4 (&acc)[2][2][4][2], const Unit& u, int wr, int wc, int fr, int fq) const {
        const int row0 = u.pm * BM + wr * 64 + fr, col0 = u.pn * BM + wc * 32 + 8 * fq;
#pragma unroll
        for (int ai = 0; ai < 2; ++ai)
#pragma unroll
            for (int m = 0; m < 4; ++m) { const int row = row0 + ai * HALF + m * 16; float q = 0.f;
#pragma unroll
                for (int bj = 0; bj < 2; ++bj) { const size_t off = (size_t)row * 1024 + col0 + bj * HALF; f32x4 b0, b1;
                    if (BASE_BF16) { const u32x4 bw = *(const u32x4*)(xb + off); b0 = bf4_lo((u32x2){bw.x, bw.y}); b1 = bf4_lo((u32x2){bw.z, bw.w}); }
                    else { b0 = *(const f32x4*)(basef + off); b1 = *(const f32x4*)(basef + off + 4); }
                    const f32x4 v0 = b0 + acc[ai][bj][m][0] * scale, v1 = b1 + acc[ai][bj][m][1] * scale;
                    *(u32x4*)(xb + off) = pack8bf(v0, v1); q += dot4(v0) + dot4(v1); }
                q += __shfl_xor(q, 16); q += __shfl_xor(q, 32);
                if (fq == 0) ssq[(size_t)row * 16 + u.pn * 4 + wc] = q; }
    }
};
struct EpiProj { static constexpr bool PERM = true, AFTER_DRAIN = false;
    bf16_t* LAT; bf16_t* QKV; const __attribute__((address_space(3))) float* rt; float* ssql; int pn_base; int pad;
    __device__ __forceinline__ void operator()(const f32x4 (&acc)[2][2][4][2], const Unit& u, int wr, int wc, int fr, int fq) const {
        const int pe = u.pn + pn_base, lt = pe - 18; const int row0 = u.pm * BM + wr * 64 + fr; const bool lat = pe >= 18;
        const int t = pe, w = t / 6, cc = (t - w * 6) * 256;
        bf16_t* dst = lat ? LAT + lt * 256 : QKV + (size_t)w * ((size_t)S_ * 1536) + cc; const int ld = lat ? 768 : 1536;
#pragma unroll
        for (int ai = 0; ai < 2; ++ai)
#pragma unroll
            for (int m = 0; m < 4; ++m) { const int row = row0 + ai * HALF + m * 16;
                const float r = rt[row & 2047];
#pragma unroll
                for (int bj = 0; bj < 2; ++bj) { const f32x4 v0 = acc[ai][bj][m][0] * r, v1 = acc[ai][bj][m][1] * r;
                    *(u32x4*)(dst + (size_t)row * ld + bj * HALF + wc * 32 + 8 * fq) = pack8bf(v0, v1);
                    if (lat) { float q = dot4(v0) + dot4(v1); q += __shfl_xor(q, 16); q += __shfl_xor(q, 32); if (fq == 0) ssql[(size_t)row * 32 + lt * 8 + bj * 4 + wc] = q; } } }
    }
};
struct EpiGate { static constexpr bool PERM = true, AFTER_DRAIN = false;
    bf16_t* G; const float* b; const __attribute__((address_space(3))) float* rt;
    __device__ __forceinline__ void operator()(const f32x4 (&acc)[2][2][4][2], const Unit& u, int wr, int wc, int fr, int fq) const {
        const int row0 = u.pm * BM + wr * 64 + fr, col0 = u.pn * BM + wc * 32 + 8 * fq;
#pragma unroll
        for (int ai = 0; ai < 2; ++ai)
#pragma unroll
            for (int m = 0; m < 4; ++m) { const int row = row0 + ai * HALF + m * 16;
                const float r = rt[row & 2047];
#pragma unroll
                for (int bj = 0; bj < 2; ++bj) { const f32x4 b0 = *(const f32x4*)(b + col0 + bj * HALF), b1 = *(const f32x4*)(b + col0 + bj * HALF + 4);
                    f32x4 v0 = acc[ai][bj][m][0] * r + b0, v1 = acc[ai][bj][m][1] * r + b1;
#pragma unroll
                    for (int e = 0; e < 4; ++e) { v0[e] = sigmoidf_(v0[e]); v1[e] = sigmoidf_(v1[e]); }
                    *(u32x4*)(G + (size_t)row * 2048 + col0 + bj * HALF) = pack8bf(v0, v1); } }
    }
};
template <bool SECOND> struct EpiMerge { static constexpr bool PERM = true, AFTER_DRAIN = false;
    bf16_t* MG; const bf16_t* G;
    __device__ __forceinline__ void operator()(const f32x4 (&acc)[2][2][4][2], const Unit& u, int wr, int wc, int fr, int fq) const {
        const int row0 = u.pm * BM + wr * 64 + fr, col0 = u.pn * BM + wc * 32 + 8 * fq;
        const __attribute__((address_space(1))) bf16_t* Gg = (const __attribute__((address_space(1))) bf16_t*)G; __attribute__((address_space(1))) bf16_t* Mg = (__attribute__((address_space(1))) bf16_t*)MG;
#pragma unroll
        for (int ai = 0; ai < 2; ++ai) {
            u32x4 gw[4][2], pw[4][2];
#pragma unroll
            for (int m = 0; m < 4; ++m)
#pragma unroll
                for (int bj = 0; bj < 2; ++bj) { const int row = row0 + ai * HALF + m * 16, col = col0 + bj * HALF;
                    gw[m][bj] = *(const __attribute__((address_space(1))) u32x4*)(Gg + (size_t)row * 2048 + (SECOND ? 1024 : 0) + col);
                    if (SECOND) pw[m][bj] = *(const __attribute__((address_space(1))) u32x4*)(Mg + (size_t)row * 1024 + col); }
#pragma unroll
            for (int m = 0; m < 4; ++m)
#pragma unroll
                for (int bj = 0; bj < 2; ++bj) { const int row = row0 + ai * HALF + m * 16, col = col0 + bj * HALF; const u32x4 g4 = gw[m][bj];
                    f32x4 v0 = bf4_lo((u32x2){g4.x, g4.y}) * acc[ai][bj][m][0], v1 = bf4_lo((u32x2){g4.z, g4.w}) * acc[ai][bj][m][1];
                    if (SECOND) { const u32x4 p4 = pw[m][bj]; v0 += bf4_lo((u32x2){p4.x, p4.y}); v1 += bf4_lo((u32x2){p4.z, p4.w}); }
                    *(__attribute__((address_space(1))) u32x4*)(Mg + (size_t)row * 1024 + col) = pack8bf(v0, v1); } }
    }
};
struct EpiQUp { static constexpr bool PERM = false, AFTER_DRAIN = false;
    bf16_t* QF; const __attribute__((address_space(3))) float* rt; const float* cs; const float* sn;
    __device__ __forceinline__ void operator()(const f32x4 (&acc)[2][2][4][2], const Unit& u, int wr, int wc, int fr, int fq) const {
        const int row0 = u.pm * BM + wr * 64 + fr;
#pragma unroll
        for (int ai = 0; ai < 2; ++ai)
#pragma unroll
            for (int m = 0; m < 4; ++m) { const int row = row0 + ai * HALF + m * 16;
                const float r = rt[row & 2047];
#pragma unroll
                for (int bj = 0; bj < 2; ++bj) { const int cg = u.pn * BM + bj * HALF + wc * 32; const bool rope = (cg % 96) == 64;
                    f32x4 x1 = acc[ai][bj][m][0] * r, x2 = acc[ai][bj][m][1] * r;
                    if (rope) { const f32x4 c = *(const f32x4*)(cs + (size_t)row * 16 + 4 * fq), s = *(const f32x4*)(sn + (size_t)row * 16 + 4 * fq);
                        const f32x4 y1 = x1 * c - x2 * s, y2 = x1 * s + x2 * c; x1 = y1; x2 = y2; }
                    u32x2 w1, w2; w1.x = cvt_pk_bf16(x1[0], x1[1]); w1.y = cvt_pk_bf16(x1[2], x1[3]); w2.x = cvt_pk_bf16(x2[0], x2[1]); w2.y = cvt_pk_bf16(x2[2], x2[3]);
                    const bool oddq = (fq & 1) != 0; const u32x2 snd = oddq ? w1 : w2; u32x2 rcv; rcv.x = (unsigned)__shfl_xor((int)snd.x, 16); rcv.y = (unsigned)__shfl_xor((int)snd.y, 16);
                    const u32x4 ov = oddq ? (u32x4){rcv.x, rcv.y, w2.x, w2.y} : (u32x4){w1.x, w1.y, rcv.x, rcv.y};
                    *(u32x4*)(QF + (size_t)row * 768 + cg + 4 * fq + (oddq ? 12 : 0)) = ov; }
                asm volatile("" ::: "memory"); }
    }
};
struct EpiKVUp { static constexpr bool PERM = true, AFTER_DRAIN = false;
    bf16_t* KF; bf16_t* VV; const __attribute__((address_space(3))) float* rt;
    __device__ __forceinline__ void operator()(const f32x4 (&acc)[2][2][4][2], const Unit& u, int wr, int wc, int fr, int fq) const {
        const int row0 = u.pm * BM + wr * 64 + fr;
#pragma unroll
        for (int ai = 0; ai < 2; ++ai)
#pragma unroll
            for (int m = 0; m < 4; ++m) { const int row = row0 + ai * HALF + m * 16;
                const float r = rt[row & 2047];
#pragma unroll
                for (int bj = 0; bj < 2; ++bj) { const int h = u.pn * 2 + bj, d = wc * 32 + 8 * fq;
                    bf16_t* dst = (wc < 2) ? KF + (size_t)row * 768 + h * 96 + d : VV + (size_t)row * 512 + h * 64 + (d - 64);
                    *(u32x4*)dst = pack8bf(acc[ai][bj][m][0] * r, acc[ai][bj][m][1] * r); }
                asm volatile("" ::: "memory"); }
    }
};
#define PGAS __attribute__((address_space(1)))
struct EpiFinal { static constexpr bool PERM = true, AFTER_DRAIN = false;
    const PGAS bf16_t* base; PGAS float* out; const PGAS float* gfin; unsigned* slots; unsigned* cnt; float scale; float pad;
    __device__ __forceinline__ void operator()(f32x4 (&acc)[2][2][4][2], const Unit& u, int wr, int wc, int fr, int fq) const {
        const int row0 = u.pm * BM + wr * 64 + fr, col0 = u.pn * BM + wc * 32 + 8 * fq;
        { u32x4 bw[2][4][2];
#pragma unroll
          for (int ai = 0; ai < 2; ++ai)
#pragma unroll
            for (int m = 0; m < 4; ++m)
#pragma unroll
                for (int bj = 0; bj < 2; ++bj) bw[ai][m][bj] = *(const PGAS u32x4*)(base + (size_t)(row0 + ai * HALF + m * 16) * 1024 + col0 + bj * HALF);
#pragma unroll
          for (int ai = 0; ai < 2; ++ai)
#pragma unroll
            for (int m = 0; m < 4; ++m) { const int row = row0 + ai * HALF + m * 16; float q = 0.f;
#pragma unroll
                for (int bj = 0; bj < 2; ++bj) { const u32x4 w = bw[ai][m][bj];
                    const f32x4 v0 = bf4_lo((u32x2){w.x, w.y}) + acc[ai][bj][m][0] * scale, v1 = bf4_lo((u32x2){w.z, w.w}) + acc[ai][bj][m][1] * scale;
                    acc[ai][bj][m][0] = v0; acc[ai][bj][m][1] = v1; q += dot4(v0) + dot4(v1); }
                q += __shfl_xor(q, 16); q += __shfl_xor(q, 32);
                if (fq == 0) __hip_atomic_store(slots + (size_t)row * 16 + u.pn * 4 + wc, __float_as_uint(q), __ATOMIC_RELAXED, __HIP_MEMORY_SCOPE_AGENT); } }
        asm volatile("s_waitcnt vmcnt(0)" ::: "memory");
        unsigned* c = cnt + 64 * u.pm;
        if (fr == 0 && fq == 0) __hip_atomic_fetch_add(c, 1u, __ATOMIC_RELAXED, __HIP_MEMORY_SCOPE_AGENT);
        { unsigned sp = 0; while ((unsigned)__builtin_amdgcn_readfirstlane(__hip_atomic_load(c, __ATOMIC_RELAXED, __HIP_MEMORY_SCOPE_AGENT)) < 32u) { __builtin_amdgcn_s_sleep(2); if (++sp > (1u << 22)) break; } }
        asm volatile("" ::: "memory");
        unsigned long long sw[2][4][2];
#pragma unroll
        for (int ai = 0; ai < 2; ++ai)
#pragma unroll
            for (int m = 0; m < 4; ++m) { const unsigned long long* sl = (const unsigned long long*)(slots + (size_t)(row0 + ai * HALF + m * 16) * 16 + 4 * fq);
                sw[ai][m][0] = __hip_atomic_load(sl, __ATOMIC_RELAXED, __HIP_MEMORY_SCOPE_AGENT); sw[ai][m][1] = __hip_atomic_load(sl + 1, __ATOMIC_RELAXED, __HIP_MEMORY_SCOPE_AGENT); }
#pragma unroll
        for (int ai = 0; ai < 2; ++ai)
#pragma unroll
            for (int m = 0; m < 4; ++m) { const int row = row0 + ai * HALF + m * 16;
                float ss = (__uint_as_float((unsigned)sw[ai][m][0]) + __uint_as_float((unsigned)(sw[ai][m][0] >> 32))) + (__uint_as_float((unsigned)sw[ai][m][1]) + __uint_as_float((unsigned)(sw[ai][m][1] >> 32)));
                ss += __shfl_xor(ss, 16); ss += __shfl_xor(ss, 32);
                const float r = rsqrtf(ss * (1.f / 1024.f) + 1e-6f);
#pragma unroll
                for (int bj = 0; bj < 2; ++bj) { const size_t off = (size_t)row * 1024 + col0 + bj * HALF;
                    const f32x4 g0 = *(const PGAS f32x4*)(gfin + col0 + bj * HALF), g1 = *(const PGAS f32x4*)(gfin + col0 + bj * HALF + 4);
                    *(PGAS f32x4*)(out + off) = acc[ai][bj][m][0] * r * g0; *(PGAS f32x4*)(out + off + 4) = acc[ai][bj][m][1] * r * g1; } }
    }
};
}

namespace mla {
#define MLAS __attribute__((address_space(3)))
#define MGAS __attribute__((address_space(1)))
constexpr int NW = 8, QBLK = 32, KVBLK = 64, QB = NW * QBLK, QS = 768, KS = 768, VS = 512, OS = 512, NSTEP = 6;
constexpr int SHM_V = KVBLK * 64 * 2, SHM_K = KVBLK * 256;
constexpr int LDS_BYTES = 2 * SHM_V + 2 * SHM_K + NW * 64 * 4;
constexpr float SCALE = 0.10206207261596575f, THR = 8.f;
constexpr unsigned WIN = 0x40000000u;
typedef short bf16x8 __attribute__((ext_vector_type(8)));
typedef short s16x4 __attribute__((ext_vector_type(4)));
typedef float f32x16 __attribute__((ext_vector_type(16)));
typedef unsigned u32x4 __attribute__((ext_vector_type(4)));
#define MLA_KSWZ(row, colB) ((row) * 256 + ((colB) ^ (((row) & 7) << 4)))
#define MLA_SBAR() __builtin_amdgcn_sched_barrier(0)
__device__ __forceinline__ int v_st(int k, int c) { const int kk = (k & ~0xC) | ((k & 4) << 1) | ((k & 8) >> 1); return ((kk >> 3) * 2 + (c >> 5)) * 512 + ((kk & 7) * 32 + (c & 31)) * 2; }
__device__ __forceinline__ int v_rd_base(int lane) { return ((lane & 3) << 3) | (((lane >> 2) & 3) << 6) | (((lane >> 4) & 1) << 5) | (((lane >> 5) & 1) << 8); }
__device__ __forceinline__ int crow(int r, int hi) { return (r & 3) + 8 * (r >> 2) + 4 * hi; }
__device__ __forceinline__ unsigned cvtpk(float lo, float hi) { unsigned r; asm volatile("v_cvt_pk_bf16_f32 %0, %1, %2" : "=v"(r) : "v"(lo), "v"(hi)); return r; }
__device__ __forceinline__ void mask_tile(f32x16& p0, f32x16& p1, int dq) {
    const float NEG = -__builtin_inff();
#pragma unroll
    for (int r = 0; r < 16; ++r) { const int c = (r & 3) + 8 * (r >> 2);
        if ((unsigned)(dq - c) >= WIN) p0[r] = NEG;
        if ((unsigned)(dq - c - 32) >= WIN) p1[r] = NEG; }
}
__device__ __forceinline__ void partialSM(f32x16& p0, f32x16& p1, float& m_reg, float& mn, float& alpha) {
    float pm_[4] = {p0[0], p0[1], p0[2], p0[3]};
#pragma unroll
    for (int r = 4; r < 16; ++r) pm_[r & 3] = fmaxf(pm_[r & 3], p0[r]);
#pragma unroll
    for (int r = 0; r < 16; ++r) pm_[r & 3] = fmaxf(pm_[r & 3], p1[r]);
    float pmax = fmaxf(fmaxf(pm_[0], pm_[1]), fmaxf(pm_[2], pm_[3]));
    { auto rr = __builtin_amdgcn_permlane32_swap(__float_as_uint(pmax), __float_as_uint(pmax), false, false);
      pmax = fmaxf(__uint_as_float(rr[0]), __uint_as_float(rr[1])); }
    constexpr float C2 = 1.4426950408889634f * SCALE;
    if (__builtin_expect(__all((pmax - m_reg) * SCALE <= THR), 1)) { mn = m_reg; alpha = 1.f; }
    else { mn = fmaxf(m_reg, pmax); alpha = __builtin_amdgcn_exp2f((m_reg - mn) * C2); m_reg = mn; }
    const float mnL = -mn * C2;
#pragma unroll
    for (int r = 0; r < 16; ++r) p0[r] = fmaf(p0[r], C2, mnL);
#pragma unroll
    for (int r = 0; r < 16; ++r) p1[r] = fmaf(p1[r], C2, mnL);
#pragma unroll
    for (int r = 0; r < 16; ++r) p0[r] = __builtin_amdgcn_exp2f(p0[r]);
}
__device__ __forceinline__ void finishSM(f32x16& p0, f32x16& p1, float alpha, float& l_reg, bf16x8& pa0, bf16x8& pa1, bf16x8& pa2, bf16x8& pa3) {
#pragma unroll
    for (int r = 0; r < 16; ++r) p1[r] = __builtin_amdgcn_exp2f(p1[r]);
    float ps_[4] = {0.f, 0.f, 0.f, 0.f};
#pragma unroll
    for (int r = 0; r < 16; ++r) ps_[r & 3] += p0[r];
#pragma unroll
    for (int r = 0; r < 16; ++r) ps_[r & 3] += p1[r];
    float ps = (ps_[0] + ps_[1]) + (ps_[2] + ps_[3]);
    { auto rr = __builtin_amdgcn_permlane32_swap(__float_as_uint(ps), __float_as_uint(ps), false, false);
      ps = __uint_as_float(rr[0]) + __uint_as_float(rr[1]); }
    l_reg = l_reg * alpha + ps;
#define MLA_PK4(P, B_, OUT) do { unsigned a0 = cvtpk(P[B_+0], P[B_+1]), a1 = cvtpk(P[B_+2], P[B_+3]);                          \
        unsigned b0 = cvtpk(P[B_+4], P[B_+5]), b1 = cvtpk(P[B_+6], P[B_+7]);                                             \
        auto r0 = __builtin_amdgcn_permlane32_swap(a0, b0, false, false); auto r1 = __builtin_amdgcn_permlane32_swap(a1, b1, false, false); \
        u32x4 w = {r0[0], r1[0], r0[1], r1[1]}; OUT = *reinterpret_cast<bf16x8*>(&w); } while (0)
    MLA_PK4(p0, 0, pa0); MLA_PK4(p0, 8, pa1); MLA_PK4(p1, 0, pa2); MLA_PK4(p1, 8, pa3);
#undef MLA_PK4
}
template <int KB>
__device__ __forceinline__ void qkt(f32x16& p0, f32x16& p1, const MLAS char* K_lds, int r32, int hi, const bf16x8* qr) {
    p0 = f32x16{}; p1 = f32x16{};
    const MLAS char* kb[4];
#pragma unroll
    for (int dd = 0; dd < 4; ++dd) kb[dd] = K_lds + KB * SHM_K + MLA_KSWZ(r32, (dd * 16 + hi * 8) * 2);
#pragma unroll
    for (int d0 = 0; d0 < NSTEP; ++d0) { const MLAS char* a = kb[d0 & 3] + (d0 >> 2) * 128;
        bf16x8 b0 = *(const MLAS bf16x8*)(a);
        bf16x8 b1 = *(const MLAS bf16x8*)(a + 32 * 256);
        p0 = __builtin_amdgcn_mfma_f32_32x32x16_bf16(b0, qr[d0], p0, 0, 0, 0);
        p1 = __builtin_amdgcn_mfma_f32_32x32x16_bf16(b1, qr[d0], p1, 0, 0, 0);
        if (d0 == 2) __builtin_amdgcn_sched_barrier(0); }
}
template <int VB>
__device__ __forceinline__ void pv_tile(f32x16* o, int vb0, bf16x8 pa0, bf16x8 pa1, bf16x8 pa2, bf16x8 pa3) {
#define MLA_TRRD(dst, off) asm volatile("ds_read_b64_tr_b16 %0, %1 offset:%2" : "=&v"(dst) : "v"(vb0), "i"(off) : "memory")
#define MLA_PV_D0(d0) do { s16x4 l0, l1, l2, l3, h0, h1, h2, h3; constexpr int b_ = VB * SHM_V + (d0) * 512;     \
        MLA_TRRD(l0, b_); MLA_TRRD(h0, b_ + 1024); MLA_TRRD(l1, b_ + 2048); MLA_TRRD(h1, b_ + 3072); MLA_TRRD(l2, b_ + 4096); MLA_TRRD(h2, b_ + 5120); MLA_TRRD(l3, b_ + 6144); MLA_TRRD(h3, b_ + 7168); \
        asm volatile("s_waitcnt lgkmcnt(0)" ::: "memory"); MLA_SBAR();   \
        o[d0] = __builtin_amdgcn_mfma_f32_32x32x16_bf16(pa0, (bf16x8){l0[0], l0[1], l0[2], l0[3], h0[0], h0[1], h0[2], h0[3]}, o[d0], 0, 0, 0);   \
        o[d0] = __builtin_amdgcn_mfma_f32_32x32x16_bf16(pa1, (bf16x8){l1[0], l1[1], l1[2], l1[3], h1[0], h1[1], h1[2], h1[3]}, o[d0], 0, 0, 0);   \
        o[d0] = __builtin_amdgcn_mfma_f32_32x32x16_bf16(pa2, (bf16x8){l2[0], l2[1], l2[2], l2[3], h2[0], h2[1], h2[2], h2[3]}, o[d0], 0, 0, 0);   \
        o[d0] = __builtin_amdgcn_mfma_f32_32x32x16_bf16(pa3, (bf16x8){l3[0], l3[1], l3[2], l3[3], h3[0], h3[1], h3[2], h3[3]}, o[d0], 0, 0, 0); } while (0)
    MLA_PV_D0(0); MLA_PV_D0(1);
#undef MLA_PV_D0
#undef MLA_TRRD
}
__device__ __forceinline__ void qkt_rt(f32x16& p0, f32x16& p1, const MLAS char* K_s, int r32, int hi, const bf16x8* qr) {
    p0 = f32x16{}; p1 = f32x16{};
    const MLAS char* kb[6];
#pragma unroll
    for (int d0 = 0; d0 < 6; ++d0) kb[d0] = K_s + r32 * 256 + (((2 * d0 + hi) ^ (r32 & 15)) << 4);
    bf16x8 f0[3], f1[3], g0[3], g1[3];
#pragma unroll
    for (int d0 = 0; d0 < 3; ++d0) { const MLAS char* a = kb[d0]; f0[d0] = *(const MLAS bf16x8*)(a); f1[d0] = *(const MLAS bf16x8*)(a + 32 * 256); }
    __builtin_amdgcn_sched_barrier(0);
#pragma unroll
    for (int d0 = 3; d0 < 6; ++d0) { const MLAS char* a = kb[d0]; g0[d0 - 3] = *(const MLAS bf16x8*)(a); g1[d0 - 3] = *(const MLAS bf16x8*)(a + 32 * 256); }
#pragma unroll
    for (int d0 = 0; d0 < 3; ++d0) { p0 = __builtin_amdgcn_mfma_f32_32x32x16_bf16(f0[d0], qr[d0], p0, 0, 0, 0); p1 = __builtin_amdgcn_mfma_f32_32x32x16_bf16(f1[d0], qr[d0], p1, 0, 0, 0); }
    __builtin_amdgcn_sched_barrier(0);
#pragma unroll
    for (int d0 = 3; d0 < 6; ++d0) { p0 = __builtin_amdgcn_mfma_f32_32x32x16_bf16(g0[d0 - 3], qr[d0], p0, 0, 0, 0); p1 = __builtin_amdgcn_mfma_f32_32x32x16_bf16(g1[d0 - 3], qr[d0], p1, 0, 0, 0); }
}
__device__ __forceinline__ void pv_rt(f32x16* o, int vb, bf16x8 pa0, bf16x8 pa1, bf16x8 pa2, bf16x8 pa3) {
#define MLA_TRRD(dst, off) asm volatile("ds_read_b64_tr_b16 %0, %1 offset:%2" : "=&v"(dst) : "v"(vb), "i"(off) : "memory")
    s16x4 l0, l1, l2, l3, h0, h1, h2, h3, m0, m1, m2, m3, n0, n1, n2, n3;
    MLA_TRRD(l0, 0); MLA_TRRD(h0, 1024); MLA_TRRD(l1, 2048); MLA_TRRD(h1, 3072); MLA_TRRD(l2, 4096); MLA_TRRD(h2, 5120); MLA_TRRD(l3, 6144); MLA_TRRD(h3, 7168);
    MLA_TRRD(m0, 512); MLA_TRRD(n0, 1536); MLA_TRRD(m1, 2560); MLA_TRRD(n1, 3584); MLA_TRRD(m2, 4608); MLA_TRRD(n2, 5632); MLA_TRRD(m3, 6656); MLA_TRRD(n3, 7680);
    asm volatile("s_waitcnt lgkmcnt(8)" ::: "memory"); MLA_SBAR();
    o[0] = __builtin_amdgcn_mfma_f32_32x32x16_bf16(pa0, (bf16x8){l0[0], l0[1], l0[2], l0[3], h0[0], h0[1], h0[2], h0[3]}, o[0], 0, 0, 0);
    o[0] = __builtin_amdgcn_mfma_f32_32x32x16_bf16(pa1, (bf16x8){l1[0], l1[1], l1[2], l1[3], h1[0], h1[1], h1[2], h1[3]}, o[0], 0, 0, 0);
    o[0] = __builtin_amdgcn_mfma_f32_32x32x16_bf16(pa2, (bf16x8){l2[0], l2[1], l2[2], l2[3], h2[0], h2[1], h2[2], h2[3]}, o[0], 0, 0, 0);
    o[0] = __builtin_amdgcn_mfma_f32_32x32x16_bf16(pa3, (bf16x8){l3[0], l3[1], l3[2], l3[3], h3[0], h3[1], h3[2], h3[3]}, o[0], 0, 0, 0);
    asm volatile("s_waitcnt lgkmcnt(0)" ::: "memory"); MLA_SBAR();
    o[1] = __builtin_amdgcn_mfma_f32_32x32x16_bf16(pa0, (bf16x8){m0[0], m0[1], m0[2], m0[3], n0[0], n0[1], n0[2], n0[3]}, o[1], 0, 0, 0);
    o[1] = __builtin_amdgcn_mfma_f32_32x32x16_bf16(pa1, (bf16x8){m1[0], m1[1], m1[2], m1[3], n1[0], n1[1], n1[2], n1[3]}, o[1], 0, 0, 0);
    o[1] = __builtin_amdgcn_mfma_f32_32x32x16_bf16(pa2, (bf16x8){m2[0], m2[1], m2[2], m2[3], n2[0], n2[1], n2[2], n2[3]}, o[1], 0, 0, 0);
    o[1] = __builtin_amdgcn_mfma_f32_32x32x16_bf16(pa3, (bf16x8){m3[0], m3[1], m3[2], m3[3], n3[0], n3[1], n3[2], n3[3]}, o[1], 0, 0, 0);
#undef MLA_TRRD
}
struct BlockRef { const MGAS bf16_t* Q; const MGAS bf16_t* K; const MGAS bf16_t* V; MGAS bf16_t* O; int P0; };
constexpr int KRING = 0, VRING = 3 * SHM_K, WSF_OFF = VRING + 4 * SHM_V, LDS_BYTES2 = WSF_OFF + NW * 64 * 4;
#define MLA_VMC(n) asm volatile("s_waitcnt vmcnt(" #n ")" ::: "memory")
#define MLA_BARX() asm volatile("s_waitcnt lgkmcnt(0)\n\ts_barrier" ::: "memory")
__device__ __forceinline__ void block2(const BlockRef& cur, MLAS char* lds, int wid, int lane) {
    const int r32 = lane & 31, hi = lane >> 5;
    const int NT = (cur.P0 + QB - 1) / KVBLK + 1;
    const int qlo = cur.P0 + wid * QBLK, qm = qlo + r32 - 4 * hi;
    MLAS char* K_lds = lds + KRING; MLAS char* V_lds = lds + VRING;
    MLAS float* wsf = (MLAS float*)(lds + WSF_OFF) + wid * 64; MLAS float* li_l = wsf; MLAS float* al_l = wsf + 32;
    unsigned kso[2];
#pragma unroll
    for (int i = 0; i < 2; ++i) { const int row = 4 * (2 * wid + i) + (lane >> 4), c = (lane & 15) ^ (row & 15), ce = c < 12 ? c : c - 4; kso[i] = (unsigned)(row * KS * 2 + ce * 16); }
    unsigned vso; { const int kk = wid * 8 + ((lane & 31) >> 2), k = (kk & ~0xC) | ((kk & 4) << 1) | ((kk & 8) >> 1), c = (lane >> 5) * 32 + (lane & 3) * 8; vso = (unsigned)(k * VS * 2 + c * 2); }
    const MGAS char* Kb = (const MGAS char*)cur.K; const MGAS char* Vb = (const MGAS char*)cur.V;
#define MLA_DMA(t, koff, voff) do { const MGAS char* kt_ = Kb + (size_t)(t) * (KVBLK * KS * 2); const MGAS char* vt_ = Vb + (size_t)(t) * (KVBLK * VS * 2);          \
        __builtin_amdgcn_global_load_lds((const MGAS unsigned*)(kt_ + kso[0]), (MLAS unsigned*)(K_lds + (koff) + (2 * wid) * 1024), 16, 0, 0);                          \
        __builtin_amdgcn_global_load_lds((const MGAS unsigned*)(kt_ + kso[1]), (MLAS unsigned*)(K_lds + (koff) + (2 * wid + 1) * 1024), 16, 0, 0);                      \
        __builtin_amdgcn_global_load_lds((const MGAS unsigned*)(vt_ + vso), (MLAS unsigned*)(V_lds + (voff) + wid * 1024), 16, 0, 0); } while (0)
    bf16x8 qr[NSTEP];
#pragma unroll
    for (int d0 = 0; d0 < NSTEP; ++d0) qr[d0] = *(const MGAS bf16x8*)(cur.Q + (size_t)(wid * QBLK + r32) * QS + d0 * 16 + hi * 8);
    float m_reg = -1e30f, l_reg = 0; f32x16 o[2] = {};
    const int vb0 = (int)(unsigned)(__UINTPTR_TYPE__)V_lds + v_rd_base(lane);
#define MLA_RESC(a) do { if (__any((a) < 1.f)) { if (hi == 0) al_l[r32] = (a); asm volatile("s_waitcnt lgkmcnt(0)" ::: "memory");              \
                     _Pragma("unroll") for (int d_ = 0; d_ < 2; ++d_) _Pragma("unroll") for (int r = 0; r < 16; ++r) o[d_][r] *= al_l[crow(r, hi)]; } } while (0)
#define MLA_MASKT(P0_, P1_, t) do { const int kb_ = (t) * KVBLK; if (__builtin_expect(__builtin_amdgcn_readfirstlane((int)(kb_ + KVBLK - 1 > qlo)) != 0, 0)) { asm volatile("" ::: "memory"); mask_tile(P0_, P1_, qm - kb_); } } while (0)
    f32x16 pA0, pA1, pB0, pB1; float mnA, mnB, alA, alB; bf16x8 pa0, pa1, pa2, pa3;
    int kc = 0, vc = 0;
#define MLA_KNEXT(x) ((x) == 2 * SHM_K ? 0 : (x) + SHM_K)
#define MLA_VNEXT(x) (((x) + SHM_V) & (4 * SHM_V - 1))
    MLA_DMA(0, 0, 0); MLA_DMA(1, SHM_K, SHM_V);
    MLA_VMC(3); MLA_BARX();
    MLA_SBAR(); qkt_rt(pA0, pA1, K_lds + kc, r32, hi, qr);
    MLA_MASKT(pA0, pA1, 0); partialSM(pA0, pA1, m_reg, mnA, alA);
    MLA_DMA(2, 2 * SHM_K, 2 * SHM_V);
    MLA_RESC(alA);
    MLA_VMC(3); MLA_BARX();
#define MLA_STEP(PX0, PX1, mnX, alX, PY0, PY1, alY, t) do {                                                                        \
        const int kp_ = kc, vp_ = vc; kc = MLA_KNEXT(kc); vc = MLA_VNEXT(vc);                \
        MLA_SBAR(); qkt_rt(PX0, PX1, K_lds + kc, r32, hi, qr);                                                                    \
        finishSM(PY0, PY1, alY, l_reg, pa0, pa1, pa2, pa3); MLA_SBAR();                                                            \
        pv_rt(o, vb0 + vp_, pa0, pa1, pa2, pa3); MLA_MASKT(PX0, PX1, (t)); partialSM(PX0, PX1, m_reg, mnX, alX);                    \
        if ((t) + 2 < NT) { MLA_DMA((t) + 2, kp_, MLA_VNEXT(MLA_VNEXT(vc))); }              \
        MLA_RESC(alX);                                                                                                             \
        if ((t) + 1 < NT) { if ((t) + 2 < NT) MLA_VMC(3); else MLA_VMC(0); MLA_BARX(); } } while (0)
    int t = 1;
    for (; t + 1 < NT; t += 2) {
        MLA_STEP(pB0, pB1, mnB, alB, pA0, pA1, alA, t);
        MLA_STEP(pA0, pA1, mnA, alA, pB0, pB1, alB, t + 1);
    }
    MLA_STEP(pB0, pB1, mnB, alB, pA0, pA1, alA, NT - 1);
    MLA_SBAR(); finishSM(pB0, pB1, alB, l_reg, pa0, pa1, pa2, pa3); MLA_SBAR(); pv_rt(o, vb0 + vc, pa0, pa1, pa2, pa3);
    if (hi == 0) li_l[r32] = l_reg; asm volatile("s_waitcnt lgkmcnt(0)" ::: "memory");
    MGAS bf16_t* Ow = cur.O + (size_t)(wid * QBLK) * OS;
#pragma unroll
    for (int r = 0; r < 16; ++r) { const int orow = crow(r, hi); const float rl = __builtin_amdgcn_rcpf(li_l[orow]);
#pragma unroll
        for (int d0 = 0; d0 < 2; ++d0) { const float v = o[d0][r] * rl; const float vn = __shfl_xor(v, 1);
            if ((r32 & 1) == 0) *(MGAS unsigned*)(Ow + (size_t)orow * OS + d0 * 32 + r32) = cvtpk(v, vn); } }
    MLA_BARX();
#undef MLA_RESC
#undef MLA_MASKT
#undef MLA_STEP
#undef MLA_DMA
}
constexpr int K5_SLOT = 16384, V5_SLOT = 8192, L5_K = 0, L5_V = 4 * K5_SLOT, L5_WS = L5_V + 4 * V5_SLOT, L5_OST = L5_WS + NW * 256, L5_BYTES = L5_OST + NW * 4096;
constexpr float THR5 = 8.f;
typedef const MLAS char* lcp;
typedef short v4i16_t __attribute__((ext_vector_type(4)));
__device__ __forceinline__ s16x4 vtr5(lcp p) { return __builtin_bit_cast(s16x4, __builtin_amdgcn_ds_read_tr16_b64_v4i16((MLAS v4i16_t*)p)); }
__device__ __forceinline__ unsigned cvtpk5(float lo, float hi) { unsigned r; asm("v_cvt_pk_bf16_f32 %0, %1, %2" : "=v"(r) : "v"(lo), "v"(hi)); return r; }
#define MX3(a, b, c) __builtin_fmaxf(__builtin_fmaxf((a), (b)), (c))
__device__ __forceinline__ float halfmax5(const f32x16& p0, const f32x16& p1) {
    float a = MX3(p0[0], p0[1], p1[0]), b = MX3(p0[2], p0[3], p1[1]); a = MX3(a, p1[2], p1[3]);
#pragma unroll
    for (int r = 4; r < 16; r += 4) { a = MX3(a, p0[r], p0[r + 1]); b = MX3(b, p0[r + 2], p0[r + 3]); a = MX3(a, p1[r], p1[r + 1]); b = MX3(b, p1[r + 2], p1[r + 3]); }
    return __builtin_fmaxf(a, b); }
__device__ __forceinline__ float mergehalves5(float m) { auto rr = __builtin_amdgcn_permlane32_swap(__float_as_uint(m), __float_as_uint(m), false, false);
    return __builtin_fmaxf(__uint_as_float(rr[0]), __uint_as_float(rr[1])); }
__device__ __forceinline__ float rowmax5(const f32x16& p0, const f32x16& p1) { return mergehalves5(halfmax5(p0, p1)); }
#undef MX3
__device__ __forceinline__ void cmask5(f32x16& p0, f32x16& p1, int jb, int qrel, int hi) {
    int dq = qrel - 64 * jb - 4 * hi; asm volatile("" : "+v"(dq)); const float NEG = -__builtin_inff();
#pragma unroll
    for (int r = 0; r < 16; ++r) { const int c = (r & 3) + 8 * (r >> 2); if (c > dq) p0[r] = NEG; if (c + 32 > dq) p1[r] = NEG; } }
__device__ __forceinline__ void block5(const BlockRef& cur, MLAS char* lds, int wid, int lane) {
    asm volatile("" : "+v"(lane));
    const int r32 = lane & 31, hi = lane >> 5;
    const int q0 = cur.P0, NT = (q0 + QB) / KVBLK;
    MLAS float* wsf = (MLAS float*)(lds + L5_WS) + wid * 64;
    unsigned kso[2];
#pragma unroll
    for (int i = 0; i < 2; ++i) { const int row = 4 * (2 * wid + i) + (lane >> 4), c = (lane & 15) ^ (row & 15), ce = c < 12 ? c : c - 4; kso[i] = (unsigned)(row * KS * 2 + ce * 16); }
    const unsigned vso = (unsigned)(((16 * (wid & 3) + (lane >> 2)) * VS + (wid >> 2) * 32 + (lane & 3) * 8) * 2);
    const MGAS char* Kb = (const MGAS char*)cur.K; const MGAS char* Vb = (const MGAS char*)cur.V;
    const unsigned ldsa = (unsigned)(__UINTPTR_TYPE__)lds;
#define GLDS16(base, off, la) do { unsigned sv_; asm volatile("s_mov_b32 %0, m0\n\ts_mov_b32 m0, %3\n\ts_nop 0\n\tglobal_load_lds_dwordx4 %1, %2\n\ts_mov_b32 m0, %0" : "=&s"(sv_) : "v"(off), "s"(base), "s"(la) : "memory"); } while (0)
#define DMA_K(t, slot) do { const MGAS char* kt_ = Kb + (size_t)(t) * (KVBLK * KS * 2); const unsigned la_ = (unsigned)__builtin_amdgcn_readfirstlane((int)(ldsa + L5_K + (slot) + (2 * wid) * 1024));  \
        GLDS16(kt_, kso[0], la_); GLDS16(kt_, kso[1], la_ + 1024u); } while (0)
#define DMA_V(t, slot) do { const MGAS char* vt_ = Vb + (size_t)(t) * (KVBLK * VS * 2); const unsigned la_ = (unsigned)__builtin_amdgcn_readfirstlane((int)(ldsa + L5_V + (slot) + wid * 1024));        \
        GLDS16(vt_, vso, la_); } while (0)
#define WAIT_BAR(N) asm volatile("s_waitcnt vmcnt(" #N ") lgkmcnt(0)\n\ts_barrier" ::: "memory")
#define SBAR() __builtin_amdgcn_sched_barrier(0)
#define PIN(x) asm volatile("" : "+v"(x))
#define MFMA(a, b, c) __builtin_amdgcn_mfma_f32_32x32x16_bf16(a, b, c, 0, 0, 0)
    int kofs[6];
#pragma unroll
    for (int d0 = 0; d0 < 6; ++d0) kofs[d0] = r32 * 256 + (((2 * d0 + hi) ^ (r32 & 15)) << 4);
    const lcp kb0 = (lcp)lds + L5_K;
    const lcp vp0 = (lcp)lds + L5_V + ((lane >> 4) & 1) * 32 + (lane & 3) * 8 + (4 * hi + ((lane & 15) >> 2)) * 64;
#define KLD(j, ks) kf[j] = *(const MLAS bf16x8*)(kb0 + (ks) + kofs[(j) >> 1] + ((j) & 1) * 8192)
    DMA_K(0, 0); DMA_V(0, 0); DMA_K(1, K5_SLOT);
    bf16x8 qr[6];
#pragma unroll
    for (int d0 = 0; d0 < 6; ++d0) qr[d0] = *(const MGAS bf16x8*)((const MGAS char*)cur.Q + (unsigned)(((wid * QBLK + r32) * QS + hi * 8) * 2) + d0 * 32);
    float mhat = 0.f, l_reg = 0.f; f32x16 o[2]; o[0] = f32x16{}; o[1] = f32x16{}; f32x16 negm;
    const int qrel = wid * QBLK + r32; bool resc = false;
    f32x16 pA0, pA1, pB0, pB1; bf16x8 kf[12]; s16x4 vlo[8], vhi[8]; u32x4 pw0, pw1, pw2, pw3;
    constexpr bool lag = false;
#define VSL(j) (((j) & 3) * V5_SLOT)
#define RESC() do { if (resc) { _Pragma("unroll") for (int d_ = 0; d_ < 2; ++d_) _Pragma("unroll") for (int r = 0; r < 16; ++r) o[d_][r] *= wsf[crow(r, hi)]; } } while (0)
    DMA_K(2, 2 * K5_SLOT);
    WAIT_BAR(5);
#pragma unroll
    for (int j = 0; j < 12; ++j) KLD(j, 0);
    pA0 = MFMA(kf[0], qr[0], f32x16{}); pA1 = MFMA(kf[1], qr[0], f32x16{});
#pragma unroll
    for (int d0 = 1; d0 < 6; ++d0) { pA0 = MFMA(kf[2 * d0], qr[d0], pA0); pA1 = MFMA(kf[2 * d0 + 1], qr[d0], pA1); }
    if (NT == 4) cmask5(pA0, pA1, 0, qrel, hi);
    { const float rm = rowmax5(pA0, pA1); mhat = rm;
#pragma unroll
      for (int r = 0; r < 16; ++r) { pA0[r] = __builtin_amdgcn_exp2f(pA0[r] - rm); pA1[r] = r < 4 ? __builtin_amdgcn_exp2f(pA1[r] - rm) : pA1[r] - rm; }
#pragma unroll
      for (int r = 0; r < 16; ++r) negm[r] = -mhat;
      PIN(negm); }
    WAIT_BAR(0);
    DMA_K(3, 3 * K5_SLOT); DMA_V(1, VSL(1));
    if (lag) { if (4 < NT) DMA_K(4, 0); DMA_V(2, VSL(2)); }
    KLD(0, K5_SLOT); KLD(1, K5_SLOT); KLD(2, K5_SLOT); KLD(3, K5_SLOT);
#define PKW(P, i) cvtpk5(P[i], P[i + 1])
#define PAF(k) __builtin_bit_cast(bf16x8, pw##k)
#define VFR(i) (bf16x8){vlo[i][0], vlo[i][1], vlo[i][2], vlo[i][3], vhi[i][0], vhi[i][1], vhi[i][2], vhi[i][3]}
#define VRD(i) do { vlo[i] = vtr5(vp_ + (((i) >> 2) * 4096 + ((i) & 3) * 1024)); vhi[i] = vtr5(vp_ + (((i) >> 2) * 4096 + ((i) & 3) * 1024 + 512)); } while (0)
#define EX(v) __builtin_amdgcn_exp2f(v)
#define GAPE(j, MF, P, i) do { KLD((j) + 4, ks_); SBAR(); MF; P[i] = EX(P[i]); P[(i) + 1] = EX(P[(i) + 1]); P[(i) + 2] = EX(P[(i) + 2]); PIN(P); SBAR(); } while (0)
#define GAPA(RD, MF, a0, a1, a2, a3, W0, W1, PW) do { RD; SBAR(); MF; sacc += a0; sacc += a1; sacc += a2; sacc += a3; W0; W1; PIN(PW); PIN(sacc); SBAR(); } while (0)
#define GAPB3(MF, X, i0, Y, i1, Z, i2) do { MF; X[i0] = EX(X[i0]); Y[i1] = EX(Y[i1]); Z[i2] = EX(Z[i2]); PIN(X); PIN(Z); SBAR(); } while (0)
#define GAPB4(MF, X, i) do { MF; X[i] = EX(X[i]); X[(i) + 1] = EX(X[(i) + 1]); X[(i) + 2] = EX(X[(i) + 2]); X[(i) + 3] = EX(X[(i) + 3]); PIN(X); SBAR(); } while (0)
#define KPRE(G, j) do { if (G) { KLD(j, kn_); } } while (0)
#define STEP(C0, C1, P0, P1, t, TS, MASK, GK, GV, GL, GK2, GV2) do { SBAR();                                                                                                                                                           \
    const int ks_ = ((TS) & 3) * K5_SLOT, kn_ = (((TS) + 1) & 3) * K5_SLOT; const lcp vp_ = vp0 + VSL((TS) + 3);                                                                  \
    GAPE(0, C0 = MFMA(kf[0], qr[0], negm), P1, 4);                                                                                                                        \
    GAPE(1, C1 = MFMA(kf[1], qr[0], negm), P1, 7);                                                                                                                        \
    GAPE(2, C0 = MFMA(kf[2], qr[1], C0),   P1, 10);                                                                                                                       \
    GAPE(3, C1 = MFMA(kf[3], qr[1], C1),   P1, 13);                                                                                                                       \
    float sacc = P0[0] + P0[1];                                                                                                                                           \
    GAPA(KLD(8, ks_),  C0 = MFMA(kf[4], qr[2], C0),  P0[2], P0[3], P0[4], P0[5],     pw0[0] = PKW(P0, 0),  pw0[1] = PKW(P0, 2),  pw0);                                     \
    GAPA(KLD(9, ks_),  C1 = MFMA(kf[5], qr[2], C1),  P0[6], P0[7], P0[8], P0[9],     pw0[2] = PKW(P0, 4),  pw0[3] = PKW(P0, 6),  pw0);                                     \
    GAPA(KLD(10, ks_), C0 = MFMA(kf[6], qr[3], C0),  P0[10], P0[11], P0[12], P0[13], pw1[0] = PKW(P0, 8),  pw1[1] = PKW(P0, 10), pw1);                                     \
    GAPA(KLD(11, ks_), C1 = MFMA(kf[7], qr[3], C1),  P0[14], P0[15], P1[0], P1[1],   pw1[2] = PKW(P0, 12), pw1[3] = PKW(P0, 14), pw1);                                     \
    GAPA((void)0,      C0 = MFMA(kf[8], qr[4], C0),  P1[2], P1[3], P1[4], P1[5],     pw2[0] = PKW(P1, 0),  pw2[1] = PKW(P1, 2),  pw2);                                     \
    GAPA((void)0,      C1 = MFMA(kf[9], qr[4], C1),  P1[6], P1[7], P1[8], P1[9],     pw2[2] = PKW(P1, 4),  pw2[3] = PKW(P1, 6),  pw2);                                     \
    GAPA(VRD(0),       C0 = MFMA(kf[10], qr[5], C0), P1[10], P1[11], P1[12], P1[13], pw3[0] = PKW(P1, 8),  pw3[1] = PKW(P1, 10), pw3);                                     \
    GAPA(VRD(4),       C1 = MFMA(kf[11], qr[5], C1), P1[14], P1[15], 0.f, 0.f,       pw3[2] = PKW(P1, 12), pw3[3] = PKW(P1, 14), pw3);                                     \
    l_reg += sacc;                                                                                                                                                        \
    if (!lag) { if (GK) DMA_K((t) + 3, (((TS) + 3) & 3) * K5_SLOT); if (GV) DMA_V((t) + 1, VSL((TS) + 1)); }                                          \
    else { ENDW(t); if (GK2) DMA_K((t) + 4, ((TS) & 3) * K5_SLOT); if (GV2) DMA_V((t) + 2, VSL((TS) + 2)); }                                           \
    VRD(1); VRD(5); SBAR();                                                                                                                                               \
    o[0] = MFMA(PAF(0), VFR(0), o[0]); o[1] = MFMA(PAF(0), VFR(4), o[1]);                                                     \
    if (MASK) cmask5(C0, C1, (t) - (NT - 4), qrel, hi);                                                                                                                   \
    { const float hm = halfmax5(C0, C1); resc = false;                                                                      \
      if (__builtin_expect(__any(hm > THR5), 0)) { const float rm = mergehalves5(hm); const float dl = __builtin_fmaxf(rm, 0.f); mhat += dl;     \
          _Pragma("unroll") for (int r = 0; r < 16; ++r) { C0[r] -= dl; C1[r] -= dl; }                                                                                    \
          _Pragma("unroll") for (int r = 0; r < 16; ++r) negm[r] = -mhat;                                                                                                 \
          PIN(negm);                                                                                                                                                      \
          const float f = __builtin_amdgcn_exp2f(-dl); l_reg *= f; if (hi == 0) wsf[r32] = f; resc = true; } }                                                            \
    SBAR();                                                                                                                                                               \
    VRD(2); KPRE(GL, 0); GAPB4(o[0] = MFMA(PAF(1), VFR(1), o[0]), C0, 0);                                                                                                 \
    VRD(6); KPRE(GL, 1); GAPB4(o[1] = MFMA(PAF(1), VFR(5), o[1]), C0, 4);                                                                                                 \
    VRD(3); KPRE(GL, 2); GAPB3(o[0] = MFMA(PAF(2), VFR(2), o[0]), C0, 8, C0, 9, C0, 10);                                                                                  \
    VRD(7); KPRE(GL, 3); GAPB3(o[1] = MFMA(PAF(2), VFR(6), o[1]), C0, 11, C0, 12, C0, 13);                                                                                \
    GAPB3(o[0] = MFMA(PAF(3), VFR(3), o[0]), C0, 14, C0, 15, C1, 0);                                                                                                      \
    GAPB3(o[1] = MFMA(PAF(3), VFR(7), o[1]), C1, 1, C1, 2, C1, 3);                                                                                                        \
    } while (0)
#define ENDW(tt) do { if ((tt) + 3 < NT) { WAIT_BAR(3); } else if ((tt) + 2 < NT) { WAIT_BAR(1); } else { WAIT_BAR(0); } } while (0)
#define ENDL(tt) do { if (!lag) ENDW(tt); } while (0)
    int t = 1;
    for (; t + 7 < NT; t += 4) {
        STEP(pB0, pB1, pA0, pA1, t,     1, false, true, true, true, true, true); ENDL(t);     RESC();
        STEP(pA0, pA1, pB0, pB1, t + 1, 2, false, true, true, true, true, true); ENDL(t + 1); RESC();
        STEP(pB0, pB1, pA0, pA1, t + 2, 3, false, true, true, true, true, true); ENDL(t + 2); RESC();
        STEP(pA0, pA1, pB0, pB1, t + 3, 0, false, true, true, true, true, true); ENDL(t + 3); RESC();
    }
    for (; t + 1 < NT; t += 2) {
        STEP(pB0, pB1, pA0, pA1, t, t, true, (t + 3 < NT), (t + 1 < NT), (t + 1 < NT), (t + 4 < NT), (t + 2 < NT));                 ENDL(t);     RESC();
        STEP(pA0, pA1, pB0, pB1, t + 1, t + 1, true, (t + 4 < NT), (t + 2 < NT), (t + 2 < NT), (t + 5 < NT), (t + 3 < NT));         ENDL(t + 1); RESC();
    }
    STEP(pB0, pB1, pA0, pA1, NT - 1, NT - 1, true, false, false, false, false, false); ENDL(NT - 1); RESC();
    {
#pragma unroll
      for (int r = 4; r < 16; ++r) pB1[r] = __builtin_amdgcn_exp2f(pB1[r]);
      float sacc = pB0[0] + pB0[1];
#pragma unroll
      for (int r = 2; r < 16; ++r) sacc += pB0[r];
#pragma unroll
      for (int r = 0; r < 16; ++r) sacc += pB1[r];
      l_reg += sacc;
      pw0 = (u32x4){PKW(pB0, 0), PKW(pB0, 2), PKW(pB0, 4), PKW(pB0, 6)}; pw1 = (u32x4){PKW(pB0, 8), PKW(pB0, 10), PKW(pB0, 12), PKW(pB0, 14)};
      pw2 = (u32x4){PKW(pB1, 0), PKW(pB1, 2), PKW(pB1, 4), PKW(pB1, 6)}; pw3 = (u32x4){PKW(pB1, 8), PKW(pB1, 10), PKW(pB1, 12), PKW(pB1, 14)};
      const lcp vp_ = vp0 + VSL(NT - 1);
      VRD(0); VRD(1); VRD(2); VRD(3); VRD(4); VRD(5); VRD(6); VRD(7);
      o[0] = MFMA(PAF(0), VFR(0), o[0]); o[1] = MFMA(PAF(0), VFR(4), o[1]); o[0] = MFMA(PAF(1), VFR(1), o[0]); o[1] = MFMA(PAF(1), VFR(5), o[1]);
      o[0] = MFMA(PAF(2), VFR(2), o[0]); o[1] = MFMA(PAF(2), VFR(6), o[1]); o[0] = MFMA(PAF(3), VFR(3), o[0]); o[1] = MFMA(PAF(3), VFR(7), o[1]); }
    { auto rr = __builtin_amdgcn_permlane32_swap(__float_as_uint(l_reg), __float_as_uint(l_reg), false, false); l_reg = __uint_as_float(rr[0]) + __uint_as_float(rr[1]); }
    if (hi == 0) wsf[32 + r32] = l_reg;
    MGAS bf16_t* Ow = cur.O + (size_t)(wid * QBLK) * OS; MLAS bf16_t* stg = (MLAS bf16_t*)(lds + L5_OST) + wid * 2048;
#pragma unroll
    for (int r = 0; r < 16; ++r) { const int orow = crow(r, hi); const float rl = __builtin_amdgcn_rcpf(wsf[32 + orow]);
#pragma unroll
        for (int d0 = 0; d0 < 2; ++d0) stg[orow * 64 + d0 * 32 + r32] = (bf16_t)cvtpk5(o[d0][r] * rl, 0.f); }
#pragma unroll
    for (int i = 0; i < 4; ++i) { const int row = i * 8 + (lane >> 3), ch = lane & 7; *(MGAS u32x4*)((MGAS char*)Ow + (unsigned)((row * OS + ch * 8) * 2)) = *(const MLAS u32x4*)(stg + row * 64 + ch * 8); }
    asm volatile("s_waitcnt lgkmcnt(0)\n\ts_barrier" ::: "memory");
#undef DMA_K
#undef DMA_V
#undef GLDS16
#undef WAIT_BAR
#undef SBAR
#undef PIN
#undef MFMA
#undef KLD
#undef VSL
#undef ENDL
#undef RESC
#undef PKW
#undef PAF
#undef VFR
#undef VRD
#undef GAPA
#undef GAPE
#undef GAPB3
#undef GAPB4
#undef EX
#undef GAPB
#undef KPRE
#undef STEP
#undef ENDW
}
__device__ __forceinline__ void mla_phase(MLAS char* lds, const bf16_t* QF_, const bf16_t* KF_, const bf16_t* VV_, bf16_t* ATT_, int bx, int nwg, int wid, int lane) {
    const MGAS bf16_t* QF = (const MGAS bf16_t*)QF_; const MGAS bf16_t* KF = (const MGAS bf16_t*)KF_; const MGAS bf16_t* VV = (const MGAS bf16_t*)VV_; MGAS bf16_t* ATT = (MGAS bf16_t*)ATT_;
    for (int item = bx; item < 256; item += nwg) { const int h = item & 7, x = item >> 3;
#pragma unroll 1
        for (int pass = 0; pass < 2; ++pass) { const int qb = pass ? 63 - x : x;
            BlockRef b{QF + (size_t)(qb * QB) * QS + h * 96, KF + h * 96, VV + h * 64, ATT + (size_t)(qb * QB) * OS + h * 64, qb * QB};
            block5(b, lds, wid, lane); }
        asm volatile("s_waitcnt vmcnt(0)" ::: "memory"); __syncthreads(); }
}
}

namespace dil {
#define DLAS __attribute__((address_space(3)))
#define DGAS __attribute__((address_space(1)))
typedef short bf16x8 __attribute__((ext_vector_type(8)));
typedef short s16x4 __attribute__((ext_vector_type(4)));
typedef float f32x16 __attribute__((ext_vector_type(16)));
typedef unsigned u32x4 __attribute__((ext_vector_type(4)));
constexpr int ITEM_LDS = 65536, K_OFF = 0, V_OFF = 32768, BIAS_OFF = 131072, WSF_OFF = 131072 + 2048;
constexpr int LDS_BYTES = WSF_OFF + 8 * 128;
constexpr float LOG2E = 1.4426950408889634f, LN2 = 0.6931471805599453f;
__device__ __forceinline__ int v_st(int k, int c) { const int kk = (k & ~0xC) | ((k & 4) << 1) | ((k & 8) >> 1); return ((kk >> 3) * 2 + (c >> 5)) * 512 + ((kk & 7) * 32 + (c & 31)) * 2; }
__device__ __forceinline__ int v_rd_base(int lane) { return ((lane & 3) << 3) | (((lane >> 2) & 3) << 6) | (((lane >> 4) & 1) << 5) | (((lane >> 5) & 1) << 8); }
__device__ __forceinline__ int crow(int r, int hi) { return (r & 3) + 8 * (r >> 2) + 4 * hi; }
__device__ __forceinline__ unsigned cvtpk(float lo, float hi) { unsigned r; asm volatile("v_cvt_pk_bf16_f32 %0, %1, %2" : "=v"(r) : "v"(lo), "v"(hi)); return r; }
__device__ __forceinline__ int t5b(int dist) { if (dist < 16) return dist; const int large = 16 + (int)(logf((float)dist / 16.f) / 4.852030263919617f * 16.f); return large < 31 ? large : 31; }
struct Item { int hd, r, ph, nbk; };
__device__ __forceinline__ Item decode(int id) { Item it; it.hd = id >> 7; const int blk = id & 127, g = it.hd >> 3; it.r = g == 0 ? 1 : (g == 1 ? 4 : 16);
    const int nblk = 128 / it.r; it.ph = blk / nblk; it.nbk = blk - it.ph * nblk; return it; }

__device__ __forceinline__ void dil_phase(DLAS char* lds, bf16_t* QD_, const bf16_t* KD_, const bf16_t* VD_, const float* rel_bias, float* LSE_, int pr0, int prstep, int prend, int wid, int lane) {
    DGAS bf16_t* QD = (DGAS bf16_t*)QD_; const DGAS bf16_t* KD = (const DGAS bf16_t*)KD_; const DGAS bf16_t* VD = (const DGAS bf16_t*)VD_; DGAS float* LSE = (DGAS float*)LSE_;
    const int tid = wid * 64 + lane, r32 = lane & 31, hi = lane >> 5, w4 = wid & 3, wi = wid >> 2;
    for (int pr = pr0; pr < prend; pr += prstep) {
        { bf16x8 kv[2][4], vv[2][4]; float bv[2];
#pragma unroll
          for (int ii = 0; ii < 2; ++ii) { const Item it = decode(2 * pr + ii);
#pragma unroll
            for (int c = 0; c < 4; ++c) { const int idx = c * 512 + tid, row = idx >> 3, ch = idx & 7; const int srow = (it.nbk - 1) * 128 + row;
                const size_t off = ((size_t)(srow * it.r + it.ph)) * 1536 + it.hd * 64 + ch * 8;
                if (srow >= 0) { kv[ii][c] = *(const DGAS bf16x8*)(KD + off); vv[ii][c] = *(const DGAS bf16x8*)(VD + off); } else { kv[ii][c] = bf16x8{}; vv[ii][c] = bf16x8{}; } }
            const int st = tid - 35;
            bv[ii] = (tid < 256 && st >= 0 && st <= 128) ? rel_bias[t5b(st * it.r) * 24 + it.hd] * LOG2E : -__builtin_inff(); }
#pragma unroll
          for (int ii = 0; ii < 2; ++ii) { DLAS char* Kl = lds + ii * ITEM_LDS + K_OFF; DLAS char* Vl = lds + ii * ITEM_LDS + V_OFF;
#pragma unroll
            for (int c = 0; c < 4; ++c) { const int idx = c * 512 + tid, row = idx >> 3, ch = idx & 7;
                *(DLAS bf16x8*)(Kl + row * 128 + ((ch ^ ((row >> 1) & 7)) * 16)) = kv[ii][c];
                *(DLAS bf16x8*)(Vl + v_st(row, ch * 8)) = vv[ii][c]; }
            if (tid < 256) ((DLAS float*)(lds + BIAS_OFF + ii * 1024))[tid] = bv[ii]; } }
        __syncthreads();
        { const Item it = decode(2 * pr + wi);
            const DLAS char* Kl = lds + wi * ITEM_LDS + K_OFF; const DLAS float* bias = (const DLAS float*)(lds + BIAS_OFF + wi * 1024);
            DLAS float* wsf = (DLAS float*)(lds + WSF_OFF + wid * 128);
            const int qtok = ((it.nbk * 128 + 32 * w4 + r32) * it.r + it.ph);
            bf16x8 qr[4];
#pragma unroll
            for (int d0 = 0; d0 < 4; ++d0) qr[d0] = *(const DGAS bf16x8*)(QD + (size_t)qtok * 1536 + it.hd * 64 + d0 * 16 + hi * 8);
            f32x16 p[5];
            const DLAS char* kb[4];
#pragma unroll
            for (int d0 = 0; d0 < 4; ++d0) kb[d0] = Kl + (32 * w4 + r32) * 128 + (((2 * d0 + hi) ^ ((r32 >> 1) & 7)) * 16);
#pragma unroll
            for (int b = 0; b < 5; ++b) { p[b] = f32x16{};
#pragma unroll
                for (int d0 = 0; d0 < 4; ++d0) p[b] = __builtin_amdgcn_mfma_f32_32x32x16_bf16(*(const DLAS bf16x8*)(kb[d0] + b * 4096), qr[d0], p[b], 0, 0, 0); }
            { const DLAS char* tb = (const DLAS char*)bias + 4 * (4 + r32 - 4 * hi);
#pragma unroll
              for (int b = 0; b < 5; ++b)
#pragma unroll
                for (int r = 0; r < 16; ++r) { const int c = 32 * b + (r & 3) + 8 * (r >> 2); p[b][r] = fmaf(p[b][r], 0.125f * LOG2E, *(const DLAS float*)(tb + 4 * (159 - c))); } }
            if (it.nbk == 0) {
                int lim = 128 - 32 * w4 - 4 * hi; asm volatile("" : "+v"(lim));
#pragma unroll
                for (int b = 0; b < 4; ++b)
#pragma unroll
                    for (int r = 0; r < 16; ++r) { const int c = 32 * b + (r & 3) + 8 * (r >> 2); if (c < lim) p[b][r] = -__builtin_inff(); } }
            float mx;
            { float m0 = fmaxf(fmaxf(p[0][0], p[0][1]), p[0][2]), m1 = fmaxf(fmaxf(p[0][3], p[0][4]), p[0][5]);
#pragma unroll
              for (int r = 6; r < 16; r += 2) { if ((r >> 1) & 1) m0 = fmaxf(fmaxf(m0, p[0][r]), p[0][r + 1]); else m1 = fmaxf(fmaxf(m1, p[0][r]), p[0][r + 1]); }
#pragma unroll
              for (int b = 1; b < 5; ++b)
#pragma unroll
                for (int r = 0; r < 16; r += 4) { m0 = fmaxf(fmaxf(m0, p[b][r]), p[b][r + 1]); m1 = fmaxf(fmaxf(m1, p[b][r + 2]), p[b][r + 3]); }
              mx = fmaxf(m0, m1); }
            { auto rr = __builtin_amdgcn_permlane32_swap(__float_as_uint(mx), __float_as_uint(mx), false, false); mx = fmaxf(__uint_as_float(rr[0]), __uint_as_float(rr[1])); }
            float den = 0.f;
#pragma unroll
            for (int b = 0; b < 5; ++b)
#pragma unroll
                for (int r = 0; r < 16; ++r) { const float e = __builtin_amdgcn_exp2f(p[b][r] - mx); p[b][r] = e; den += e; }
            { auto rr = __builtin_amdgcn_permlane32_swap(__float_as_uint(den), __float_as_uint(den), false, false); den = __uint_as_float(rr[0]) + __uint_as_float(rr[1]); }
            if (hi == 0) { wsf[r32] = __builtin_amdgcn_rcpf(den); LSE[(size_t)qtok * 24 + it.hd] = mx * LN2 + __logf(den); }
            bf16x8 pa[5][2];
#define DIL_PK4(P, B_, OUT) do { unsigned a0 = cvtpk(P[B_+0], P[B_+1]), a1 = cvtpk(P[B_+2], P[B_+3]);                          \
        unsigned b0 = cvtpk(P[B_+4], P[B_+5]), b1 = cvtpk(P[B_+6], P[B_+7]);                                             \
        auto r0 = __builtin_amdgcn_permlane32_swap(a0, b0, false, false); auto r1 = __builtin_amdgcn_permlane32_swap(a1, b1, false, false); \
        u32x4 w_ = {r0[0], r1[0], r0[1], r1[1]}; OUT = *reinterpret_cast<bf16x8*>(&w_); } while (0)
#pragma unroll
            for (int b = 0; b < 5; ++b) { DIL_PK4(p[b], 0, pa[b][0]); DIL_PK4(p[b], 8, pa[b][1]); }
#undef DIL_PK4
            f32x16 o[2] = {};
            const int vb0 = (int)(unsigned)(__UINTPTR_TYPE__)(lds + wi * ITEM_LDS + V_OFF) + v_rd_base(lane) + 4 * w4 * 1024;
#define DIL_TRRD(dst, off) asm volatile("ds_read_b64_tr_b16 %0, %1 offset:%2" : "=&v"(dst) : "v"(vb0), "i"(off) : "memory")
#define DIL_PV(b, d0) do { s16x4 l0, h0, l1, h1; constexpr int o_ = (4 * (b)) * 1024 + (d0) * 512;                                         \
        DIL_TRRD(l0, o_); DIL_TRRD(h0, o_ + 1024); DIL_TRRD(l1, o_ + 2048); DIL_TRRD(h1, o_ + 3072);                                        \
        asm volatile("s_waitcnt lgkmcnt(0)" ::: "memory"); __builtin_amdgcn_sched_barrier(0);                                               \
        o[d0] = __builtin_amdgcn_mfma_f32_32x32x16_bf16(pa[b][0], (bf16x8){l0[0], l0[1], l0[2], l0[3], h0[0], h0[1], h0[2], h0[3]}, o[d0], 0, 0, 0);   \
        o[d0] = __builtin_amdgcn_mfma_f32_32x32x16_bf16(pa[b][1], (bf16x8){l1[0], l1[1], l1[2], l1[3], h1[0], h1[1], h1[2], h1[3]}, o[d0], 0, 0, 0); } while (0)
            DIL_PV(0, 0); DIL_PV(0, 1); DIL_PV(1, 0); DIL_PV(1, 1); DIL_PV(2, 0); DIL_PV(2, 1); DIL_PV(3, 0); DIL_PV(3, 1); DIL_PV(4, 0); DIL_PV(4, 1);
#undef DIL_PV
#undef DIL_TRRD
            asm volatile("s_waitcnt lgkmcnt(0)" ::: "memory");
            __syncthreads();
            { DLAS bf16_t* stg = (DLAS bf16_t*)(lds + wi * ITEM_LDS + K_OFF + w4 * 4096);
#pragma unroll
              for (int r = 0; r < 16; ++r) { const int orow = crow(r, hi); const float rd = wsf[orow];
#pragma unroll
                  for (int d0 = 0; d0 < 2; ++d0) stg[orow * 64 + d0 * 32 + r32] = (bf16_t)cvtpk(o[d0][r] * rd, 0.f); }
              asm volatile("s_waitcnt lgkmcnt(0)" ::: "memory");
#pragma unroll
              for (int i = 0; i < 4; ++i) { const int row = i * 8 + (lane >> 3), ch = lane & 7; const int otok = (it.nbk * 128 + 32 * w4 + row) * it.r + it.ph;
                  *(DGAS u32x4*)(QD + (size_t)otok * 1536 + it.hd * 64 + ch * 8) = *(const DLAS u32x4*)(stg + row * 64 + ch * 8); } }
        }
        __syncthreads();
    }
}
}

#define LAS __attribute__((address_space(3)))
constexpr size_t MiB = 1u << 20;
constexpr int NWAVES = 8, MK_LDS_BYTES = 147456;
constexpr size_t WS_CTL = 0, WS_R0 = 1 * MiB, WS_CS = 2 * MiB, WS_SN = 3 * MiB, WS_SSQ1 = 4 * MiB, WS_SSQ2 = 5 * MiB, WS_SSQL = 6 * MiB, WS_LSE = 8 * MiB;
constexpr size_t WS_WGU = 10 * MiB, WS_WD = 21 * MiB, WS_WIN = 27 * MiB, WS_WG = 38 * MiB, WS_WUQ = 42 * MiB, WS_WUKV = 43 * MiB, WS_WBA = 44 * MiB, WS_WBD = 45 * MiB, WS_WO = 46 * MiB;
constexpr size_t WS_XB = 48 * MiB, WS_ACT = 80 * MiB;
constexpr size_t WS_H = 80 * MiB, WS_QD = 80 * MiB, WS_KD = 128 * MiB, WS_VD = 176 * MiB, WS_LAT = 224 * MiB;
constexpr size_t WS_G = 80 * MiB, WS_QF = 144 * MiB, WS_KF = 168 * MiB, WS_VV = 192 * MiB, WS_DIL = 208 * MiB, WS_ATT = 224 * MiB, WS_MG = 176 * MiB;
constexpr size_t WS_CQN = 80 * MiB, WS_CKVN = 92 * MiB;

struct MkArgs { const float* in[22]; float* out; unsigned char* ws; int ph_lo, ph_hi; };

__device__ __forceinline__ unsigned mk_pk2(float lo, float hi) { return (unsigned)f2bf(lo) | ((unsigned)f2bf(hi) << 16); }
__device__ __forceinline__ void conv_item(const float* W, int ldw, int col0, int k0, int K, bf16_t* WT, int dstrow0, const float* gain, LAS float* scr, int lane) {
    pg8::f32x4 wv[8];
#pragma unroll
    for (int i = 0; i < 8; ++i) { const int kk = 8 * i + (lane >> 3); wv[i] = *(const pg8::f32x4*)(W + (size_t)(k0 + kk) * ldw + col0 + (lane & 7) * 4); }
    const float gl = gain ? gain[k0 + lane] : 1.f;
#pragma unroll
    for (int i = 0; i < 8; ++i) { const int kk = 8 * i + (lane >> 3); const float gk = __shfl(gl, kk); LAS float* d = scr + kk * 33 + (lane & 7) * 4;
        d[0] = wv[i][0] * gk; d[1] = wv[i][1] * gk; d[2] = wv[i][2] * gk; d[3] = wv[i][3] * gk; }
    asm volatile("s_waitcnt lgkmcnt(0)" ::: "memory");
    const int c = lane & 7;
#pragma unroll
    for (int j = 0; j < 4; ++j) { const int n = (lane >> 3) + 8 * j; const LAS float* s = scr + (8 * c) * 33 + n;
        pg8::u32x4 o; o.x = pg8::cvt_pk_bf16(s[0 * 33], s[1 * 33]); o.y = pg8::cvt_pk_bf16(s[2 * 33], s[3 * 33]); o.z = pg8::cvt_pk_bf16(s[4 * 33], s[5 * 33]); o.w = pg8::cvt_pk_bf16(s[6 * 33], s[7 * 33]);
        *(pg8::u32x4*)(WT + (size_t)(dstrow0 + n) * K + k0 + 8 * c) = o; }
    asm volatile("s_waitcnt lgkmcnt(0)" ::: "memory");
}
struct ConvSeg { const float* src; const float* src2; const float* gain; bf16_t* dst; int ldw, col0, K, row0, nblk, kind; };
typedef const __attribute__((address_space(4))) MkArgs* KArgP;
__device__ __forceinline__ KArgP kargs() { KArgP p = (KArgP)__builtin_amdgcn_kernarg_segment_ptr(); asm volatile("" : "+s"(p)); return p; }
__device__ __forceinline__ ConvSeg conv_seg(KArgP ap, int si) {
    unsigned char* ws = ap->ws;
    bf16_t* W_GU = (bf16_t*)(ws + WS_WGU); bf16_t* W_D = (bf16_t*)(ws + WS_WD); bf16_t* W_IN = (bf16_t*)(ws + WS_WIN); bf16_t* W_G = (bf16_t*)(ws + WS_WG);
    bf16_t* W_UQ = (bf16_t*)(ws + WS_WUQ); bf16_t* W_UKV = (bf16_t*)(ws + WS_WUKV); bf16_t* W_BA = (bf16_t*)(ws + WS_WBA); bf16_t* W_BD = (bf16_t*)(ws + WS_WBD); bf16_t* W_O = (bf16_t*)(ws + WS_WO);
    switch (si) {
    case 0: return ConvSeg{ap->in[5], ap->in[6], ap->in[4], W_GU, DFF, 0, 1024, 0, 176, 1};
    case 1: return ConvSeg{ap->in[7], nullptr, nullptr, W_D, 1024, 0, DFF, 0, 32, 0};
    case 2: return ConvSeg{ap->in[9], nullptr, ap->in[8], W_IN, DIN, 0, 1024, 4608, 21, 0};
    case 3: return ConvSeg{nullptr, nullptr, nullptr, W_IN, 0, 0, 1024, 5280, 3, 2};
    case 4: return ConvSeg{ap->in[9], nullptr, ap->in[8], W_IN, DIN, 672, 1024, 0, 144, 0};
    case 5: return ConvSeg{ap->in[9], nullptr, ap->in[8], W_G, DIN, 5280, 1024, 0, 64, 0};
    case 6: return ConvSeg{ap->in[12], nullptr, ap->in[11], W_UQ, 768, 0, QLORA, 0, 24, 0};
    case 7: return ConvSeg{ap->in[14], nullptr, ap->in[13], W_UKV, 1024, 0, KVLORA, 0, 32, 0};
    case 8: return ConvSeg{ap->in[15], nullptr, nullptr, W_BA, 1024, 0, 512, 0, 32, 0};
    case 9: return ConvSeg{ap->in[16], nullptr, nullptr, W_BD, 1024, 0, 512, 0, 32, 0};
    case 10: return ConvSeg{ap->in[17], nullptr, nullptr, W_O, 1024, 0, 1024, 0, 32, 0};
    case 11: return ConvSeg{ap->in[19], ap->in[20], ap->in[18], W_GU, DFF, 0, 1024, 0, 176, 1};
    default: return ConvSeg{ap->in[21], nullptr, nullptr, W_D, 1024, 0, DFF, 0, 32, 0};
    }
}
__device__ __forceinline__ void conv_run(KArgP a, int s0, int s1, LAS float* scr, int gw, int ngw, int lane) {
    int base = 0;
    for (int si = s0; si < s1; ++si) { const ConvSeg sg = conv_seg(a, si); const int kt = sg.K / 64, nit = sg.nblk * kt;
        int it = gw - (base % ngw); if (it < 0) it += ngw;
        for (; it < nit; it += ngw) { const int b = it / kt, k0 = (it - b * kt) * 64;
            if (sg.kind == 2) { const int c = lane & 7;
#pragma unroll
                for (int j = 0; j < 4; ++j) { const int n = (lane >> 3) + 8 * j; *(pg8::u32x4*)(sg.dst + (size_t)(sg.row0 + 32 * b + n) * sg.K + k0 + 8 * c) = (pg8::u32x4){0u, 0u, 0u, 0u}; } }
            else if (sg.kind == 1) { const int tile = b >> 3, sub = b & 7; conv_item(sub < 4 ? sg.src : sg.src2, sg.ldw, tile * 128 + (sub & 3) * 32, k0, sg.K, sg.dst, sg.row0 + 32 * b, sg.gain, scr, lane); }
            else conv_item(sg.src, sg.ldw, sg.col0 + 32 * b, k0, sg.K, sg.dst, sg.row0 + 32 * b, sg.gain, scr, lane); }
        base += nit; }
}
__device__ __forceinline__ void xb_row(const float* xrow, bf16_t* orow, float* r0, int lane) {
    pg8::f32x4 v[4]; float s = 0.f;
#pragma unroll
    for (int j = 0; j < 4; ++j) { v[j] = *((const pg8::f32x4*)xrow + lane + 64 * j); s += pg8::dot4(v[j]); }
    s = wave_sum(s);
#pragma unroll
    for (int j = 0; j < 4; ++j) { pg8::u32x2 w; w.x = mk_pk2(v[j][0], v[j][1]); w.y = mk_pk2(v[j][2], v[j][3]); *((pg8::u32x2*)orow + lane + 64 * j) = w; }
    if (lane == 0) *r0 = rsqrtf(s * (1.f / 1024.f) + EPS);
}

struct MkConst { InvFreq ifr; };

#define XB_TMO      128
#define XB_XCNT(j)  (256  + 64 * (j))
#define XB_XSUB(j)  (1280 + 64 * (j))
#define XB_XGEN(j)  (2304 + 64 * (j))
#define XB_TOP      3328
#define XB_TOPGEN   3392
#define XCD_BAR_WORDS 3456
#define XB_SPIN_CAP (1u << 18)

__device__ __forceinline__ unsigned xb_ld(unsigned* p)              { return __hip_atomic_load(p, __ATOMIC_RELAXED, __HIP_MEMORY_SCOPE_AGENT); }
__device__ __forceinline__ unsigned xb_add(unsigned* p, unsigned v) { return __hip_atomic_fetch_add(p, v, __ATOMIC_RELAXED, __HIP_MEMORY_SCOPE_AGENT); }
__device__ __forceinline__ unsigned xb_xcc_id() { return (unsigned)__builtin_amdgcn_s_getreg((3 << 11) | 20) & 0xFu; }
#define XB_SPIN(cond, bar) do { unsigned _sp = 0; while (cond) { __builtin_amdgcn_s_sleep(1); \
    if ((++_sp & 255u) == 0u) { if (xb_ld(&(bar)[XB_TMO])) break; if (_sp > XB_SPIN_CAP) { atomicAdd(&(bar)[XB_TMO], 1u); break; } } } } while (0)

struct XcdBarrier {
    unsigned* bar; unsigned x;
    volatile LAS unsigned* st;
};

__device__ __forceinline__ XcdBarrier xcd_barrier_post(unsigned* bar, volatile LAS unsigned* st, bool leader) {
    XcdBarrier b; b.bar = bar; b.x = xb_xcc_id(); b.st = st;
    if (leader) (void)xb_add(&bar[XB_XCNT(b.x)], 1u);
    return b;
}
__device__ __forceinline__ void xcd_barrier_complete(unsigned* bar, unsigned x, unsigned& nloc, unsigned& nx) {
    const unsigned G = gridDim.x * gridDim.y * gridDim.z;
    unsigned sum, cnt, mine, sp = 0u;
    for (;;) {
        sum = 0u; cnt = 0u; mine = 0u;
#pragma unroll
        for (unsigned j = 0; j < 16; ++j) { const unsigned c = xb_ld(&bar[XB_XCNT(j)]); sum += c; cnt += (c > 0u) ? 1u : 0u; mine = (j == x) ? c : mine; }
        if (sum == G) break;
        __builtin_amdgcn_s_sleep(1);
        if ((++sp & 255u) == 0u) { if (xb_ld(&bar[XB_TMO])) break; if (sp > XB_SPIN_CAP) { atomicAdd(&bar[XB_TMO], 1u); break; } }
    }
    nloc = mine > 0u ? mine : 1u; nx = cnt > 0u ? cnt : 1u;
}

__device__ __forceinline__ void xcd_barrier(const XcdBarrier& b, bool leader) {
    asm volatile("s_waitcnt vmcnt(0)" ::: "memory");
    __syncthreads();
    if (leader) {
        unsigned* bar = b.bar;
        __builtin_amdgcn_s_waitcnt(0);
        unsigned nloc = b.st[0], nx = b.st[1];
        if (nloc == 0u) { xcd_barrier_complete(bar, b.x, nloc, nx); b.st[0] = nloc; b.st[1] = nx; }
        const unsigned old = xb_add(&bar[XB_XSUB(b.x)], 1u);
        const unsigned gen = old / nloc;
        if (old + 1u == (gen + 1u) * nloc) {
            __builtin_amdgcn_fence(__ATOMIC_RELEASE, "agent");
            asm volatile("s_waitcnt vmcnt(0)" ::: "memory");
            const unsigned og = xb_add(&bar[XB_TOP], 1u);
            const unsigned tg = og / nx;
            if (og + 1u == (tg + 1u) * nx) xb_add(&bar[XB_TOPGEN], 1u);
            else XB_SPIN(xb_ld(&bar[XB_TOPGEN]) == tg, bar);
            __builtin_amdgcn_fence(__ATOMIC_ACQUIRE, "agent");
            xb_add(&bar[XB_XGEN(b.x)], 1u);
            asm volatile("s_waitcnt vmcnt(0)" ::: "memory");
        } else {
            XB_SPIN(xb_ld(&bar[XB_XGEN(b.x)]) == gen, bar);
            __builtin_amdgcn_fence(__ATOMIC_ACQUIRE, "agent");
            asm volatile("s_waitcnt vmcnt(0)" ::: "memory");
        }
    }
    __syncthreads();
}

#define XB_LSUB(j)  (3456 + 64 * (j))
#define XB_LGEN(j)  (3968 + 64 * (j))
#define XB_MISM     4480
__device__ __forceinline__ void xcd_local_barrier(const XcdBarrier& b, int g, unsigned ngrp, bool leader) {
    asm volatile("s_waitcnt vmcnt(0)" ::: "memory");
    __syncthreads();
    if (leader) {
        unsigned* bar = b.bar;
        __builtin_amdgcn_s_waitcnt(0);
        const unsigned old = xb_add(&bar[XB_LSUB(g)], 1u);
        const unsigned gen = old / ngrp;
        if (old + 1u == (gen + 1u) * ngrp) xb_add(&bar[XB_LGEN(g)], 1u);
        else XB_SPIN(xb_ld(&bar[XB_LGEN(g)]) == gen, bar);
        __builtin_amdgcn_fence(__ATOMIC_ACQUIRE, "agent");
        asm volatile("s_waitcnt vmcnt(0)" ::: "memory");
    }
    __syncthreads();
}

__device__ __forceinline__ unsigned char* opq(unsigned char* p) { asm volatile("" : "+s"(p)); return p; }
#define WP(T, off) ((T*)(w + (off)))
constexpr int RS_TAB_OFF = 131072;
#define RT_PTR ((const LAS float*)(L + RS_TAB_OFF))
template <int N4>
__device__ __forceinline__ void rs_fill_t(LAS unsigned char* L, const float* slots_, int stride, int first, float inv_n, float mul, int group, int wave, int ln) {
    LAS float* tab = (LAS float*)(L + RS_TAB_OFF); const __attribute__((address_space(1))) float* slots = (const __attribute__((address_space(1))) float*)slots_;
    pg8::f32x4 v[4][N4];
#pragma unroll
    for (int j = 0; j < 4; ++j) { const __attribute__((address_space(1))) float* p = slots + (size_t)(group * 2048 + j * 512 + wave * 64 + ln) * stride + first;
#pragma unroll
        for (int k = 0; k < N4; ++k) v[j][k] = *(const __attribute__((address_space(1))) pg8::f32x4*)(p + 4 * k); }
#pragma unroll
    for (int j = 0; j < 4; ++j) { float sacc = 0.f;
#pragma unroll
        for (int k = 0; k < N4; ++k) sacc += (v[j][k][0] + v[j][k][1]) + (v[j][k][2] + v[j][k][3]);
        tab[j * 512 + wave * 64 + ln] = rsqrtf(sacc * inv_n + 1e-6f) * mul; }
    __syncthreads();
}
__device__ __forceinline__ void rs_fill(LAS unsigned char* L, const float* slots, int stride, int first, int n4, float inv_n, float mul, int group, int wave, int ln) {
    if (n4 == 4) rs_fill_t<4>(L, slots, stride, first, inv_n, mul, group, wave, ln); else if (n4 == 3) rs_fill_t<3>(L, slots, stride, first, inv_n, mul, group, wave, ln); else rs_fill_t<2>(L, slots, stride, first, inv_n, mul, group, wave, ln);
}
__global__ void __launch_bounds__(NWAVES * 64, 2) mk_fwd(MkArgs args_in_kernarg, InvFreq ifr) {
#define args (*kargs())
    extern __shared__ __attribute__((aligned(16))) unsigned char lds[];
    LAS unsigned char* L = (LAS unsigned char*)lds;
    const int wave = __builtin_amdgcn_readfirstlane((int)threadIdx.x >> 6);
#define lane ((int)__builtin_amdgcn_mbcnt_hi(~0u, __builtin_amdgcn_mbcnt_lo(~0u, 0u)))
#define tid (wave * 64 + lane)
    const int G = gridDim.x, bx = blockIdx.x, vcu = (G % 8 == 0) ? (bx % 8) * (G / 8) + bx / 8 : bx;
    const int gw = vcu * NWAVES + wave, ngw = G * NWAVES;
    const int lo = args.ph_lo, hi = args.ph_hi;
#define IN(k) (lo <= (k) && (k) < hi)
    volatile LAS unsigned* bst = (volatile LAS unsigned*)(L + MK_LDS_BYTES - 64);
    const bool leader = (wave == 0) && (lane == 0);
    XcdBarrier bar; bar.bar = (unsigned*)(args.ws + WS_CTL) + 4096; bar.x = 0; bar.st = bst;
    if (hi - lo > 1) { if (leader) { bst[0] = 0u; bst[1] = 0u; } __syncthreads(); bar = xcd_barrier_post((unsigned*)(args.ws + WS_CTL) + 4096, bst, leader); }
#define SEAM(k) do { if (IN(k) && IN((k) + 1)) xcd_barrier(bar, leader); } while (0)
#define SEAML(k) do { if (IN(k) && IN((k) + 1)) { if (bst[2] != 0u) xcd_local_barrier(bar, bx & 7, (unsigned)(G >> 3), leader); else xcd_barrier(bar, leader); } } while (0)
    if (leader) { bst[2] = 0u; if (hi - lo > 1 && lo == 0 && bar.x != (unsigned)(bx & 7)) (void)xb_add(&bar.bar[XB_MISM], 1u); }

    if (IN(0)) { unsigned char* w = opq(args.ws); LAS float* scr = (LAS float*)(L + wave * 16384);
        conv_run(kargs(), 0, (G == 256) ? 1 : 11, scr, gw, ngw, lane);
        const float* x = args.in[0]; const int* pos = (const int*)args.in[1];
#pragma unroll 4
        for (int m = gw; m < S; m += ngw) xb_row(x + (size_t)m * DM, WP(bf16_t, WS_XB) + (size_t)m * DM, WP(float, WS_R0) + m, lane);
        float* CS = WP(float, WS_CS); float* SN = WP(float, WS_SN);
        for (int idx = (vcu * NWAVES * 64) + tid; idx < S * 16; idx += G * NWAVES * 64) { const float ang = (float)pos[idx >> 4] * ifr.f[idx & 15]; float c, s; sincos_acc(ang, c, s); CS[idx] = c; SN[idx] = s; }
        __syncthreads();
    }
    SEAM(0);
    if (IN(0) && IN(1)) { if (leader) bst[2] = (G == 256 && xb_ld(&bar.bar[XB_MISM]) == 0u) ? 1u : 0u; __syncthreads(); }
    if (IN(1)) { unsigned char* w = opq(args.ws); pg8::Gemm g{WP(bf16_t, WS_XB), WP(bf16_t, WS_WGU), S, 2 * DFF, DM, DM}; pg8::StaticOrder so; so.init(S, 2 * DFF, G, bx);
        pg8::EpiSwiglu E{WP(bf16_t, WS_H), WP(float, WS_R0), 0, RT_PTR}; pg8::gemm_phase<pg8::EpiSwiglu, pg8::StaticOrder, true, true>(L, g, so, E, wave);
        if (G == 256 && bx >= 128) { LAS float* scr = (LAS float*)(L + wave * 16384); conv_run(kargs(), 1, 11, scr, (bx - 128) * NWAVES + wave, 128 * NWAVES, lane); __syncthreads(); } }
    SEAM(1);
    if (IN(2)) { unsigned char* w = opq(args.ws); pg8::Gemm g{WP(bf16_t, WS_H), WP(bf16_t, WS_WD), S, DM, DFF, DFF}; pg8::StaticOrder so; so.init(S, DM, G, bx);
        pg8::EpiResid<true> E{nullptr, WP(bf16_t, WS_XB), WP(float, WS_SSQ1), 0.5f, 0.f}; pg8::gemm_phase<pg8::EpiResid<true>, pg8::StaticOrder, true, true>(L, g, so, E, wave); }
    SEAM(2);
    if (IN(3)) { unsigned char* w = opq(args.ws); pg8::Gemm g{WP(bf16_t, WS_XB), WP(bf16_t, WS_WIN), S, 5120, DM, DM}; pg8::StaticOrder so; so.init(S, 5120, G, bx);
        rs_fill(L, WP(const float, WS_SSQ1), 16, 0, 4, 1.f / 1024.f, 1.f, bx & 7, wave, lane); pg8::EpiProj E{WP(bf16_t, WS_LAT), WP(bf16_t, WS_QD), RT_PTR, WP(float, WS_SSQL), 0, 0}; pg8::gemm_phase<pg8::EpiProj, pg8::StaticOrder, true, true>(L, g, so, E, wave); }
    SEAM(3);
    if (IN(4)) {
        { unsigned char* w = opq(args.ws); pg8::Gemm g{WP(bf16_t, WS_XB), WP(bf16_t, WS_WIN) + (size_t)5120 * DM, S, 256, DM, DM}; pg8::StaticOrder so; so.init(S, 256, G, bx);
          rs_fill(L, WP(const float, WS_SSQ1), 16, 0, 4, 1.f / 1024.f, 1.f, bx & 7, wave, lane); pg8::EpiProj E{WP(bf16_t, WS_LAT), WP(bf16_t, WS_QD), RT_PTR, WP(float, WS_SSQL), 20, 0}; pg8::gemm_phase<pg8::EpiProj, pg8::StaticOrder, true, true>(L, g, so, E, wave); }
        unsigned char* w = opq(args.ws); const bool split = (G == 256); const int p0 = !split ? bx : (bx < 64 ? 1344 + bx : bx - 64), pst = !split ? G : (bx < 64 ? 64 : 192), pend = !split ? 1536 : (bx < 64 ? 1536 : 1344);
        dil::dil_phase((__attribute__((address_space(3))) char*)L, WP(bf16_t, WS_QD), WP(const bf16_t, WS_KD), WP(const bf16_t, WS_VD), args.in[2], WP(float, WS_LSE), p0, pst, pend, wave, lane); }
    SEAM(4);
    if (IN(5)) { unsigned char* w = opq(args.ws); LAS float* scr = (LAS float*)(L + wave * 16384);
        conv_run(kargs(), 11, 13, scr, gw, ngw, lane);
        const bf16_t* DO = WP(const bf16_t, WS_QD); const float* LSE = WP(const float, WS_LSE); const bf16_t* LAT = WP(const bf16_t, WS_LAT);
        const float* CS = WP(const float, WS_CS); const float* SN = WP(const float, WS_SN);
        bf16_t* KF = WP(bf16_t, WS_KF); bf16_t* DIL = WP(bf16_t, WS_DIL);
#pragma unroll 4
        for (int row = gw; row < S; row += ngw) {
            { const int j = lane >> 3, d0 = (lane & 7) * 8; const float* lp = LSE + (size_t)row * 24 + j;
              const float l0 = lp[0], l1 = lp[8], l2 = lp[16]; const float mx = fmaxf(l0, fmaxf(l1, l2));
              const float e0 = __expf(l0 - mx), e1 = __expf(l1 - mx), e2 = __expf(l2 - mx), inv = 1.f / (e0 + e1 + e2);
              const bf16_t* dp = DO + (size_t)row * 1536 + j * 64 + d0;
              const pg8::u32x4 a = *(const pg8::u32x4*)dp, b = *(const pg8::u32x4*)(dp + 512), c = *(const pg8::u32x4*)(dp + 1024);
              const float w0 = e0 * inv, w1 = e1 * inv, w2 = e2 * inv;
              const pg8::f32x4 o0 = pg8::bf4_lo((pg8::u32x2){a.x, a.y}) * w0 + pg8::bf4_lo((pg8::u32x2){b.x, b.y}) * w1 + pg8::bf4_lo((pg8::u32x2){c.x, c.y}) * w2;
              const pg8::f32x4 o1 = pg8::bf4_lo((pg8::u32x2){a.z, a.w}) * w0 + pg8::bf4_lo((pg8::u32x2){b.z, b.w}) * w1 + pg8::bf4_lo((pg8::u32x2){c.z, c.w}) * w2;
              *(pg8::u32x4*)(DIL + (size_t)row * 512 + j * 64 + d0) = pg8::pack8bf(o0, o1); }
            { const int h = lane >> 3, ii = (lane & 7) * 2; const bf16_t* lp = LAT + (size_t)row * 768 + 640;
              const unsigned xa = *(const unsigned*)(lp + ii), xb2 = *(const unsigned*)(lp + 16 + ii);
              const float x10 = __uint_as_float(xa << 16), x11 = __uint_as_float(xa & 0xffff0000u), x20 = __uint_as_float(xb2 << 16), x21 = __uint_as_float(xb2 & 0xffff0000u);
              const float c0 = CS[(size_t)row * 16 + ii], c1 = CS[(size_t)row * 16 + ii + 1], s0 = SN[(size_t)row * 16 + ii], s1 = SN[(size_t)row * 16 + ii + 1];
              *(unsigned*)(KF + (size_t)row * 768 + h * 96 + 64 + ii) = mk_pk2(x10 * c0 - x20 * s0, x11 * c1 - x21 * s1);
              *(unsigned*)(KF + (size_t)row * 768 + h * 96 + 80 + ii) = mk_pk2(x10 * s0 + x20 * c0, x11 * s1 + x21 * c1); }
        }
        __syncthreads();
        { unsigned char* w = opq(args.ws); pg8::Gemm g{WP(bf16_t, WS_LAT), WP(bf16_t, WS_WUQ), S, 768, QLORA, 768}; pg8::StaticOrder so; so.init(S, 768, G, bx);
          rs_fill(L, WP(const float, WS_SSQL), 32, 0, 3, 1.f / 384.f, 0.14724444602590306f, bx & 7, wave, lane); pg8::EpiQUp E{WP(bf16_t, WS_QF), RT_PTR, WP(float, WS_CS), WP(float, WS_SN)}; pg8::gemm_phase<pg8::EpiQUp, pg8::StaticOrder, true, true>(L, g, so, E, wave); }
        { unsigned char* w = opq(args.ws); pg8::Gemm g{WP(bf16_t, WS_LAT) + 384, WP(bf16_t, WS_WUKV), S, 1024, KVLORA, 768}; pg8::StaticOrder so; so.init(S, 1024, G, bx);
          rs_fill(L, WP(const float, WS_SSQL), 32, 12, 2, 1.f / 256.f, 1.f, bx & 7, wave, lane); pg8::EpiKVUp E{WP(bf16_t, WS_KF), WP(bf16_t, WS_VV), RT_PTR}; pg8::gemm_phase<pg8::EpiKVUp, pg8::StaticOrder, true, true>(L, g, so, E, wave); }
    }
    SEAM(5);
    if (IN(6)) { { unsigned char* w = opq(args.ws); mla::mla_phase((__attribute__((address_space(3))) char*)L, WP(const bf16_t, WS_QF), WP(const bf16_t, WS_KF), WP(const bf16_t, WS_VV), WP(bf16_t, WS_ATT), bx, G, wave, lane); }
        unsigned char* w = opq(args.ws); pg8::Gemm g{WP(bf16_t, WS_XB), WP(bf16_t, WS_WG), S, 2048, DM, DM}; pg8::StaticOrder so; so.init(S, 2048, G, bx);
        rs_fill(L, WP(const float, WS_SSQ1), 16, 0, 4, 1.f / 1024.f, 1.f, bx & 7, wave, lane); pg8::EpiGate E{WP(bf16_t, WS_G), args.in[10], RT_PTR}; pg8::gemm_phase<pg8::EpiGate, pg8::StaticOrder, true, true>(L, g, so, E, wave); }
    SEAM(6);
    if (IN(7)) { pg8::StaticOrder so; so.init(S, DM, G, bx);
        { unsigned char* w = opq(args.ws); pg8::Gemm g{WP(bf16_t, WS_ATT), WP(bf16_t, WS_WBA), S, DM, 512, 512}; pg8::EpiMerge<false> E{WP(bf16_t, WS_MG), WP(bf16_t, WS_G)}; pg8::gemm_phase<pg8::EpiMerge<false>, pg8::StaticOrder, true, true>(L, g, so, E, wave); }
        { unsigned char* w = opq(args.ws); pg8::Gemm g{WP(bf16_t, WS_DIL), WP(bf16_t, WS_WBD), S, DM, 512, 512}; pg8::EpiMerge<true> E{WP(bf16_t, WS_MG), WP(bf16_t, WS_G)}; pg8::gemm_phase<pg8::EpiMerge<true>, pg8::StaticOrder, true, true>(L, g, so, E, wave); } }
    SEAM(7);
    if (IN(8)) { unsigned char* w = opq(args.ws); pg8::Gemm g{WP(bf16_t, WS_MG), WP(bf16_t, WS_WO), S, DM, DM, DM}; pg8::StaticOrder so; so.init(S, DM, G, bx);
        pg8::EpiResid<true> E{nullptr, WP(bf16_t, WS_XB), WP(float, WS_SSQ2), 1.0f, 0.f}; pg8::gemm_phase<pg8::EpiResid<true>, pg8::StaticOrder, true, true>(L, g, so, E, wave); }
    SEAML(8);
    if (IN(9)) { unsigned char* w = opq(args.ws); pg8::Gemm g{WP(bf16_t, WS_XB), WP(bf16_t, WS_WGU), S, 2 * DFF, DM, DM}; pg8::StaticOrder so; so.init(S, 2 * DFF, G, bx);
        rs_fill(L, WP(const float, WS_SSQ2), 16, 0, 4, 1.f / 1024.f, 1.f, bx & 7, wave, lane); pg8::EpiSwiglu E{WP(bf16_t, WS_H), WP(float, WS_SSQ2), 1, RT_PTR}; pg8::gemm_phase<pg8::EpiSwiglu, pg8::StaticOrder, true, true>(L, g, so, E, wave); }
    SEAML(9);
    if (IN(10)) { unsigned char* w = opq(args.ws); pg8::Gemm g{WP(bf16_t, WS_H), WP(bf16_t, WS_WD), S, DM, DFF, DFF}; pg8::StaticOrder so; so.init(S, DM, G, bx);
        pg8::EpiFinal E{(const PGAS bf16_t*)WP(bf16_t, WS_XB), (PGAS float*)args.out, (const PGAS float*)args.in[3], (unsigned*)(w + 248 * MiB), (unsigned*)(w + WS_CTL) + 16384, 0.5f, 0.f};
        pg8::gemm_phase<pg8::EpiFinal, pg8::StaticOrder, true, true>(L, g, so, E, wave); }
#undef IN
#undef SEAM
#undef lane
#undef tid
}

#undef args
extern "C" void kernel_launch(void* const* d_in, const int* in_sizes, int n_in, void* d_out, int out_size, void* d_ws, size_t ws_size, hipStream_t stream) {
    float* R = (float*)d_out; unsigned char* ws = (unsigned char*)d_ws;
    if (ws_size < 256 * MiB || n_in != 22) { fprintf(stderr, "bad args: ws %zu n_in %d\n", ws_size, n_in); return; }
    static int grid = 0;
    if (grid == 0) {
        int dev = 0, cus = 0, per_cu = 0; (void)hipGetDevice(&dev); (void)hipDeviceGetAttribute(&cus, hipDeviceAttributeMultiprocessorCount, dev);
        if (hipFuncSetAttribute((const void*)mk_fwd, hipFuncAttributeMaxDynamicSharedMemorySize, MK_LDS_BYTES) != hipSuccess) fprintf(stderr, "hipFuncSetAttribute failed\n");
        if (hipOccupancyMaxActiveBlocksPerMultiprocessor(&per_cu, (const void*)mk_fwd, NWAVES * 64, MK_LDS_BYTES) != hipSuccess || per_cu < 1) { fprintf(stderr, "occupancy query: %d\n", per_cu); per_cu = 1; }
        (void)hipGetLastError();
        grid = cus * (per_cu < 1 ? 1 : per_cu);
        if (grid != 256) fprintf(stderr, "note: grid %d (per_cu %d)\n", grid, per_cu);
    }
    MkArgs a{}; for (int i = 0; i < 22; ++i) a.in[i] = (const float*)d_in[i]; a.out = R; a.ws = ws;
    InvFreq ifr; for (int i = 0; i < 16; ++i) ifr.f[i] = (float)(1.0 / pow(10000.0, (double)(2 * i) / 32.0));
    (void)hipMemsetAsync(ws + WS_CTL, 0, 131072, stream);
    a.ph_lo = 0; a.ph_hi = 11;
    void* kargs[] = {(void*)&a, (void*)&ifr};
    hipError_t le = hipLaunchCooperativeKernel((const void*)mk_fwd, dim3(grid), dim3(NWAVES * 64), kargs, MK_LDS_BYTES, stream);
    if (le != hipSuccess) fprintf(stderr, "cooperative launch failed: %s (grid %d)\n", hipGetErrorString(le), grid);
}
```
